# Optimizing an MI355X kernel written in HIP

```python
import math, functools
import jax, jax.numpy as jnp
from jax import lax
import numpy as np

D_MODEL = 1024
BATCH = 8
SEQ = 2048
DEPTH = 1
DEC_BATCH = 32
DEC_SEQ = 32
PAST_LEN = 4096

CHUNK = 64
Q_BLOCK = 128
EPS = 1e-6
A_HEADS = 8
A_NOPE = 64
A_ROPE = 32
A_V = 64
A_Q_LORA = 256
A_KV_LORA = 128
ROPE_THETA = 10000.0
A_WIDTH = A_HEADS * A_V
B_HEADS = 8
B_KV_HEADS = 2
B_HEAD_DIM = 64
B_WIDTH = B_HEADS * B_HEAD_DIM
IDX_HEADS = 8
IDX_DIM = 64
TOP_K_MAX = 256
N_BUCKETS = 32
MAX_DISTANCE = 128

D_MIX = A_WIDTH + B_WIDTH
SPLITS = (A_Q_LORA, A_KV_LORA, A_ROPE, A_WIDTH,
          B_WIDTH, B_KV_HEADS * B_HEAD_DIM, B_KV_HEADS * B_HEAD_DIM,
          IDX_HEADS * IDX_DIM, IDX_DIM, IDX_HEADS, B_WIDTH)
IN_WIDTH = (A_Q_LORA + A_KV_LORA + A_ROPE + A_WIDTH + B_WIDTH + 2 * B_KV_HEADS * B_HEAD_DIM
            + IDX_HEADS * IDX_DIM + IDX_DIM + IDX_HEADS + B_WIDTH)

kernel_name = "hybrid_mla_dsa_streaming_step"


def rmsnorm(x, g):
    xf = x.astype(jnp.float32)
    y = xf * lax.rsqrt(jnp.mean(xf * xf, axis=-1, keepdims=True) + EPS)
    return (y * g.astype(jnp.float32)).astype(x.dtype)


def rope(x, pos):
    half = A_ROPE // 2
    inv = ROPE_THETA ** (-jnp.arange(half, dtype=jnp.float32) / half)
    ang = pos.astype(jnp.float32)[:, None] * inv[None, :]
    bshape = (pos.shape[0],) + (1,) * (x.ndim - 3) + (half,)
    cos = jnp.cos(ang).reshape(bshape)
    sin = jnp.sin(ang).reshape(bshape)
    xf = x.astype(jnp.float32)
    x1, x2 = xf[..., :half], xf[..., half:]
    return jnp.concatenate([x1 * cos - x2 * sin, x1 * sin + x2 * cos], axis=-1).astype(x.dtype)


def t5_bucket(rel):
    nb = N_BUCKETS // 2
    max_exact = nb // 2
    ret = (rel > 0).astype(jnp.int32) * nb
    n = jnp.abs(rel)
    nf = jnp.maximum(n, 1).astype(jnp.float32)
    large = max_exact + (jnp.log(nf / max_exact) / math.log(MAX_DISTANCE / max_exact)
                         * (nb - max_exact)).astype(jnp.int32)
    large = jnp.minimum(large, nb - 1)
    return ret + jnp.where(n < max_exact, n, large)


def chunk_admissible(pos_q, pos_k):
    return (pos_q[:, None] // CHUNK) >= (pos_k[None, :] // CHUNK)


def project(x, pos, norm_g, w_in, q_norm_g, kv_norm_g, w_uq, w_uk):
    b, t = x.shape[0], x.shape[1]
    h = rmsnorm(x, norm_g)
    z = jnp.einsum('btd,de->bte', h, w_in)
    offs = [int(o) for o in np.cumsum(SPLITS)[:-1]]
    (c_q, c_kv, k_pe, gate_a, q_b, k_b, v_b, q_idx, k_idx, w_idx, gate_b) = jnp.split(z, offs, axis=-1)
    cq = rmsnorm(c_q, q_norm_g)
    q = jnp.einsum('btc,che->bthe', cq, w_uq)
    q_nope, q_pe = q[..., :A_NOPE], rope(q[..., A_NOPE:], pos)
    q_lat = jnp.einsum('bthn,chn->bthc', q_nope, w_uk)
    ckv = rmsnorm(c_kv, kv_norm_g)
    kpe = rope(k_pe, pos)
    q_b = q_b.reshape(b, t, B_HEADS, B_HEAD_DIM)
    k_b = k_b.reshape(b, t, B_KV_HEADS, B_HEAD_DIM)
    v_b = v_b.reshape(b, t, B_KV_HEADS, B_HEAD_DIM)
    q_idx = q_idx.reshape(b, t, IDX_HEADS, IDX_DIM)
    w_idx = w_idx * (IDX_HEADS ** -0.5)
    return q_lat, q_pe, ckv, kpe, gate_a, q_b, k_b, v_b, q_idx, k_idx, w_idx, gate_b


def mla_attend(ckv, kpe, pos_k, q_lat, q_pe, pos_q):
    s = (jnp.einsum('bthc,bsc->bhts', q_lat, ckv) + jnp.einsum('bthr,bsr->bhts', q_pe, kpe)).astype(jnp.float32)
    s = s * ((A_NOPE + A_ROPE) ** -0.5)
    s = jnp.where(chunk_admissible(pos_q, pos_k)[None, None], s, -jnp.inf)
    p = jax.nn.softmax(s, axis=-1).astype(ckv.dtype)
    return jnp.einsum('bhts,bsc->bthc', p, ckv)


def dsa_attend(k, v, k_idx, pos_k, rel_bias, n_top, q, q_idx, w_idx, pos_q):
    b, tq = q.shape[0], q.shape[1]
    dots = jnp.einsum('bthd,bsd->bths', q_idx, k_idx).astype(jnp.float32) * (IDX_DIM ** -0.5)
    score = jnp.einsum('bths,bth->bts', jax.nn.relu(dots), w_idx.astype(jnp.float32))
    score = jnp.where(chunk_admissible(pos_q, pos_k)[None], score, -jnp.inf)
    _, sel = lax.top_k(score, n_top)
    gather = jax.vmap(lambda rows, ib: rows[ib])
    k_sel = gather(k, sel)
    v_sel = gather(v, sel)
    pos_sel = pos_k[sel]
    valid = (pos_sel // CHUNK) <= (pos_q[None, :, None] // CHUNK)
    bias = rel_bias[t5_bucket(pos_sel - pos_q[None, :, None])].astype(jnp.float32)
    g = B_HEADS // B_KV_HEADS
    bias = jnp.moveaxis(bias.reshape(b, tq, n_top, B_KV_HEADS, g), 2, -1)
    qg = q.reshape(b, tq, B_KV_HEADS, g, B_HEAD_DIM)
    logits = jnp.einsum('btkgd,btjkd->btkgj', qg, k_sel).astype(jnp.float32) * (B_HEAD_DIM ** -0.5) + bias
    logits = jnp.where(valid[:, :, None, None, :], logits, -jnp.inf)
    p = jax.nn.softmax(logits, axis=-1).astype(v.dtype)
    o = jnp.einsum('btkgj,btjkd->btkgd', p, v_sel)
    return o.reshape(b, tq, B_HEADS, B_HEAD_DIM)


def sweep(fn, q_args, pos_q):
    b, t = q_args[0].shape[0], q_args[0].shape[1]
    nb = t // Q_BLOCK
    blk = lambda a: jnp.moveaxis(a.reshape((b, nb, Q_BLOCK) + a.shape[2:]), 1, 0)
    xs = tuple(blk(a) for a in q_args) + (pos_q.reshape(nb, Q_BLOCK),)
    out = lax.map(lambda args: fn(*args), xs)
    return jnp.moveaxis(out, 0, 1).reshape((b, t) + out.shape[3:])


def combine(x, o_lat, o_b, gate_a, gate_b, w_uv, w_out):
    b, t = x.shape[0], x.shape[1]
    o_a = jnp.einsum('bthc,chv->bthv', o_lat, w_uv).reshape(b, t, A_WIDTH)
    mix = jnp.concatenate([o_a * jax.nn.silu(gate_a), o_b.reshape(b, t, B_WIDTH) * jax.nn.silu(gate_b)], axis=-1)
    return x + jnp.einsum('bte,ed->btd', mix, w_out)


def setup_inputs(seed: int = 0) -> dict:
    key = jax.random.key(seed)
    ks = jax.random.split(key, 20)
    f = jnp.float32
    nrm = lambda k, shape, scale: jax.random.normal(k, shape, f) * scale
    return {
        "x_prompt": nrm(ks[0], (BATCH, SEQ, D_MODEL), 1.0),
        "x_sample": nrm(ks[1], (DEC_BATCH, DEC_SEQ, D_MODEL), 1.0),
        "cache_mla_ckv": nrm(ks[2], (DEPTH, DEC_BATCH, PAST_LEN, A_KV_LORA), 1.0),
        "cache_mla_kpe": nrm(ks[3], (DEPTH, DEC_BATCH, PAST_LEN, A_ROPE), 1.0),
        "cache_dsa_k": nrm(ks[4], (DEPTH, DEC_BATCH, PAST_LEN, B_KV_HEADS, B_HEAD_DIM), 1.0),
        "cache_dsa_v": nrm(ks[5], (DEPTH, DEC_BATCH, PAST_LEN, B_KV_HEADS, B_HEAD_DIM), 1.0),
        "cache_dsa_kidx": nrm(ks[6], (DEPTH, DEC_BATCH, PAST_LEN, IDX_DIM), 1.0),
        "norm_g": 1.0 + nrm(ks[7], (DEPTH, D_MODEL), 0.01),
        "w_in": nrm(ks[8], (DEPTH, D_MODEL, IN_WIDTH), D_MODEL ** -0.5),
        "mla_q_norm_g": 1.0 + nrm(ks[9], (DEPTH, A_Q_LORA), 0.01),
        "mla_kv_norm_g": 1.0 + nrm(ks[10], (DEPTH, A_KV_LORA), 0.01),
        "mla_w_uq": nrm(ks[11], (DEPTH, A_Q_LORA, A_HEADS, A_NOPE + A_ROPE), A_Q_LORA ** -0.5),
        "mla_w_uk": nrm(ks[12], (DEPTH, A_KV_LORA, A_HEADS, A_NOPE), A_KV_LORA ** -0.5),
        "mla_w_uv": nrm(ks[13], (DEPTH, A_KV_LORA, A_HEADS, A_V), A_KV_LORA ** -0.5),
        "rel_bias": nrm(ks[14], (N_BUCKETS, B_HEADS), 0.1),
        "w_out": nrm(ks[15], (DEPTH, D_MIX, D_MODEL), D_MIX ** -0.5),
        "final_norm_g": 1.0 + nrm(ks[16], (D_MODEL,), 0.01),
    }


def reference(x_prompt, x_sample, cache_mla_ckv, cache_mla_kpe, cache_dsa_k, cache_dsa_v, cache_dsa_kidx,
              norm_g, w_in, mla_q_norm_g, mla_kv_norm_g, mla_w_uq, mla_w_uk, mla_w_uv, rel_bias, w_out,
              final_norm_g):
    t_p = x_prompt.shape[1]
    t_s = x_sample.shape[1]
    past = cache_mla_ckv.shape[2]
    pos_p = jnp.arange(t_p, dtype=jnp.int32)
    pos_s = past + jnp.arange(t_s, dtype=jnp.int32)
    pos_all = jnp.arange(past + t_s, dtype=jnp.int32)
    n_top_p = min(TOP_K_MAX, t_p // 4)
    n_top_s = min(TOP_K_MAX, (past + t_s) // 4)

    xp, xs = x_prompt, x_sample
    p_ckv, p_kpe, p_k, p_v, p_kidx = [], [], [], [], []
    s_ckv, s_kpe, s_k, s_v, s_kidx = [], [], [], [], []
    for l in range(DEPTH):
        lw = (norm_g[l], w_in[l], mla_q_norm_g[l], mla_kv_norm_g[l], mla_w_uq[l], mla_w_uk[l])
        (q_lat, q_pe, ckv, kpe, gate_a, q_b, k_b, v_b, q_idx, k_idx, w_idx, gate_b) = project(xp, pos_p, *lw)
        o_lat = sweep(functools.partial(mla_attend, ckv, kpe, pos_p), (q_lat, q_pe), pos_p)
        o_b = sweep(functools.partial(dsa_attend, k_b, v_b, k_idx, pos_p, rel_bias, n_top_p),
                    (q_b, q_idx, w_idx), pos_p)
        xp = combine(xp, o_lat, o_b, gate_a, gate_b, mla_w_uv[l], w_out[l])
        p_ckv.append(ckv); p_kpe.append(kpe); p_k.append(k_b); p_v.append(v_b); p_kidx.append(k_idx)
        (q_lat, q_pe, ckv, kpe, gate_a, q_b, k_b, v_b, q_idx, k_idx, w_idx, gate_b) = project(xs, pos_s, *lw)
        ckv_all = jnp.concatenate([cache_mla_ckv[l], ckv], axis=1)
        kpe_all = jnp.concatenate([cache_mla_kpe[l], kpe], axis=1)
        k_all = jnp.concatenate([cache_dsa_k[l], k_b], axis=1)
        v_all = jnp.concatenate([cache_dsa_v[l], v_b], axis=1)
        kidx_all = jnp.concatenate([cache_dsa_kidx[l], k_idx], axis=1)
        o_lat = mla_attend(ckv_all, kpe_all, pos_all, q_lat, q_pe, pos_s)
        o_b = dsa_attend(k_all, v_all, kidx_all, pos_all, rel_bias, n_top_s, q_b, q_idx, w_idx, pos_s)
        xs = combine(xs, o_lat, o_b, gate_a, gate_b, mla_w_uv[l], w_out[l])
        s_ckv.append(ckv); s_kpe.append(kpe); s_k.append(k_b); s_v.append(v_b); s_kidx.append(k_idx)

    y_prompt = rmsnorm(xp, final_norm_g)
    y_sample = rmsnorm(xs, final_norm_g)
    return (y_prompt, y_sample,
            jnp.stack(p_ckv), jnp.stack(p_kpe), jnp.stack(p_k), jnp.stack(p_v), jnp.stack(p_kidx),
            jnp.stack(s_ckv), jnp.stack(s_kpe), jnp.stack(s_k), jnp.stack(s_v), jnp.stack(s_kidx))
```

```cpp
#include <hip/hip_runtime.h>
#include <stdint.h>
#include <stdio.h>

typedef _Float16 h16;
typedef h16 h8 __attribute__((ext_vector_type(8)));
typedef h16 h4 __attribute__((ext_vector_type(4)));
typedef h16 h2 __attribute__((ext_vector_type(2)));
typedef float f16v __attribute__((ext_vector_type(16)));
typedef short s4v __attribute__((vector_size(8)));
typedef __attribute__((address_space(3))) s4v* lds_s4p;

#define DI __device__ __forceinline__
#define MFMA32(a, b, c) __builtin_amdgcn_mfma_f32_32x32x16_f16((a), (b), (c), 0, 0, 0)

#define NTOK 17408
#define NP 16384
#define DM 1024
#define INW 2792
#define INWP 2816
#define PAST 4096
#define SKEYS 4128
#define NBLK_THREADS 512

#define OFF_Y 0
#define OFF_P_CKV 17825792
#define OFF_P_KPE 19922944
#define OFF_P_K 20447232
#define OFF_P_V 22544384
#define OFF_P_KIDX 24641536
#define OFF_S_CKV 25690112
#define OFF_S_KPE 25821184
#define OFF_S_K 25853952
#define OFF_S_V 25985024
#define OFF_S_KIDX 26116096

#define ZC_CQ 0
#define ZC_CKV 256
#define ZC_KPE 384
#define ZC_GA 416
#define ZC_QB 928
#define ZC_KB 1440
#define ZC_VB 1568
#define ZC_QI 1696
#define ZC_KI 2208
#define ZC_WI 2272
#define ZC_GB 2280

#define LOG2E 1.4426950408889634f
#define QM_SCALE 0.14724444602590306f
#define QB_SCALE 0.18033688011112042f
#define WI_SCALE 0.04419417382415922f
#define NEGBIG (-1.0e30f)

#define SMEM_BYTES 131072
#define SC_STRIDE_P 2048
#define SC_STRIDE_S 4160
#define MASK_W 132
#define N_ITEMS 1088

struct P {
  const float *x_p, *x_s, *c_ckv, *c_kpe, *c_k, *c_v, *c_kidx, *norm_g, *w_in, *qn_g, *kvn_g, *w_uq, *w_uk, *w_uv,
      *rel_bias, *w_out, *fn_g;
  float* out;
  h16 *hX, *CQ, *Wt_in, *Wt_out, *Wq, *Wuv, *QM, *KM, *GA, *GB, *QB, *KB, *VB, *QI, *KI, *mix, *XN;
  float *WI, *ropeC, *ropeS, *scP, *scS, *RQP;
  unsigned* counters;
};

DI int crow(int i, int hh) { return (i & 3) + 8 * (i >> 2) + 4 * hh; }
DI float wave_sum(float v) {
#pragma unroll
  for (int off = 32; off > 0; off >>= 1) v += __shfl_xor(v, off);
  return v;
}
DI float wave_max(float v) {
#pragma unroll
  for (int off = 32; off > 0; off >>= 1) v = fmaxf(v, __shfl_xor(v, off));
  return v;
}
DI float wave_min(float v) {
#pragma unroll
  for (int off = 32; off > 0; off >>= 1) v = fminf(v, __shfl_xor(v, off));
  return v;
}
DI h4 trread(const h16* p) {
  s4v r = __builtin_amdgcn_ds_read_tr16_b64_v4i16((lds_s4p)(p));
  return __builtin_bit_cast(h4, r);
}
DI h8 cat8(h4 a, h4 b) { return __builtin_shufflevector(a, b, 0, 1, 2, 3, 4, 5, 6, 7); }
DI h8 cvt8(float4 a, float4 b) {
  h8 r;
  r[0] = (h16)a.x; r[1] = (h16)a.y; r[2] = (h16)a.z; r[3] = (h16)a.w;
  r[4] = (h16)b.x; r[5] = (h16)b.y; r[6] = (h16)b.z; r[7] = (h16)b.w;
  return r;
}
DI h8 zero8() { h8 r; for (int i = 0; i < 8; ++i) r[i] = (h16)0.f; return r; }
DI float fast_exp2(float x) { return __builtin_amdgcn_exp2f(x); }
DI float silu(float x) { return x * __builtin_amdgcn_rcpf(1.f + __expf(-x)); }
DI int rope_idx(int t) { return t < NP ? (t & 2047) : 2048 + ((t - NP) & 31); }
DI int opaque_tid() { int t = threadIdx.x; asm volatile("" : "+v"(t)); return t; }
#define XB_CNT(x) (256 + 64 * (x))
#define XB_ARR(x) (256 + 64 * (16 + (x)))
#define XB_GEN(x) (256 + 64 * (32 + (x)))
#define XB_TOP (256 + 64 * 48)
#define XB_WORDS (256 + 64 * 49)
DI unsigned xb_ld(unsigned* q) { return __hip_atomic_load(q, __ATOMIC_RELAXED, __HIP_MEMORY_SCOPE_AGENT); }
struct XBar { unsigned* w; unsigned x, nloc, nx; };
DI void xcd_barrier(XBar& xb, unsigned k, char* smem) {
  asm volatile("s_waitcnt vmcnt(0)" ::: "memory");
  __syncthreads();
  volatile unsigned* bc = (volatile unsigned*)(smem + SMEM_BYTES - 64);
  if (threadIdx.x == 0) {
    if (k == 1u) {
      const unsigned G = gridDim.x;
      unsigned sum, nxx;
      do {
        sum = 0u; nxx = 0u;
        for (int j = 0; j < 16; ++j) { const unsigned c = xb_ld(&xb.w[XB_CNT(j)]); sum += c; nxx += (c != 0u); }
        if (sum != G) __builtin_amdgcn_s_sleep(2);
      } while (sum != G);
      bc[0] = xb_ld(&xb.w[XB_CNT(xb.x)]);
      bc[1] = nxx;
    }
  }
  if (k == 1u) {
    __syncthreads();
    xb.nloc = (unsigned)__builtin_amdgcn_readfirstlane((int)bc[0]);
    xb.nx = (unsigned)__builtin_amdgcn_readfirstlane((int)bc[1]);
  }
  if (threadIdx.x == 0) {
    const unsigned old = __hip_atomic_fetch_add(&xb.w[XB_ARR(xb.x)], 1u, __ATOMIC_RELAXED, __HIP_MEMORY_SCOPE_AGENT);
    if (old + 1u == k * xb.nloc) {
      __builtin_amdgcn_fence(__ATOMIC_RELEASE, "agent");
      asm volatile("s_waitcnt vmcnt(0)" ::: "memory");
      __hip_atomic_fetch_add(&xb.w[XB_TOP], 1u, __ATOMIC_RELAXED, __HIP_MEMORY_SCOPE_AGENT);
      while (xb_ld(&xb.w[XB_TOP]) < k * xb.nx) __builtin_amdgcn_s_sleep(1);
      __hip_atomic_store(&xb.w[XB_GEN(xb.x)], k, __ATOMIC_RELAXED, __HIP_MEMORY_SCOPE_AGENT);
    } else {
      while (xb_ld(&xb.w[XB_GEN(xb.x)]) < k) __builtin_amdgcn_s_sleep(1);
    }
    __builtin_amdgcn_fence(__ATOMIC_ACQUIRE, "agent");
    asm volatile("s_waitcnt vmcnt(0)" ::: "memory");
  }
  __syncthreads();
}
DI void grid_barrier(unsigned* bar, unsigned target) {
  asm volatile("s_waitcnt vmcnt(0)" ::: "memory");
  __syncthreads();
  if (threadIdx.x == 0) {
    __builtin_amdgcn_fence(__ATOMIC_RELEASE, "agent");
    asm volatile("s_waitcnt vmcnt(0)" ::: "memory");
    __hip_atomic_fetch_add(bar, 1u, __ATOMIC_RELAXED, __HIP_MEMORY_SCOPE_AGENT);
    while (__hip_atomic_load(bar, __ATOMIC_RELAXED, __HIP_MEMORY_SCOPE_AGENT) < target) __builtin_amdgcn_s_sleep(2);
    __builtin_amdgcn_fence(__ATOMIC_ACQUIRE, "agent");
    asm volatile("s_waitcnt vmcnt(0)" ::: "memory");
  }
  __syncthreads();
}
typedef float f2v __attribute__((ext_vector_type(2)));
DI float max3f(float a, float b, float c) {
  float d;
  asm("v_max3_f32 %0, %1, %2, %3" : "=v"(d) : "v"(a), "v"(b), "v"(c));
  return d;
}
DI void mfma_settle() {
  __builtin_amdgcn_sched_barrier(0);
  asm volatile("s_nop 7\n\ts_nop 7");
  __builtin_amdgcn_sched_barrier(0);
}
DI void pin8(const h8& v) { asm volatile("" ::"v"(v)); }
DI void pinf(const float& v) { asm volatile("" ::"v"(v)); }
DI void wavebar() { asm volatile("s_waitcnt lgkmcnt(0)" ::: "memory"); }

__constant__ float c_inv_freq[16] = {1.000000000e+00f, 5.623413324e-01f, 3.162277639e-01f, 1.778279394e-01f,
                                     1.000000015e-01f, 5.623413250e-02f, 3.162277490e-02f, 1.778279431e-02f,
                                     9.999999776e-03f, 5.623413250e-03f, 3.162277630e-03f, 1.778279431e-03f,
                                     1.000000047e-03f, 5.623413017e-04f, 3.162277571e-04f, 1.778279402e-04f};

DI void sincos_acc(float angf, float* so, float* co) {
  const double a = (double)angf;
  const double q = rint(a * 0.6366197723675814);
  double t = fma(-q, 1.5707963267948966, a);
  t = fma(-q, 6.123233995736766e-17, t);
  const int qi = ((int)q) & 3;
  const double t2 = t * t;
  double sn = -1.0 / 1307674368000.0;
  sn = fma(sn, t2, 1.0 / 6227020800.0);
  sn = fma(sn, t2, -1.0 / 39916800.0);
  sn = fma(sn, t2, 1.0 / 362880.0);
  sn = fma(sn, t2, -1.0 / 5040.0);
  sn = fma(sn, t2, 1.0 / 120.0);
  sn = fma(sn, t2, -1.0 / 6.0);
  sn = fma(sn * t2, t, t);
  double cs = 1.0 / 20922789888000.0;
  cs = fma(cs, t2, -1.0 / 87178291200.0);
  cs = fma(cs, t2, 1.0 / 479001600.0);
  cs = fma(cs, t2, -1.0 / 3628800.0);
  cs = fma(cs, t2, 1.0 / 40320.0);
  cs = fma(cs, t2, -1.0 / 720.0);
  cs = fma(cs, t2, 1.0 / 24.0);
  cs = fma(cs, t2, -0.5);
  cs = fma(cs, t2, 1.0);
  double s, c;
  if (qi == 0) { s = sn; c = cs; }
  else if (qi == 1) { s = cs; c = -sn; }
  else if (qi == 2) { s = -sn; c = -cs; }
  else { s = -cs; c = sn; }
  *so = (float)s; *co = (float)c;
}

DI void transpose_to_h(const float* __restrict__ src, int K, int N, int Npad, h16* __restrict__ dst, char* smem) {
  float* tile = (float*)smem;
  const int tid = opaque_tid();
  const int ktn = K / 64, ntn = Npad / 64;
  for (int tix = blockIdx.x; tix < ktn * ntn; tix += gridDim.x) {
    const int k0 = (tix / ntn) * 64, n0 = (tix % ntn) * 64;
    {
      const int nn = tid & 63;
#pragma unroll
      for (int i = 0; i < 8; ++i) {
        const int kk = (tid >> 6) + 8 * i;
        const int n = n0 + nn;
        tile[kk * 65 + nn] = (n < N) ? src[(size_t)(k0 + kk) * N + n] : 0.f;
      }
    }
    __syncthreads();
    {
      const int kk = tid & 63;
#pragma unroll
      for (int i = 0; i < 8; ++i) {
        const int nn = (tid >> 6) + 8 * i;
        dst[(size_t)(n0 + nn) * K + k0 + kk] = (h16)tile[kk * 65 + nn];
      }
    }
    __syncthreads();
  }
}

DI void phase0(const P& p, char* smem) {
  const int tid = opaque_tid(), lane = tid & 63, w = tid >> 6;
  const int gw = blockIdx.x * 8 + w, nw = gridDim.x * 8;
  const int gt = blockIdx.x * NBLK_THREADS + tid, nt = gridDim.x * NBLK_THREADS;
  for (int row0 = gw * 4; row0 < NTOK; row0 += nw * 4) {
    float4 v[4][4];
    float ss[4];
#pragma unroll
    for (int rr = 0; rr < 4; ++rr) {
      const int row = row0 + rr;
      const float* x = row < NP ? p.x_p + (size_t)row * DM : p.x_s + (size_t)(row - NP) * DM;
#pragma unroll
      for (int i = 0; i < 4; ++i) v[rr][i] = ((const float4*)x)[lane + 64 * i];
    }
#pragma unroll
    for (int rr = 0; rr < 4; ++rr) {
      float a = 0.f;
#pragma unroll
      for (int i = 0; i < 4; ++i)
        a += v[rr][i].x * v[rr][i].x + v[rr][i].y * v[rr][i].y + v[rr][i].z * v[rr][i].z + v[rr][i].w * v[rr][i].w;
      ss[rr] = a;
    }
#pragma unroll
    for (int off = 32; off > 0; off >>= 1) {
#pragma unroll
      for (int rr = 0; rr < 4; ++rr) ss[rr] += __shfl_xor(ss[rr], off);
    }
#pragma unroll
    for (int rr = 0; rr < 4; ++rr) {
      const float rstd = rsqrtf(ss[rr] * (1.f / 1024.f) + 1e-6f);
#pragma unroll
      for (int i = 0; i < 4; ++i) {
        const float4 g = ((const float4*)p.norm_g)[lane + 64 * i];
        h4 o;
        o[0] = (h16)(v[rr][i].x * rstd * g.x); o[1] = (h16)(v[rr][i].y * rstd * g.y);
        o[2] = (h16)(v[rr][i].z * rstd * g.z); o[3] = (h16)(v[rr][i].w * rstd * g.w);
        *(h4*)(p.hX + (size_t)(row0 + rr) * DM + (lane + 64 * i) * 4) = o;
      }
    }
  }
  transpose_to_h(p.w_in, 1024, INW, INWP, p.Wt_in, smem);
  transpose_to_h(p.w_out, 1024, 1024, 1024, p.Wt_out, smem);
  for (int wt = gw; wt < 256; wt += nw) {
    const int hd = wt >> 5, k0 = ((wt >> 2) & 7) * 32, c0 = (wt & 3) * 32;
    const int r = lane & 31, hh = lane >> 5;
    f16v D;
#pragma unroll
    for (int i = 0; i < 16; ++i) D[i] = 0.f;
#pragma unroll
    for (int t = 0; t < 4; ++t) {
      const float* ap = p.w_uq + (size_t)(k0 + r) * 768 + hd * 96 + 16 * t + 8 * hh;
      const float* bp = p.w_uk + (size_t)(c0 + r) * 512 + hd * 64 + 16 * t + 8 * hh;
      const h8 a = cvt8(*(const float4*)ap, *(const float4*)(ap + 4));
      const h8 bq = cvt8(*(const float4*)bp, *(const float4*)(bp + 4));
      D = MFMA32(a, bq, D);
    }
#pragma unroll
    for (int g4 = 0; g4 < 4; ++g4) {
      const int k = k0 + 8 * g4 + 4 * hh;
      const float4 g = *(const float4*)(p.qn_g + k);
      h4 o;
      o[0] = (h16)(D[4 * g4 + 0] * g.x); o[1] = (h16)(D[4 * g4 + 1] * g.y);
      o[2] = (h16)(D[4 * g4 + 2] * g.z); o[3] = (h16)(D[4 * g4 + 3] * g.w);
      *(h4*)(p.Wq + (size_t)(hd * 128 + c0 + r) * 256 + k) = o;
    }
  }
  for (int idx = gt; idx < 256 * 256; idx += nt) {
    const int n = 1024 + (idx >> 8), k = idx & 255;
    const int hd = (n - 1024) >> 5, rr = (n - 1024) & 31;
    p.Wq[(size_t)n * 256 + k] = (h16)(p.w_uq[(size_t)k * 768 + hd * 96 + 64 + rr] * p.qn_g[k]);
  }
  for (int idx = gt; idx < 8 * 64 * 128; idx += nt) {
    const int j = idx & 7, ln = (idx >> 3) & 63, sq = (idx >> 9) & 1, dt = (idx >> 10) & 3, vt = (idx >> 12) & 1, hd = idx >> 13;
    const int v = 32 * vt + (ln & 31);
    const int c = 32 * dt + 16 * sq + 8 * (j >> 2) + 4 * (ln >> 5) + (j & 3);
    p.Wuv[idx] = (h16)p.w_uv[(size_t)c * 512 + hd * 64 + v];
  }
  for (int idx = gt; idx < 2080 * 16; idx += nt) {
    const int pi = idx >> 4, j = idx & 15;
    const int pos = pi < 2048 ? pi : PAST + (pi - 2048);
    const float ang = (float)pos * c_inv_freq[j];
    float s, c;
    sincos_acc(ang, &s, &c);
    p.ropeC[idx] = c; p.ropeS[idx] = s;
  }
}

template <int BM, int BN, int WGM, int WGN>
DI void gemm_tile(const h16* __restrict__ A, int lda, const h16* __restrict__ B, int ldb, int K, int m0, int n0,
                  char* smem) {
  constexpr int LS = 72, TS = 136;
  constexpr int TM = BM / WGM, TN = BN / WGN, MI = TM / 32, NI = TN / 32;
  constexpr int ACH = BM * 8 / NBLK_THREADS, BCH = BN * 8 / NBLK_THREADS;
  h16* sA = (h16*)smem;
  h16* sB = sA + 2 * BM * LS;
  const int tid = opaque_tid(), lane = tid & 63, w = tid >> 6;
  const int wm = w / WGN, wn = w % WGN;
  const int r = lane & 31, hh = lane >> 5;
  f16v acc[MI][NI];
#pragma unroll
  for (int mi = 0; mi < MI; ++mi)
#pragma unroll
    for (int ni = 0; ni < NI; ++ni)
#pragma unroll
      for (int i = 0; i < 16; ++i) acc[mi][ni][i] = 0.f;
  h8 ra[ACH], rb[BCH];
  const int KT = K / 64;
#define GLOAD(kt)                                                                                   \
  {                                                                                                 \
    _Pragma("unroll") for (int i = 0; i < ACH; ++i) {                                               \
      const int q = tid + NBLK_THREADS * i;                                                         \
      ra[i] = *(const h8*)(A + (size_t)(m0 + (q >> 3)) * lda + (kt) * 64 + (q & 7) * 8);            \
    }                                                                                               \
    _Pragma("unroll") for (int i = 0; i < BCH; ++i) {                                               \
      const int q = tid + NBLK_THREADS * i;                                                         \
      rb[i] = *(const h8*)(B + (size_t)(n0 + (q >> 3)) * ldb + (kt) * 64 + (q & 7) * 8);            \
    }                                                                                               \
  }
#define SSTORE(buf)                                                                                 \
  {                                                                                                 \
    _Pragma("unroll") for (int i = 0; i < ACH; ++i) {                                               \
      const int q = tid + NBLK_THREADS * i;                                                         \
      *(h8*)(sA + ((buf) * BM + (q >> 3)) * LS + (q & 7) * 8) = ra[i];                              \
    }                                                                                               \
    _Pragma("unroll") for (int i = 0; i < BCH; ++i) {                                               \
      const int q = tid + NBLK_THREADS * i;                                                         \
      *(h8*)(sB + ((buf) * BN + (q >> 3)) * LS + (q & 7) * 8) = rb[i];                              \
    }                                                                                               \
  }
  GLOAD(0);
  SSTORE(0);
  __syncthreads();
  int buf = 0;
  for (int kt = 0; kt < KT; ++kt) {
    if (kt + 1 < KT) GLOAD(kt + 1);
    const h16* a_base = sA + (buf * BM + wm * TM + r) * LS + 8 * hh;
    const h16* b_base = sB + (buf * BN + wn * TN + r) * LS + 8 * hh;
#pragma unroll
    for (int t = 0; t < 4; ++t) {
      h8 af[MI], bf[NI];
#pragma unroll
      for (int mi = 0; mi < MI; ++mi) af[mi] = *(const h8*)(a_base + mi * 32 * LS + t * 16);
#pragma unroll
      for (int ni = 0; ni < NI; ++ni) bf[ni] = *(const h8*)(b_base + ni * 32 * LS + t * 16);
#pragma unroll
      for (int mi = 0; mi < MI; ++mi)
#pragma unroll
        for (int ni = 0; ni < NI; ++ni) acc[mi][ni] = MFMA32(bf[ni], af[mi], acc[mi][ni]);
    }
    if (kt + 1 < KT) SSTORE(buf ^ 1);
    __syncthreads();
    buf ^= 1;
  }
#undef GLOAD
#undef SSTORE
  h16* T = (h16*)smem;
#pragma unroll
  for (int mi = 0; mi < MI; ++mi)
#pragma unroll
    for (int ni = 0; ni < NI; ++ni)
#pragma unroll
      for (int g4 = 0; g4 < 4; ++g4) {
        h4 o;
#pragma unroll
        for (int jj = 0; jj < 4; ++jj) o[jj] = (h16)acc[mi][ni][4 * g4 + jj];
        *(h4*)(T + (wm * TM + mi * 32 + r) * TS + wn * TN + ni * 32 + 8 * g4 + 4 * hh) = o;
      }
  __syncthreads();
}

template <int OP>
DI void epi_simple(const h16* T, int m0, h16* dst, int ld, int col0, int tid) {
  h8 v[8];
#pragma unroll
  for (int it = 0; it < 8; ++it) {
    const int q = tid + NBLK_THREADS * it;
    v[it] = *(const h8*)(T + (q >> 4) * 136 + (q & 15) * 8);
  }
#pragma unroll
  for (int it = 0; it < 8; ++it) {
    const int q = tid + NBLK_THREADS * it;
    h8 o;
#pragma unroll
    for (int e = 0; e < 8; ++e) {
      const float x = (float)v[it][e];
      o[e] = (OP == 1) ? (h16)silu(x) : (OP == 2) ? (h16)(x * QB_SCALE) : v[it][e];
    }
    *(h8*)(dst + (size_t)(m0 + (q >> 4)) * ld + col0 + (q & 15) * 8) = o;
  }
}
DI float4 f4_lo(h8 v) { return make_float4((float)v[0], (float)v[1], (float)v[2], (float)v[3]); }
DI float4 f4_hi(h8 v) { return make_float4((float)v[4], (float)v[5], (float)v[6], (float)v[7]); }
typedef float f32x4 __attribute__((ext_vector_type(4)));
typedef __attribute__((address_space(3))) unsigned* lds_u32p;
DI int g8_lds_byte(int r, int c) {
  const int st = (r >> 4) * 2 + (c >> 5), rr = r & 15, cc = c & 31, ob = rr * 64 + cc * 2;
  return st * 1024 + (ob ^ (((ob >> 9) & 1) << 5));
}
DI void g8_stage_rc(int b, int& R, int& C) {
  const int st = b / 1024, sb = b % 1024, swz = sb ^ (((sb >> 9) & 1) << 5);
  R = (st >> 1) * 16 + swz / 64;
  C = (st & 1) * 32 + (swz % 64) / 2;
}
#define G8_HT (128 * 64)
DI void gemm8_mainloop(const h16* __restrict__ A, const h16* __restrict__ Bt, int K, int brow, int bcol, char* smem,
                       f32x4 (&acc)[2][2][4][2]) {
  h16* shm = (h16*)smem;
  const int tid = opaque_tid();
  const int wid = tid >> 6, lane = tid & 63, wr = wid >> 2, wc = wid & 3, fr = lane & 15, fq = lane >> 4;
  int so[2];
#pragma unroll
  for (int i = 0; i < 2; ++i) { int R, C; g8_stage_rc(tid * 16 + i * 8192, R, C); so[i] = R * K + C; }
#define G8_SA(b, h) (shm + ((b) * 2 + (h)) * G8_HT)
#define G8_SB(b, h) (shm + (4 + (b) * 2 + (h)) * G8_HT)
#define G8_STAGE(Pp, BASE, br, kt)                                                                        \
  do {                                                                                                    \
    const h16* _bp = (BASE) + (size_t)(br) * K + (kt) * 64;                              \
    _Pragma("unroll") for (int _i = 0; _i < 2; ++_i) {                                                    \
      const h16* _g = _bp + so[_i];                                                                       \
      __builtin_amdgcn_global_load_lds((const unsigned*)_g,                                               \
                                       (lds_u32p)((char*)(Pp) + tid * 16 + _i * 8192), 16, 0, 0);         \
    }                                                                                                     \
  } while (0)
#define G8_LDA(dst, b, h)                                                                                 \
  _Pragma("unroll") for (int m = 0; m < 4; ++m) _Pragma("unroll") for (int k = 0; k < 2; ++k)             \
    dst[m][k] = *(const h8*)((const char*)G8_SA(b, h) + g8_lds_byte(wr * 64 + m * 16 + fr, k * 32 + fq * 8))
#define G8_LDB(dst, b, h)                                                                                 \
  _Pragma("unroll") for (int n = 0; n < 2; ++n) _Pragma("unroll") for (int k = 0; k < 2; ++k)             \
    dst[n][k] = *(const h8*)((const char*)G8_SB(b, h) + g8_lds_byte(wc * 32 + n * 16 + fr, k * 32 + fq * 8))
#define G8_MMA(ai, bj, At, Bq)                                                                            \
  do {                                                                                                    \
    __builtin_amdgcn_s_setprio(1);                                                                        \
    _Pragma("unroll") for (int m = 0; m < 4; ++m) _Pragma("unroll") for (int n = 0; n < 2; ++n)           \
      _Pragma("unroll") for (int k = 0; k < 2; ++k)                                                       \
        acc[ai][bj][m][n] = __builtin_amdgcn_mfma_f32_16x16x32_f16(Bq[n][k], At[m][k], acc[ai][bj][m][n], 0, 0, 0); \
    __builtin_amdgcn_s_setprio(0);                                                                        \
  } while (0)
#define G8_WAIT_V(n) asm volatile("s_waitcnt vmcnt(" #n ")" ::: "memory")
#define G8_WAIT_L(n) asm volatile("s_waitcnt lgkmcnt(" #n ")" ::: "memory")
#define G8_BAR __builtin_amdgcn_s_barrier()
#define G8_SCHED __builtin_amdgcn_sched_barrier(0)
#pragma unroll
  for (int a = 0; a < 2; ++a)
#pragma unroll
    for (int b = 0; b < 2; ++b)
#pragma unroll
      for (int m = 0; m < 4; ++m)
#pragma unroll
        for (int n = 0; n < 2; ++n) acc[a][b][m][n] = f32x4{0.f, 0.f, 0.f, 0.f};
  h8 At[4][2], B0[2][2], B1[2][2];
  const int nt = K / 64;
  G8_STAGE(G8_SB(0, 0), Bt, bcol, 0); G8_STAGE(G8_SA(0, 0), A, brow, 0);
  G8_STAGE(G8_SB(0, 1), Bt, bcol + 128, 0); G8_STAGE(G8_SA(0, 1), A, brow + 128, 0);
  if (wr == 1) G8_BAR;
  G8_WAIT_V(4); G8_BAR;
  G8_STAGE(G8_SB(1, 0), Bt, bcol, 1); G8_STAGE(G8_SA(1, 0), A, brow, 1); G8_STAGE(G8_SB(1, 1), Bt, bcol + 128, 1);
  G8_WAIT_V(6); G8_BAR;
  for (int t = 0; t < nt - 2; t += 2) {
    G8_LDB(B0, 0, 0); G8_SCHED; G8_LDA(At, 0, 0); G8_STAGE(G8_SA(1, 1), A, brow + 128, t + 1);
    G8_WAIT_L(8); G8_BAR; G8_WAIT_L(0); G8_MMA(0, 0, At, B0); G8_BAR; G8_SCHED;
    G8_LDB(B1, 0, 1); G8_STAGE(G8_SB(0, 0), Bt, bcol, t + 2);
    G8_BAR; G8_WAIT_L(0); G8_MMA(0, 1, At, B1); G8_BAR;
    G8_LDA(At, 0, 1); G8_STAGE(G8_SA(0, 0), A, brow, t + 2);
    G8_BAR; G8_WAIT_L(0); G8_MMA(1, 0, At, B0); G8_BAR; G8_SCHED;
    G8_STAGE(G8_SB(0, 1), Bt, bcol + 128, t + 2);
    G8_WAIT_V(6); G8_BAR; G8_MMA(1, 1, At, B1); G8_BAR;
    G8_LDB(B0, 1, 0); G8_SCHED; G8_LDA(At, 1, 0); G8_STAGE(G8_SA(0, 1), A, brow + 128, t + 2);
    G8_WAIT_L(8); G8_BAR; G8_WAIT_L(0); G8_MMA(0, 0, At, B0); G8_BAR; G8_SCHED;
    G8_LDB(B1, 1, 1); G8_STAGE(G8_SB(1, 0), Bt, bcol, t + 3);
    G8_BAR; G8_WAIT_L(0); G8_MMA(0, 1, At, B1); G8_BAR;
    G8_LDA(At, 1, 1); G8_STAGE(G8_SA(1, 0), A, brow, t + 3);
    G8_BAR; G8_WAIT_L(0); G8_MMA(1, 0, At, B0); G8_BAR; G8_SCHED;
    G8_STAGE(G8_SB(1, 1), Bt, bcol + 128, t + 3);
    G8_WAIT_V(6); G8_BAR; G8_MMA(1, 1, At, B1); G8_BAR;
  }
  { G8_LDB(B0, 0, 0); G8_LDA(At, 0, 0); G8_STAGE(G8_SA(1, 1), A, brow + 128, nt - 1);
    G8_BAR; G8_WAIT_L(0); G8_MMA(0, 0, At, B0); G8_BAR;
    G8_LDB(B1, 0, 1); G8_BAR; G8_WAIT_L(0); G8_MMA(0, 1, At, B1); G8_BAR;
    G8_LDA(At, 0, 1); G8_WAIT_V(4); G8_BAR; G8_WAIT_L(0); G8_MMA(1, 0, At, B0); G8_MMA(1, 1, At, B1); G8_BAR; }
  { G8_LDB(B0, 1, 0); G8_LDA(At, 1, 0); G8_WAIT_V(2); G8_BAR; G8_WAIT_L(0); G8_MMA(0, 0, At, B0); G8_BAR;
    G8_LDB(B1, 1, 1); G8_WAIT_V(0); G8_BAR; G8_WAIT_L(0); G8_MMA(0, 1, At, B1); G8_BAR;
    G8_LDA(At, 1, 1); G8_BAR; G8_WAIT_L(0); G8_MMA(1, 0, At, B0); G8_MMA(1, 1, At, B1); G8_BAR; }
  if (wr == 0) G8_BAR;
#undef G8_SA
#undef G8_SB
#undef G8_STAGE
#undef G8_LDA
#undef G8_LDB
#undef G8_MMA
}

DI void p1_epilogue(const P& p, const h16* T, int m0, int n0, int nt, bool isP) {
  constexpr int TS = 136;
  const int tid = opaque_tid(), lane = tid & 63, w = tid >> 6;
  if (nt == 2) {
    for (int rr = w; rr < 256; rr += 8) {
      const int m = m0 + rr;
      const h2 v2 = *(const h2*)(T + rr * TS + 2 * lane);
      const float a = (float)v2[0], b = (float)v2[1];
      const float ss = wave_sum(a * a + b * b);
      const float rstd = rsqrtf(ss * (1.f / 128.f) + 1e-6f);
      const float2 g = *(const float2*)(p.kvn_g + 2 * lane);
      const float o0 = a * rstd * g.x, o1 = b * rstd * g.y;
      float* oc = isP ? p.out + OFF_P_CKV + (size_t)m * 128 : p.out + OFF_S_CKV + (size_t)(m - NP) * 128;
      *(float2*)(oc + 2 * lane) = make_float2(o0, o1);
      h2 o; o[0] = (h16)o0; o[1] = (h16)o1;
      *(h2*)(p.KM + (size_t)m * 160 + 2 * lane) = o;
    }
  } else if (nt >= 4 && nt <= 6) {
    epi_simple<1>(T, m0, p.GA, 512, n0 - ZC_GA, tid);
  } else if (nt >= 8 && nt <= 10) {
    epi_simple<2>(T, m0, p.QB, 512, n0 - ZC_QB, tid);
  } else if (nt >= 14 && nt <= 16) {
    epi_simple<0>(T, m0, p.QI, 512, n0 - ZC_QI, tid);
  } else if (nt >= 18 && nt <= 20) {
    epi_simple<1>(T, m0, p.GB, 512, n0 - ZC_GB, tid);
  } else {
#pragma unroll 2
    for (int it = 0; it < 8; ++it) {
      const int q = tid + NBLK_THREADS * it;
      const int row = q >> 4, ch = q & 15;
      const int col = n0 + ch * 8, m = m0 + row;
      const int ms = isP ? m : m - NP;
      const h8 v = *(const h8*)(T + row * TS + ch * 8);
      if (col < ZC_CKV) {
        *(h8*)(p.CQ + (size_t)m * 256 + col) = v;
        float ss = 0.f;
#pragma unroll
        for (int e = 0; e < 8; ++e) ss += (float)v[e] * (float)v[e];
        ss += __shfl_xor(ss, 1); ss += __shfl_xor(ss, 2); ss += __shfl_xor(ss, 4); ss += __shfl_xor(ss, 8);
        if (ch == 0) p.RQP[(size_t)m * 2 + nt] = ss;
      } else if (col < ZC_GA) {
        const int j0 = col - ZC_KPE;
        const bool hiHalf = j0 >= 16;
        const h8 u = *(const h8*)(T + row * TS + (hiHalf ? ch - 2 : ch + 2) * 8);
        const int ri = rope_idx(m) * 16 + (j0 & 15);
        const float4 c0 = *(const float4*)(p.ropeC + ri), c1 = *(const float4*)(p.ropeC + ri + 4);
        const float4 s0 = *(const float4*)(p.ropeS + ri), s1 = *(const float4*)(p.ropeS + ri + 4);
        const float cs[8] = {c0.x, c0.y, c0.z, c0.w, c1.x, c1.y, c1.z, c1.w};
        const float sn[8] = {s0.x, s0.y, s0.z, s0.w, s1.x, s1.y, s1.z, s1.w};
        float o[8];
        h8 oh;
#pragma unroll
        for (int e = 0; e < 8; ++e) {
          const float mine = (float)v[e], other = (float)u[e];
          o[e] = hiHalf ? (other * sn[e] + mine * cs[e]) : (mine * cs[e] - other * sn[e]);
          oh[e] = (h16)o[e];
        }
        float* oc = (isP ? p.out + OFF_P_KPE : p.out + OFF_S_KPE) + (size_t)ms * 32 + j0;
        *(float4*)oc = make_float4(o[0], o[1], o[2], o[3]);
        *(float4*)(oc + 4) = make_float4(o[4], o[5], o[6], o[7]);
        *(h8*)(p.KM + (size_t)m * 160 + 128 + j0) = oh;
      } else if (col < ZC_QB) {
        h8 o;
#pragma unroll
        for (int e = 0; e < 8; ++e) o[e] = (h16)silu((float)v[e]);
        *(h8*)(p.GA + (size_t)m * 512 + (col - ZC_GA)) = o;
      } else if (col < ZC_KB) {
        h8 o;
#pragma unroll
        for (int e = 0; e < 8; ++e) o[e] = (h16)((float)v[e] * QB_SCALE);
        *(h8*)(p.QB + (size_t)m * 512 + (col - ZC_QB)) = o;
      } else if (col < ZC_QI) {
        const bool isK = col < ZC_VB;
        const int c0 = col - (isK ? ZC_KB : ZC_VB);
        float* oc = (isK ? (isP ? p.out + OFF_P_K : p.out + OFF_S_K) : (isP ? p.out + OFF_P_V : p.out + OFF_S_V)) +
                    (size_t)ms * 128 + c0;
        *(float4*)oc = f4_lo(v);
        *(float4*)(oc + 4) = f4_hi(v);
        *(h8*)((isK ? p.KB : p.VB) + (size_t)m * 128 + c0) = v;
      } else if (col < ZC_KI) {
        *(h8*)(p.QI + (size_t)m * 512 + (col - ZC_QI)) = v;
      } else if (col < ZC_WI) {
        float* oc = (isP ? p.out + OFF_P_KIDX : p.out + OFF_S_KIDX) + (size_t)ms * 64 + (col - ZC_KI);
        *(float4*)oc = f4_lo(v);
        *(float4*)(oc + 4) = f4_hi(v);
        *(h8*)(p.KI + (size_t)m * 64 + (col - ZC_KI)) = v;
      } else if (col < ZC_GB) {
        float* oc = p.WI + (size_t)m * 8;
        const float4 a = f4_lo(v), b = f4_hi(v);
        *(float4*)oc = make_float4(a.x * WI_SCALE, a.y * WI_SCALE, a.z * WI_SCALE, a.w * WI_SCALE);
        *(float4*)(oc + 4) = make_float4(b.x * WI_SCALE, b.y * WI_SCALE, b.z * WI_SCALE, b.w * WI_SCALE);
      } else if (col < INW) {
        h8 o;
#pragma unroll
        for (int e = 0; e < 8; ++e) o[e] = (h16)silu((float)v[e]);
        *(h8*)(p.GB + (size_t)m * 512 + (col - ZC_GB)) = o;
      }
    }
  }
}

DI void phase1(const P& p, char* smem) {
  constexpr int TS = 136;
  h16* T = (h16*)smem;
  const int ntiles = 68 * 11;
  const int xcd = blockIdx.x & 7, lb = blockIdx.x >> 3, nlb = gridDim.x >> 3;
  const int per = (ntiles + 7) >> 3;
  const int tend = (xcd * per + per) < ntiles ? (xcd * per + per) : ntiles;
  for (int L = xcd * per + lb; L < tend; L += nlb) {
    const int pg = L / 44, rem = L - pg * 44;
    const int pn = rem >> 2, mt = pg * 4 + (rem & 3);
    const int m0 = mt * 256;
    const bool isP = mt < 64;
    f32x4 acc[2][2][4][2];
    gemm8_mainloop(p.hX, p.Wt_in, DM, m0, pn * 256, smem, acc);
    __syncthreads();
    const int tid = opaque_tid();
    const int wid = tid >> 6, lane = tid & 63, wr = wid >> 2, wc = wid & 3, fr = lane & 15, fq = lane >> 4;
#pragma unroll
    for (int bj = 0; bj < 2; ++bj) {
#pragma unroll
      for (int ai = 0; ai < 2; ++ai)
#pragma unroll
        for (int m = 0; m < 4; ++m)
#pragma unroll
          for (int n = 0; n < 2; ++n)
          {
            h4 o;
#pragma unroll
            for (int jj = 0; jj < 4; ++jj) o[jj] = (h16)acc[ai][bj][m][n][jj];
            *(h4*)(T + (ai * 128 + wr * 64 + m * 16 + fr) * TS + wc * 32 + n * 16 + fq * 4) = o;
          }
      __syncthreads();
      p1_epilogue(p, T, m0, pn * 256 + bj * 128, pn * 2 + bj, isP);
      __syncthreads();
    }
  }
}

DI size_t qm_index(int m, int hd, int d) {
  return ((((size_t)(m >> 5) * 8 + hd) * 10 + (d >> 4)) * 64 + (((d >> 3) & 1) * 32 + (m & 31))) * 8 + (d & 7);
}
DI void phase1b(const P& p, char* smem) {
  constexpr int TS = 136;
  h16* T = (h16*)smem;
  float* rq = (float*)(smem + 128 * 1024 - 2048);
  const int ntiles = 68 * 5;
  for (int tile = blockIdx.x; tile < ntiles; tile += gridDim.x) {
    const int mt = tile / 5, pn = tile % 5;
    const int m0 = mt * 256;
    f32x4 acc[2][2][4][2];
    gemm8_mainloop(p.CQ, p.Wq, 256, m0, pn * 256, smem, acc);
    __syncthreads();
    const int tid = opaque_tid();
    if (tid < 256) {
      const float2 pp = *(const float2*)(p.RQP + (size_t)(m0 + tid) * 2);
      rq[tid] = rsqrtf((pp.x + pp.y) * (1.f / 256.f) + 1e-6f) * QM_SCALE;
    }
    const int wid = tid >> 6, lane = tid & 63, wr = wid >> 2, wc = wid & 3, fr = lane & 15, fq = lane >> 4;
#pragma unroll
    for (int bj = 0; bj < 2; ++bj) {
      const int nt = pn * 2 + bj;
#pragma unroll
      for (int ai = 0; ai < 2; ++ai)
#pragma unroll
        for (int m = 0; m < 4; ++m)
#pragma unroll
          for (int n = 0; n < 2; ++n)
          {
            h4 o;
#pragma unroll
            for (int jj = 0; jj < 4; ++jj) o[jj] = (h16)acc[ai][bj][m][n][jj];
            *(h4*)(T + (ai * 128 + wr * 64 + m * 16 + fr) * TS + wc * 32 + n * 16 + fq * 4) = o;
          }
      __syncthreads();
#pragma unroll 2
      for (int it = 0; it < 8; ++it) {
        const int q = tid + NBLK_THREADS * it;
        const int row = q >> 4, ch = q & 15;
        const int m = m0 + row;
        const float sc = rq[row];
        const h8 v = *(const h8*)(T + row * TS + ch * 8);
        h8 o;
        int hd, d0;
        if (nt < 8) {
          hd = nt; d0 = ch * 8;
#pragma unroll
          for (int e = 0; e < 8; ++e) o[e] = (h16)((float)v[e] * sc);
        } else {
          hd = (nt - 8) * 4 + (ch >> 2);
          const int j0 = (ch & 3) * 8;
          d0 = 128 + j0;
          const bool hiHalf = j0 >= 16;
          const h8 u = *(const h8*)(T + row * TS + (hiHalf ? ch - 2 : ch + 2) * 8);
          const int ri = rope_idx(m) * 16 + (j0 & 15);
          const float4 c0 = *(const float4*)(p.ropeC + ri), c1 = *(const float4*)(p.ropeC + ri + 4);
          const float4 s0 = *(const float4*)(p.ropeS + ri), s1 = *(const float4*)(p.ropeS + ri + 4);
          const float cs[8] = {c0.x, c0.y, c0.z, c0.w, c1.x, c1.y, c1.z, c1.w};
          const float sn[8] = {s0.x, s0.y, s0.z, s0.w, s1.x, s1.y, s1.z, s1.w};
#pragma unroll
          for (int e = 0; e < 8; ++e) {
            const float mine = (float)v[e] * sc, other = (float)u[e] * sc;
            o[e] = (h16)(hiHalf ? (other * sn[e] + mine * cs[e]) : (mine * cs[e] - other * sn[e]));
          }
        }
        *(h8*)(p.QM + qm_index(m, hd, d0)) = o;
      }
      __syncthreads();
    }
  }
}

template <bool SAMPLE>
DI void mla_item(const P& p, int b, int tok0, int nkeys, char* smem, const int tid, unsigned* ctr, int& nxt) {
  constexpr int KS = 168;
  h16* sK = (h16*)smem;
  const int lane = tid & 63, w = tid >> 6;
  const int r = lane & 31, hh = lane >> 5;
  const int i16 = lane & 15, q4 = i16 >> 2, p4 = i16 & 3, blk = (lane >> 4) & 1;

  h8 qf[10];
  {
    const h16* qp = p.QM + ((size_t)((tok0 >> 5) * 8 + w) * 10 * 64 + lane) * 8;
#pragma unroll
    for (int t = 0; t < 10; ++t) qf[t] = *(const h8*)(qp + t * 512);
  }
  f16v O[4];
#pragma unroll
  for (int dt = 0; dt < 4; ++dt)
#pragma unroll
    for (int i = 0; i < 16; ++i) O[dt][i] = 0.f;
  float m = NEGBIG, l = 0.f;

  h8 sh[3];
  float4 sf[3][2];
  const int NT = (nkeys + 63) >> 6;

#define MLA_GLOAD(kt)                                                                                          \
  {                                                                                                            \
    _Pragma("unroll") for (int i = 0; i < 3; ++i) {                                                            \
      const int q = tid + NBLK_THREADS * i;                                                                    \
      const int row = q / 20, cc = q % 20;                                                                     \
      const int s = (kt) * 64 + row;                                                                           \
      if (q < 1280) {                                                                                          \
        if (!SAMPLE) {                                                                                         \
          sh[i] = *(const h8*)(p.KM + (size_t)(b * 2048 + s) * 160 + cc * 8);                                  \
        } else {                                                                                               \
          if (s < PAST) {                                                                                      \
            const float* src = (cc < 16) ? p.c_ckv + ((size_t)(b * PAST + s) * 128 + cc * 8)                   \
                                         : p.c_kpe + ((size_t)(b * PAST + s) * 32 + (cc - 16) * 8);            \
            sf[i][0] = *(const float4*)src; sf[i][1] = *(const float4*)(src + 4);                              \
          } else if (s < SKEYS) {                                                                              \
            sf[i][0] = __builtin_bit_cast(float4, *(const h8*)(p.KM + (size_t)(NP + b * 32 + (s - PAST)) * 160 + cc * 8)); \
          } else {                                                                                             \
            sf[i][0] = make_float4(0.f, 0.f, 0.f, 0.f);                                                        \
          }                                                                                                    \
        }                                                                                                      \
      }                                                                                                        \
    }                                                                                                          \
  }
#define MLA_SSTORE(kt, buf)                                                                                    \
  {                                                                                                            \
    _Pragma("unroll") for (int i = 0; i < 3; ++i) {                                                            \
      const int q = tid + NBLK_THREADS * i;                                                                    \
      const int row = q / 20, cc = q % 20;                                                                     \
      const int s = (kt) * 64 + row;                                                                           \
      if (q < 1280) {                                                                                          \
        h8 v;                                                                                                  \
        if (SAMPLE) v = (s < PAST) ? cvt8(sf[i][0], sf[i][1]) : __builtin_bit_cast(h8, sf[i][0]);              \
        else v = sh[i];                                                                                        \
        *(h8*)(sK + ((buf) * 64 + row) * KS + cc * 8) = v;                                                     \
      }                                                                                                        \
    }                                                                                                          \
  }

  MLA_GLOAD(0);
#pragma unroll
  for (int t = 0; t < 10; ++t) pin8(qf[t]);
  MLA_SSTORE(0, 0);
  __syncthreads();
  int buf = 0;
  for (int kt = 0; kt < NT; ++kt) {
    if (kt + 1 < NT) MLA_GLOAD(kt + 1);
    const bool two = (nkeys - kt * 64) > 32;
    const h16* kbase = sK + buf * 64 * KS;
    const h16* ka_ptr = kbase + r * KS + 8 * hh;
    const h16* vb_ptr = kbase + (4 * hh + q4) * KS + 16 * blk + 4 * p4;
    f16v S0, S1;
#pragma unroll
    for (int i = 0; i < 16; ++i) { S0[i] = 0.f; S1[i] = 0.f; }
    {
      h8 ka0[3], ka1[3];
#pragma unroll
      for (int t = 0; t < 3; ++t) {
        ka0[t] = *(const h8*)(ka_ptr + 16 * t);
        ka1[t] = *(const h8*)(ka_ptr + 32 * KS + 16 * t);
      }
#pragma unroll
      for (int t = 0; t < 10; ++t) {
        S0 = MFMA32(ka0[t % 3], qf[t], S0);
        S1 = MFMA32(ka1[t % 3], qf[t], S1);
        if (t + 3 < 10) {
          ka0[t % 3] = *(const h8*)(ka_ptr + 16 * (t + 3));
          ka1[t % 3] = *(const h8*)(ka_ptr + 32 * KS + 16 * (t + 3));
        }
      }
    }
    h8 vf[4];
#define MLA_VLOAD(f)                                                                   \
  {                                                                                    \
    const h16* vp = vb_ptr + ((((f) >> 3) * 32) + ((((f) >> 2) & 1) * 16)) * KS + 32 * ((f) & 3); \
    vf[(f) & 3] = cat8(trread(vp), trread(vp + 8 * KS));                               \
  }
#pragma unroll
    for (int f = 0; f < 4; ++f) MLA_VLOAD(f);
    if (!two) {
      asm volatile("" ::: "memory");
#pragma unroll
      for (int i = 0; i < 16; ++i) S1[i] = NEGBIG;
    }
    mfma_settle();
    float mx = max3f(S0[0], S0[1], S1[0]);
    mx = max3f(mx, S1[1], S0[2]);
#pragma unroll
    for (int i = 2; i < 15; ++i) mx = max3f(mx, S1[i], S0[i + 1]);
    mx = fmaxf(mx, S1[15]);
    mx = fmaxf(mx, __shfl_xor(mx, 32));
    if (__any(mx > m)) {
      const float mn = fmaxf(m, mx);
      const float alpha = fast_exp2(m - mn);
      m = mn;
      l *= alpha;
#pragma unroll
      for (int dt = 0; dt < 4; ++dt)
#pragma unroll
        for (int i = 0; i < 16; ++i) O[dt][i] *= alpha;
    }
    {
      const f2v m2 = {m, m};
      f2v rs2 = {0.f, 0.f};
#pragma unroll
      for (int i = 0; i < 16; i += 2) {
        f2v a = {S0[i], S0[i + 1]};
        f2v b = {S1[i], S1[i + 1]};
        a -= m2; b -= m2;
        a[0] = fast_exp2(a[0]); a[1] = fast_exp2(a[1]);
        b[0] = fast_exp2(b[0]); b[1] = fast_exp2(b[1]);
        rs2 += a; rs2 += b;
        S0[i] = a[0]; S0[i + 1] = a[1]; S1[i] = b[0]; S1[i + 1] = b[1];
      }
      l += rs2[0] + rs2[1];
    }
    h8 pb[4];
#pragma unroll
    for (int g = 0; g < 4; ++g)
#pragma unroll
      for (int jj = 0; jj < 8; ++jj) pb[g][jj] = (h16)((g < 2) ? S0[8 * (g & 1) + jj] : S1[8 * (g & 1) + jj]);
#pragma unroll
    for (int f = 0; f < 16; ++f) {
      O[f & 3] = MFMA32(vf[f & 3], pb[f >> 2], O[f & 3]);
      if (f + 4 < 16) MLA_VLOAD(f + 4);
    }
#undef MLA_VLOAD
    if (kt + 1 < NT) MLA_SSTORE(kt + 1, buf ^ 1);
    __syncthreads();
    buf ^= 1;
  }
#undef MLA_GLOAD
#undef MLA_SSTORE
  if (threadIdx.x == 0) nxt = (int)atomicAdd(ctr, 1u);
  const float inv = 1.f / (l + __shfl_xor(l, 32));
  f16v Y[2];
#pragma unroll
  for (int vt = 0; vt < 2; ++vt)
#pragma unroll
    for (int i = 0; i < 16; ++i) Y[vt][i] = 0.f;
#pragma unroll
  for (int dt = 0; dt < 4; ++dt) {
#pragma unroll
    for (int s = 0; s < 2; ++s) {
      h8 ob;
#pragma unroll
      for (int j = 0; j < 8; ++j) ob[j] = (h16)(O[dt][8 * s + j] * inv);
#pragma unroll
      for (int vt = 0; vt < 2; ++vt) {
        const h8 a = *(const h8*)(p.Wuv + ((size_t)((((w * 2 + vt) * 4 + dt) * 2 + s) * 64 + lane)) * 8);
        Y[vt] = MFMA32(a, ob, Y[vt]);
      }
    }
  }
  h16* Yt = (h16*)smem + w * (32 * 72);
#pragma unroll
  for (int vt = 0; vt < 2; ++vt) {
#pragma unroll
    for (int g4 = 0; g4 < 4; ++g4) {
      h4 o;
#pragma unroll
      for (int j = 0; j < 4; ++j) o[j] = (h16)Y[vt][4 * g4 + j];
      *(h4*)(Yt + r * 72 + 32 * vt + 8 * g4 + 4 * hh) = o;
    }
  }
  wavebar();
#pragma unroll
  for (int i = 0; i < 4; ++i) {
    const int q = lane + 64 * i;
    const int row = q >> 3, ch = q & 7;
    const h8 y = *(const h8*)(Yt + row * 72 + ch * 8);
    const h8 ga = *(const h8*)(p.GA + (size_t)(tok0 + row) * 512 + w * 64 + ch * 8);
    h8 o;
#pragma unroll
    for (int j = 0; j < 8; ++j) o[j] = (h16)((float)y[j] * (float)ga[j]);
    *(h8*)(p.mix + (size_t)(tok0 + row) * 1024 + w * 64 + ch * 8) = o;
  }
  __syncthreads();
}

#define SEL_CAP 256
DI int sel_bin(float v, float lo, float scale, bool degen) {
  if (degen) return v > lo ? 1023 : 0;
  int b = (int)((v - lo) * scale);
  return b > 1023 ? 1023 : b;
}
template <int NR, int NH>
DI void wave_select(const float* sc, int N, unsigned* maskrow, unsigned* hist, float* candv, int* candi, int lane,
                 float (&vpre)[NR], const float* scnext) {
  const int nwords = N >> 5;
  if (lane == 0) maskrow[nwords] = 0u;
  if (N <= 256) {
    for (int wd = lane; wd < nwords; wd += 64) maskrow[wd] = 0xffffffffu;
    return;
  }
  float v[NR];
#define SEL_LOAD(hf)                                                     \
  {                                                                      \
    _Pragma("unroll") for (int i = 0; i < NR; ++i) {                     \
      const int e = 64 * ((hf) * NR + i) + lane;                         \
      v[i] = (e < N) ? sc[e] : -INFINITY;                                \
    }                                                                    \
  }
  if (NH == 1) {
#pragma unroll
    for (int i = 0; i < NR; ++i) v[i] = vpre[i];
    if (scnext) {
#pragma unroll
      for (int i = 0; i < NR; ++i) {
        const int e = 64 * i + lane;
        vpre[i] = (e < N) ? scnext[e] : -INFINITY;
      }
    }
  }
  float lo = INFINITY, hi = -INFINITY;
#pragma unroll 1
  for (int hf = 0; hf < NH; ++hf) {
    if (NH > 1) SEL_LOAD(hf);
#pragma unroll
    for (int i = 0; i < NR; ++i) {
      hi = fmaxf(hi, v[i]);
      lo = fminf(lo, (v[i] == -INFINITY) ? INFINITY : v[i]);
    }
  }
  lo = wave_min(lo); hi = wave_max(hi);
  int need = 256;
  int T = 0, above = 0;
  float scale = 0.f;
  bool degen = false;
  bool rankmode = false;
  bool first = true;
  for (int iter = 0; iter < 64; ++iter) {
    if (!(lo < hi)) break;
    scale = 1024.f / (hi - lo);
    degen = !(scale < 1.0e37f);
    for (int i = lane; i < 1024; i += 64) hist[i] = 0u;
    wavebar();
    if (first && !degen) {
#pragma unroll 1
      for (int hf = 0; hf < NH; ++hf) {
        if (NH > 1) SEL_LOAD(hf);
#pragma unroll
        for (int i = 0; i < NR; ++i) {
          const int eb = 64 * (hf * NR + i);
          if (eb < N) {
            int bn = (int)((v[i] - lo) * scale);
            bn = bn > 1023 ? 1023 : bn;
            if (eb + 64 <= N) atomicAdd(&hist[bn], 1u);
            else if (eb + lane < N) atomicAdd(&hist[bn], 1u);
          }
        }
      }
    } else {
#pragma unroll 1
      for (int hf = 0; hf < NH; ++hf) {
        if (NH > 1) SEL_LOAD(hf);
#pragma unroll
        for (int i = 0; i < NR; ++i) {
          if (v[i] >= lo && v[i] <= hi) atomicAdd(&hist[sel_bin(v[i], lo, scale, degen)], 1u);
          if ((i & 7) == 7) __builtin_amdgcn_sched_barrier(0);
        }
      }
    }
    wavebar();
    unsigned ssum = 0;
#pragma unroll
    for (int i = 0; i < 16; ++i) ssum += hist[16 * lane + i];
    unsigned x = ssum;
#pragma unroll
    for (int off = 1; off < 64; off <<= 1) {
      const unsigned y = __shfl_down(x, off);
      if (lane + off < 64) x += y;
    }
    const unsigned sufx = x - ssum;
    const bool cross = (sufx < (unsigned)need) && (x >= (unsigned)need);
    int myT = 0, myAbove = 0, myC = 0;
    if (cross) {
      unsigned run = sufx;
      for (int i = 15; i >= 0; --i) {
        const unsigned c = hist[16 * lane + i];
        if (run + c >= (unsigned)need) { myT = 16 * lane + i; myAbove = (int)run; myC = (int)c; break; }
        run += c;
      }
    }
    const unsigned long long bal = __ballot(cross);
    const int src = bal ? (int)__builtin_ctzll(bal) : 0;
    T = __shfl(myT, src); above = __shfl(myAbove, src);
    const int cT = __shfl(myC, src);
    if (cT <= SEL_CAP) { rankmode = true; break; }
    first = false;
    need -= above;
    float nlo = INFINITY, nhi = -INFINITY;
#pragma unroll 1
    for (int hf = 0; hf < NH; ++hf) {
      if (NH > 1) SEL_LOAD(hf);
#pragma unroll
      for (int i = 0; i < NR; ++i) {
        if (v[i] >= lo && v[i] <= hi && sel_bin(v[i], lo, scale, degen) == T) { nlo = fminf(nlo, v[i]); nhi = fmaxf(nhi, v[i]); }
      }
    }
    lo = wave_min(nlo); hi = wave_max(nhi);
  }
  const int pick = rankmode ? need - above : need;
  int running = 0;
  const unsigned long long ltmask = (lane == 0) ? 0ull : (~0ull >> (64 - lane));
  const bool fastfinal = rankmode && first && !degen;
#pragma unroll 1
  for (int hf = 0; hf < NH; ++hf) {
    if (NH > 1) SEL_LOAD(hf);
    int mlo = 0, mhi = 0;
#pragma unroll
    for (int i = 0; i < NR; ++i) {
      const int eb = 64 * (hf * NR + i);
      if (eb < N) {
        const float vv = v[i];
        unsigned long long bs, bc;
        if (fastfinal) {
          int bn = (int)((vv - lo) * scale);
          bn = bn > 1023 ? 1023 : bn;
          bs = __ballot(bn > T);
          bc = __ballot(bn == T);
        } else {
          bool s = vv > hi;
          bool c;
          if (rankmode) {
            const bool inr = (vv >= lo && vv <= hi);
            const int bn = inr ? sel_bin(vv, lo, scale, degen) : -1;
            s = s || (bn > T);
            c = (bn == T);
          } else {
            c = (vv == hi);
          }
          bc = __ballot(c);
          if (!rankmode) {
            const int pos = running + __popcll(bc & ltmask);
            s = s || (c && pos < pick);
          }
          bs = __ballot(s);
        }
        if (bc != 0ull) {
          if (rankmode) {
            const bool c = (bc >> lane) & 1ull;
            const int pos = running + __popcll(bc & ltmask);
            if (c) { candv[pos] = vv; candi[pos] = eb + lane; }
          }
          running += __popcll(bc);
        }
        if (lane == i) { mlo = (int)(unsigned)bs; mhi = (int)(unsigned)(bs >> 32); }
      }
      if ((i & 7) == 7) __builtin_amdgcn_sched_barrier(0);
    }
    {
      const int wd = 2 * (hf * NR + lane);
      if (lane < NR && wd < nwords) {
        maskrow[wd] = (unsigned)mlo;
        if (wd + 1 < nwords) maskrow[wd + 1] = (unsigned)mhi;
      }
    }
  }
#undef SEL_LOAD
  if (rankmode) {
    wavebar();
    const int ncand = running;
    for (int i = lane; i < ncand; i += 64) {
      const float vi = candv[i];
      const int ii = candi[i];
      int rank = 0;
      for (int j = 0; j < ncand; ++j) {
        const float vj = candv[j];
        const int ij = candi[j];
        rank += ((vj > vi) || (vj == vi && ij < ii)) ? 1 : 0;
      }
      if (rank < pick) atomicOr(&maskrow[ii >> 5], 1u << (ii & 31));
    }
  }
  wavebar();
}

template <bool SAMPLE>
DI void dsa_item(const P& p, int b, int tok0, int qpos0, int nkeys, float* sc, int scs,
                         char* smem, const int tid, unsigned* ctr, int& nxt) {
  const int lane = tid & 63, w = tid >> 6;
  const int r = lane & 31, hh = lane >> 5;
  const int NT = (nkeys + 63) >> 6;
  unsigned* sMask = (unsigned*)(smem + 73728);
  float* sBias = (float*)(smem + 73728 + 32 * MASK_W * 4);
  if (tid < 256) sBias[tid] = p.rel_bias[tid] * LOG2E;
  {
    constexpr int LS = 72;
    h16* sKI = (h16*)smem;
    const int NTA = (nkeys + 127) >> 7;
    h8 ai[4];
    {
      const int aq = ((r >> 2) & 1) * 2 + (r >> 4), ah = (r & 3) + 4 * ((r >> 3) & 1);
      const h16* qp = p.QI + ((size_t)(tok0 + 4 * w + aq) * 8 + ah) * 64 + 8 * hh;
#pragma unroll
      for (int t = 0; t < 4; ++t) ai[t] = *(const h8*)(qp + 16 * t);
    }
    float w16[16];
#pragma unroll
    for (int i = 0; i < 16; ++i)
      w16[i] = p.WI[(size_t)(tok0 + 4 * w + 2 * hh + (i >> 3)) * 8 + (i & 3) + 4 * ((i >> 2) & 1)];
    h8 sh[2];
    float4 sf[2][2];
#define KI_GLOAD(kt)                                                                                  \
  {                                                                                                   \
    _Pragma("unroll") for (int i = 0; i < 2; ++i) {                                                   \
      const int q = tid + NBLK_THREADS * i;                                                           \
      const int s = (kt) * 128 + (q >> 3), lcc = q & 7;                                               \
      if (!SAMPLE) {                                                                                  \
        sh[i] = (s < nkeys) ? *(const h8*)(p.KI + (size_t)(b * 2048 + s) * 64 + lcc * 8) : zero8();   \
      } else if (s < PAST) {                                                                          \
        const float* src = p.c_kidx + ((size_t)(b * PAST + s) * 64 + lcc * 8);                        \
        sf[i][0] = *(const float4*)src; sf[i][1] = *(const float4*)(src + 4);                         \
      } else if (s < SKEYS) {                                                                         \
        sf[i][0] = __builtin_bit_cast(float4, *(const h8*)(p.KI + (size_t)(NP + b * 32 + (s - PAST)) * 64 + lcc * 8)); \
      } else {                                                                                        \
        sf[i][0] = make_float4(0.f, 0.f, 0.f, 0.f);                                                   \
      }                                                                                               \
    }                                                                                                 \
  }
#define KI_SSTORE(kt, buf)                                                                            \
  {                                                                                                   \
    _Pragma("unroll") for (int i = 0; i < 2; ++i) {                                                   \
      const int q = tid + NBLK_THREADS * i;                                                           \
      const int s = (kt) * 128 + (q >> 3), lcc = q & 7;                                               \
      h8 v;                                                                                           \
      if (SAMPLE) v = (s < PAST) ? cvt8(sf[i][0], sf[i][1]) : __builtin_bit_cast(h8, sf[i][0]);       \
      else v = sh[i];                                                                                 \
      *(h8*)(sKI + ((buf) * 128 + (q >> 3)) * LS + lcc * 8) = v;                                      \
    }                                                                                                 \
  }
    KI_GLOAD(0);
#pragma unroll
    for (int t = 0; t < 4; ++t) pin8(ai[t]);
#pragma unroll
    for (int i = 0; i < 16; ++i) pinf(w16[i]);
    KI_SSTORE(0, 0);
    __syncthreads();
    int buf = 0;
    for (int kt = 0; kt < NTA; ++kt) {
      if (kt + 1 < NTA) KI_GLOAD(kt + 1);
      const h16* kbase = sKI + buf * 128 * LS + r * LS + 8 * hh;
#pragma unroll
      for (int sub = 0; sub < 4; ++sub) {
        const int key0 = kt * 128 + 32 * sub;
        if (key0 < nkeys) {
          f16v D;
#pragma unroll
          for (int i = 0; i < 16; ++i) D[i] = 0.f;
#pragma unroll
          for (int t = 0; t < 4; ++t) {
            const h8 bf = *(const h8*)(kbase + 32 * sub * LS + 16 * t);
            D = MFMA32(ai[t], bf, D);
          }
          float ps0 = 0.f, ps1 = 0.f;
#pragma unroll
          for (int i = 0; i < 8; ++i) {
            ps0 = fmaf(fmaxf(D[i], 0.f), w16[i], ps0);
            ps1 = fmaf(fmaxf(D[8 + i], 0.f), w16[8 + i], ps1);
          }
          float* so = sc + (size_t)(4 * w + 2 * hh) * scs + key0 + r;
          so[0] = ps0;
          so[scs] = ps1;
        }
      }
      if (kt + 1 < NTA) KI_SSTORE(kt + 1, buf ^ 1);
      __syncthreads();
      buf ^= 1;
    }
#undef KI_GLOAD
#undef KI_SSTORE
  }
    constexpr int LS = 136;
    h16* sKb = (h16*)smem;
    h16* sVb = sKb + 2 * 64 * LS;
    const int kv = w >> 2, ql = 8 * (w & 3) + (r >> 2), g = r & 3, head = 4 * kv + g;
    const int i16 = lane & 15, q4 = i16 >> 2, p4 = i16 & 3, blk = (lane >> 4) & 1;
    const int tq = tok0 + ql;
    const int pq = qpos0 + ql;
    h8 qf[4];
#define DSA_QLOAD                                                                  \
    {                                                                              \
      const h16* qp = p.QB + (size_t)tq * 512 + head * 64 + 8 * hh;                \
      _Pragma("unroll") for (int t = 0; t < 4; ++t) qf[t] = *(const h8*)(qp + 16 * t); \
    }
    if (!SAMPLE) DSA_QLOAD;
    h8 sh[4];
    float4 sf[4][2];
#define KV_GLOAD(kt)                                                                                   \
  {                                                                                                    \
    _Pragma("unroll") for (int i = 0; i < 4; ++i) {                                                    \
      const int q = tid + NBLK_THREADS * i;                                                            \
      const int row = q >> 5, cc = q & 31, c16 = cc & 15;                                              \
      const int s = (kt) * 64 + row;                                                                   \
      if (!SAMPLE) {                                                                                   \
        sh[i] = *(const h8*)(((cc < 16) ? p.KB : p.VB) + (size_t)(b * 2048 + s) * 128 + c16 * 8);      \
      } else if (s < PAST) {                                                                           \
        const float* src = ((cc < 16) ? p.c_k : p.c_v) + ((size_t)(b * PAST + s) * 128 + c16 * 8);     \
        sf[i][0] = *(const float4*)src; sf[i][1] = *(const float4*)(src + 4);                          \
      } else if (s < SKEYS) {                                                                          \
        sf[i][0] = __builtin_bit_cast(float4, *(const h8*)(((cc < 16) ? p.KB : p.VB) + (size_t)(NP + b * 32 + (s - PAST)) * 128 + c16 * 8)); \
      } else {                                                                                         \
        sf[i][0] = make_float4(0.f, 0.f, 0.f, 0.f);                                                    \
      }                                                                                                \
    }                                                                                                  \
  }
#define KV_SSTORE(kt, buf)                                                                             \
  {                                                                                                    \
    _Pragma("unroll") for (int i = 0; i < 4; ++i) {                                                    \
      const int q = tid + NBLK_THREADS * i;                                                            \
      const int row = q >> 5, cc = q & 31, c16 = cc & 15;                                              \
      const int s = (kt) * 64 + row;                                                                   \
      h8 v;                                                                                            \
      if (SAMPLE) v = (s < PAST) ? cvt8(sf[i][0], sf[i][1]) : __builtin_bit_cast(h8, sf[i][0]);        \
      else v = sh[i];                                                                                  \
      *(h8*)(((cc < 16) ? sKb : sVb) + ((buf) * 64 + row) * LS + c16 * 8) = v;                         \
    }                                                                                                  \
  }
    if (!SAMPLE) KV_GLOAD(0);
  __syncthreads();
  {
    unsigned* hist = (unsigned*)(smem + w * 8192);
    float* candv = (float*)(smem + w * 8192 + 4096);
    int* candi = (int*)(smem + w * 8192 + 4096 + 1024);
    constexpr int SNR = SAMPLE ? 33 : 32;
    float vpre[SNR];
    if (!SAMPLE && nkeys > 256) {
#pragma unroll
      for (int i = 0; i < SNR; ++i) {
        const int e = 64 * i + lane;
        vpre[i] = (e < nkeys) ? sc[(size_t)(4 * w) * scs + e] : -INFINITY;
      }
    } else {
#pragma unroll
      for (int i = 0; i < SNR; ++i) vpre[i] = 0.f;
    }
#pragma unroll 1
    for (int qw = 0; qw < 4; ++qw) {
      const int ql = 4 * w + qw;
      wave_select<SNR, SAMPLE ? 2 : 1>(sc + (size_t)ql * scs, nkeys, sMask + ql * MASK_W, hist, candv, candi, lane, vpre,
                                      (qw < 3) ? sc + (size_t)(ql + 1) * scs : (const float*)nullptr);
    }
  }
  __syncthreads();
  {
    const float bias_far = sBias[15 * 8 + head];
    f16v O[2];
#pragma unroll
    for (int dt = 0; dt < 2; ++dt)
#pragma unroll
      for (int i = 0; i < 16; ++i) O[dt][i] = 0.f;
    float m = -1.0e29f, l = 0.f;
    if (SAMPLE) { DSA_QLOAD; KV_GLOAD(0); }
#undef DSA_QLOAD
#pragma unroll
    for (int t = 0; t < 4; ++t) pin8(qf[t]);
    KV_SSTORE(0, 0);
    __syncthreads();
    int buf = 0;
    for (int kt = 0; kt < NT; ++kt) {
      if (kt + 1 < NT) KV_GLOAD(kt + 1);
      const h16* ka_ptr = sKb + buf * 64 * LS + 64 * kv + r * LS + 8 * hh;
      const h16* vb_ptr = sVb + buf * 64 * LS + 64 * kv + (4 * hh + q4) * LS + 16 * blk + 4 * p4;
      const bool nearb = (qpos0 - (kt * 64 + 63)) < 91;
      const unsigned mw0 = sMask[ql * MASK_W + kt * 2] >> (4 * hh);
      const unsigned mw1 = sMask[ql * MASK_W + kt * 2 + 1] >> (4 * hh);
      f16v S0, S1;
      if (!nearb) {
        const int bb = __float_as_int(bias_far), nb = __float_as_int(NEGBIG);
#pragma unroll
        for (int i = 0; i < 16; ++i) {
          const int t0 = __builtin_amdgcn_sbfe((int)mw0, (i & 3) + 8 * (i >> 2), 1);
          const int t1 = __builtin_amdgcn_sbfe((int)mw1, (i & 3) + 8 * (i >> 2), 1);
          S0[i] = __int_as_float((t0 & bb) | (~t0 & nb));
          S1[i] = __int_as_float((t1 & bb) | (~t1 & nb));
        }
      } else {
#pragma unroll
        for (int ks = 0; ks < 2; ++ks) {
#pragma unroll
          for (int i = 0; i < 16; ++i) {
            const int pk = kt * 64 + 32 * ks + crow(i, hh);
            const int rel = pk - pq;
            const int n = rel < 0 ? -rel : rel;
            int bk = n;
            if (n >= 8)
              bk = 8 + (n >= 12) + (n >= 16) + (n >= 23) + (n >= 32) + (n >= 46) + (n >= 64) + (n >= 91);
            if (rel > 0) bk += 16;
            const bool sel = ((ks ? mw1 : mw0) >> ((i & 3) + 8 * (i >> 2))) & 1u;
            const float v = sel ? sBias[bk * 8 + head] : NEGBIG;
            if (ks) S1[i] = v; else S0[i] = v;
          }
        }
      }
      {
        h8 ka0[2], ka1[2];
#pragma unroll
        for (int t = 0; t < 2; ++t) {
          ka0[t] = *(const h8*)(ka_ptr + 16 * t);
          ka1[t] = *(const h8*)(ka_ptr + 32 * LS + 16 * t);
        }
#pragma unroll
        for (int t = 0; t < 4; ++t) {
          S0 = MFMA32(ka0[t & 1], qf[t], S0);
          S1 = MFMA32(ka1[t & 1], qf[t], S1);
          if (t + 2 < 4) {
            ka0[t & 1] = *(const h8*)(ka_ptr + 16 * (t + 2));
            ka1[t & 1] = *(const h8*)(ka_ptr + 32 * LS + 16 * (t + 2));
          }
        }
      }
      h8 vf[4];
#define DSA_VLOAD(f)                                                                              \
  {                                                                                               \
    const h16* vp = vb_ptr + ((((f) >> 2) * 32) + ((((f) >> 1) & 1) * 16)) * LS + 32 * ((f) & 1); \
    vf[(f) & 3] = cat8(trread(vp), trread(vp + 8 * LS));                                          \
  }
#pragma unroll
      for (int f = 0; f < 4; ++f) DSA_VLOAD(f);
      mfma_settle();
      float mx = max3f(S0[0], S0[1], S1[0]);
      mx = max3f(mx, S1[1], S0[2]);
#pragma unroll
      for (int i = 2; i < 15; ++i) mx = max3f(mx, S1[i], S0[i + 1]);
      mx = fmaxf(mx, S1[15]);
      mx = fmaxf(mx, __shfl_xor(mx, 32));
      if (__any(mx > m)) {
        const float mn = fmaxf(m, mx);
        const float alpha = fast_exp2(m - mn);
        m = mn;
        l *= alpha;
#pragma unroll
        for (int dt = 0; dt < 2; ++dt)
#pragma unroll
          for (int i = 0; i < 16; ++i) O[dt][i] *= alpha;
      }
      {
        const f2v m2 = {m, m};
        f2v rs2 = {0.f, 0.f};
#pragma unroll
        for (int i = 0; i < 16; i += 2) {
          f2v a = {S0[i], S0[i + 1]};
          f2v c = {S1[i], S1[i + 1]};
          a -= m2; c -= m2;
          a[0] = fast_exp2(a[0]); a[1] = fast_exp2(a[1]);
          c[0] = fast_exp2(c[0]); c[1] = fast_exp2(c[1]);
          rs2 += a; rs2 += c;
          S0[i] = a[0]; S0[i + 1] = a[1]; S1[i] = c[0]; S1[i + 1] = c[1];
        }
        l += rs2[0] + rs2[1];
      }
      h8 pb[4];
#pragma unroll
      for (int gg = 0; gg < 4; ++gg)
#pragma unroll
        for (int jj = 0; jj < 8; ++jj) pb[gg][jj] = (h16)((gg < 2) ? S0[8 * (gg & 1) + jj] : S1[8 * (gg & 1) + jj]);
#pragma unroll
      for (int f = 0; f < 8; ++f) {
        O[f & 1] = MFMA32(vf[f & 3], pb[f >> 1], O[f & 1]);
        if (f + 4 < 8) DSA_VLOAD(f + 4);
      }
#undef DSA_VLOAD
      if (kt + 1 < NT) KV_SSTORE(kt + 1, buf ^ 1);
      __syncthreads();
      buf ^= 1;
    }
#undef KV_GLOAD
#undef KV_SSTORE
    if (threadIdx.x == 0) nxt = (int)atomicAdd(ctr, 1u);
    const float inv = 1.f / (l + __shfl_xor(l, 32));
    h16* Ot = (h16*)smem + w * (8 * 264);
    {
      const int q8 = r >> 2;
#pragma unroll
      for (int dt = 0; dt < 2; ++dt) {
#pragma unroll
        for (int g4 = 0; g4 < 4; ++g4) {
          h4 o;
#pragma unroll
          for (int j = 0; j < 4; ++j) o[j] = (h16)(O[dt][4 * g4 + j] * inv);
          *(h4*)(Ot + q8 * 264 + g * 64 + 32 * dt + 8 * g4 + 4 * hh) = o;
        }
      }
    }
    wavebar();
#pragma unroll
    for (int i = 0; i < 4; ++i) {
      const int q = lane + 64 * i;
      const int row = q >> 5, ch = q & 31;
      const int tk = tok0 + 8 * (w & 3) + row;
      const h8 y = *(const h8*)(Ot + row * 264 + ch * 8);
      const h8 gb = *(const h8*)(p.GB + (size_t)tk * 512 + kv * 256 + ch * 8);
      h8 o;
#pragma unroll
      for (int j = 0; j < 8; ++j) o[j] = (h16)((float)y[j] * (float)gb[j]);
      *(h8*)(p.mix + (size_t)tk * 1024 + 512 + kv * 256 + ch * 8) = o;
    }
  }
  __syncthreads();
}

#define ITEMS_PER_Q 136
DI void phase2(const P& p, char* smem, int cidx = 0) {
  volatile int& s_item = *(volatile int*)(smem + SMEM_BYTES - 16);
  const int xq = blockIdx.x & 7;
  unsigned* ctr = &p.counters[cidx * 8 + xq];
  if (threadIdx.x == 0) s_item = (int)atomicAdd(ctr, 1u);
  __syncthreads();
  int item = s_item;
  while (item < ITEMS_PER_Q) {
    int nxt = 0;
    const int tid = opaque_tid();
    if (item < 4) {
      const int b = xq + 8 * item;
      mla_item<true>(p, b, NP + b * 32, SKEYS, smem, tid, ctr, nxt);
    } else if (item < 8) {
      const int b = xq + 8 * (item - 4);
      dsa_item<true>(p, b, NP + b * 32, PAST, SKEYS, p.scS + (size_t)b * 32 * SC_STRIDE_S, SC_STRIDE_S, smem, tid, ctr, nxt);
    } else {
      const int k = item - 8;
      const int kind = k & 1, sub = (k >> 1) & 1, b = xq, c = 31 - (k >> 2);
      const int tok0 = b * 2048 + c * 64 + sub * 32;
      const int nkeys = 64 * (c + 1);
      if (kind == 0) mla_item<false>(p, b, tok0, nkeys, smem, tid, ctr, nxt);
      else dsa_item<false>(p, b, tok0, c * 64 + sub * 32, nkeys, p.scP + (size_t)blockIdx.x * 32 * SC_STRIDE_P,
                           SC_STRIDE_P, smem, tid, ctr, nxt);
    }
    if (threadIdx.x == 0) s_item = nxt;
    __syncthreads();
    item = s_item;
    __syncthreads();
  }
}

template <int BM>
DI void p3_epilogue(const P& p, const h16* T, int m0, int n0) {
  constexpr int TS = 136;
  const int tid = opaque_tid();
  constexpr int NIT = BM / 32;
  float4 x0[NIT], x1[NIT];
#pragma unroll
  for (int it = 0; it < NIT; ++it) {
    const int q = tid + NBLK_THREADS * it;
    const int m = m0 + (q >> 4), n = n0 + (q & 15) * 8;
    const float* xr = (m < NP ? p.x_p + (size_t)m * DM : p.x_s + (size_t)(m - NP) * DM) + n;
    x0[it] = *(const float4*)xr; x1[it] = *(const float4*)(xr + 4);
  }
#pragma unroll
  for (int it = 0; it < NIT; ++it) {
    const int q = tid + NBLK_THREADS * it;
    const int row = q >> 4, ch = q & 15;
    const int m = m0 + row, n = n0 + ch * 8;
    const h8 v = *(const h8*)(T + row * TS + ch * 8);
    h8 o;
    o[0] = (h16)(x0[it].x + (float)v[0]); o[1] = (h16)(x0[it].y + (float)v[1]);
    o[2] = (h16)(x0[it].z + (float)v[2]); o[3] = (h16)(x0[it].w + (float)v[3]);
    o[4] = (h16)(x1[it].x + (float)v[4]); o[5] = (h16)(x1[it].y + (float)v[5]);
    o[6] = (h16)(x1[it].z + (float)v[6]); o[7] = (h16)(x1[it].w + (float)v[7]);
    *(h8*)(p.XN + (size_t)m * DM + n) = o;
  }
}
DI void phase3(const P& p, char* smem) {
  constexpr int TS = 136;
  h16* T = (h16*)smem;
  for (int tile = blockIdx.x; tile < 256; tile += gridDim.x) {
    const int xcd = tile & 7, idx = tile >> 3;
    const int mt = xcd * 8 + (idx >> 2), pn = idx & 3;
    const int m0 = mt * 256;
    f32x4 acc[2][2][4][2];
    gemm8_mainloop(p.mix, p.Wt_out, DM, m0, pn * 256, smem, acc);
    __syncthreads();
    const int tid = opaque_tid();
    const int wid = tid >> 6, lane = tid & 63, wr = wid >> 2, wc = wid & 3, fr = lane & 15, fq = lane >> 4;
#pragma unroll
    for (int bj = 0; bj < 2; ++bj) {
#pragma unroll
      for (int ai = 0; ai < 2; ++ai)
#pragma unroll
        for (int m = 0; m < 4; ++m)
#pragma unroll
          for (int n = 0; n < 2; ++n)
          {
            h4 o;
#pragma unroll
            for (int jj = 0; jj < 4; ++jj) o[jj] = (h16)acc[ai][bj][m][n][jj];
            *(h4*)(T + (ai * 128 + wr * 64 + m * 16 + fr) * TS + wc * 32 + n * 16 + fq * 4) = o;
          }
      __syncthreads();
      p3_epilogue<256>(p, T, m0, pn * 256 + bj * 128);
      __syncthreads();
    }
  }
  for (int tile = blockIdx.x; tile < 128; tile += gridDim.x) {
    const int m0 = NP + (tile >> 3) * 64, n0 = (tile & 7) * 128;
    gemm_tile<64, 128, 2, 4>(p.mix, 1024, p.Wt_out, 1024, 1024, m0, n0, smem);
    p3_epilogue<64>(p, T, m0, n0);
    __syncthreads();
  }
}

DI void phase4(const P& p) {
  const int tid = opaque_tid(), lane = tid & 63, w = tid >> 6;
  const int gw = blockIdx.x * 8 + w, nw = gridDim.x * 8;
  for (int row0 = gw * 4; row0 < NTOK; row0 += nw * 4) {
    h4 v[4][4];
    float ss[4];
#pragma unroll
    for (int rr = 0; rr < 4; ++rr)
#pragma unroll
      for (int k = 0; k < 4; ++k) v[rr][k] = *(const h4*)(p.XN + (size_t)(row0 + rr) * DM + 4 * lane + 256 * k);
#pragma unroll
    for (int rr = 0; rr < 4; ++rr) {
      float a = 0.f;
#pragma unroll
      for (int k = 0; k < 4; ++k)
#pragma unroll
        for (int e = 0; e < 4; ++e) a += (float)v[rr][k][e] * (float)v[rr][k][e];
      ss[rr] = a;
    }
#pragma unroll
    for (int off = 32; off > 0; off >>= 1) {
#pragma unroll
      for (int rr = 0; rr < 4; ++rr) ss[rr] += __shfl_xor(ss[rr], off);
    }
    float4 g[4];
#pragma unroll
    for (int k = 0; k < 4; ++k) g[k] = *(const float4*)(p.fn_g + 4 * lane + 256 * k);
#pragma unroll
    for (int rr = 0; rr < 4; ++rr) {
      const float rstd = rsqrtf(ss[rr] * (1.f / 1024.f) + 1e-6f);
      float* o = p.out + (size_t)(row0 + rr) * DM;
#pragma unroll
      for (int k = 0; k < 4; ++k)
        *(float4*)(o + 4 * lane + 256 * k) = make_float4((float)v[rr][k][0] * rstd * g[k].x, (float)v[rr][k][1] * rstd * g[k].y,
                                                         (float)v[rr][k][2] * rstd * g[k].z, (float)v[rr][k][3] * rstd * g[k].w);
    }
  }
}

__global__ void __launch_bounds__(NBLK_THREADS) mega_kernel(P p) {
  __shared__ __attribute__((aligned(16))) char smem[SMEM_BYTES];
  XBar xb;
  xb.w = p.counters;
  xb.x = (unsigned)__builtin_amdgcn_s_getreg((3 << 11) | 20) & 0xFu;
  xb.nloc = 0u; xb.nx = 0u;
  if (threadIdx.x == 0) __hip_atomic_fetch_add(&xb.w[XB_CNT(xb.x)], 1u, __ATOMIC_RELAXED, __HIP_MEMORY_SCOPE_AGENT);
  phase0(p, smem);
  xcd_barrier(xb, 1u, smem);
  phase1(p, smem);
  xcd_barrier(xb, 2u, smem);
  phase1b(p, smem);
  xcd_barrier(xb, 3u, smem);
  phase2(p, smem);
  xcd_barrier(xb, 4u, smem);
  phase3(p, smem);
  xcd_barrier(xb, 5u, smem);
  phase4(p);
}

extern "C" void kernel_launch(void* const* d_in, const int* in_sizes, int n_in, void* d_out, int out_size, void* d_ws,
                              size_t ws_size, hipStream_t stream) {
  P p{};
  p.x_p = (const float*)d_in[0];
  p.x_s = (const float*)d_in[1];
  p.c_ckv = (const float*)d_in[2];
  p.c_kpe = (const float*)d_in[3];
  p.c_k = (const float*)d_in[4];
  p.c_v = (const float*)d_in[5];
  p.c_kidx = (const float*)d_in[6];
  p.norm_g = (const float*)d_in[7];
  p.w_in = (const float*)d_in[8];
  p.qn_g = (const float*)d_in[9];
  p.kvn_g = (const float*)d_in[10];
  p.w_uq = (const float*)d_in[11];
  p.w_uk = (const float*)d_in[12];
  p.w_uv = (const float*)d_in[13];
  p.rel_bias = (const float*)d_in[14];
  p.w_out = (const float*)d_in[15];
  p.fn_g = (const float*)d_in[16];
  p.out = (float*)d_out;

  char* ws = (char*)d_ws;
  size_t off = 0;
  auto carve = [&](size_t bytes) {
    char* r = ws + off;
    off += (bytes + 255) & ~(size_t)255;
    return r;
  };
  p.counters = (unsigned*)carve(XB_WORDS * 4);
  p.hX = (h16*)carve((size_t)NTOK * DM * 2);
  p.mix = p.hX;
  p.scP = (float*)carve((size_t)256 * 32 * SC_STRIDE_P * 4);
  p.CQ = (h16*)carve((size_t)NTOK * 256 * 2);
  p.Wt_in = (h16*)carve((size_t)INWP * DM * 2);
  p.Wt_out = (h16*)carve((size_t)DM * DM * 2);
  p.Wq = (h16*)carve((size_t)1280 * 256 * 2);
  p.Wuv = (h16*)carve((size_t)8 * 64 * 128 * 2);
  p.QM = (h16*)carve((size_t)NTOK * 1280 * 2);
  p.XN = (h16*)carve((size_t)NTOK * DM * 2);
  p.KM = (h16*)carve((size_t)NTOK * 160 * 2);
  p.GA = (h16*)carve((size_t)NTOK * 512 * 2);
  p.GB = (h16*)carve((size_t)NTOK * 512 * 2);
  p.QB = (h16*)carve((size_t)NTOK * 512 * 2);
  p.KB = (h16*)carve((size_t)NTOK * 128 * 2);
  p.VB = (h16*)carve((size_t)NTOK * 128 * 2);
  p.QI = (h16*)carve((size_t)NTOK * 512 * 2);
  p.KI = (h16*)carve((size_t)NTOK * 64 * 2);
  p.WI = (float*)carve((size_t)NTOK * 8 * 4);
  p.RQP = (float*)carve((size_t)NTOK * 2 * 4);
  p.ropeC = (float*)carve((size_t)2080 * 16 * 4);
  p.ropeS = (float*)carve((size_t)2080 * 16 * 4);
  p.scS = (float*)carve((size_t)32 * 32 * SC_STRIDE_S * 4);
  if (off > ws_size) {
    fprintf(stderr, "workspace too small: need %zu have %zu\n", off, ws_size);
    return;
  }
  static int grid_blocks = 0;
  if (!grid_blocks) {
    int dev = 0, cus = 0, per_cu = 0;
    hipGetDevice(&dev);
    hipDeviceGetAttribute(&cus, hipDeviceAttributeMultiprocessorCount, dev);
    hipOccupancyMaxActiveBlocksPerMultiprocessor(&per_cu, mega_kernel, NBLK_THREADS, 0);
    if (per_cu > 1) per_cu = 1;
    grid_blocks = cus * per_cu;
    if (grid_blocks > 256) grid_blocks = 256;
  }
  hipMemsetAsync(p.counters, 0, XB_WORDS * 4, stream);
  hipLaunchKernelGGL(mega_kernel, dim3(grid_blocks), dim3(NBLK_THREADS), 0, stream, p);
}
```

```cpp
#include <hip/hip_runtime.h>
#include <stdint.h>
#include <stdio.h>

typedef _Float16 h16;
typedef h16 h8 __attribute__((ext_vector_type(8)));
typedef h16 h4 __attribute__((ext_vector_type(4)));
typedef h16 h2 __attribute__((ext_vector_type(2)));
typedef float f16v __attribute__((ext_vector_type(16)));
typedef short s4v __attribute__((vector_size(8)));
typedef __attribute__((address_space(3))) s4v* lds_s4p;

#define DI __device__ __forceinline__
#define MFMA32(a, b, c) __builtin_amdgcn_mfma_f32_32x32x16_f16((a), (b), (c), 0, 0, 0)

#define NTOK 17408
#define NP 16384
#define DM 1024
#define INW 2792
#define INWP 2816
#define PAST 4096
#define SKEYS 4128
#define NBLK_THREADS 512

#define OFF_Y 0
#define OFF_P_CKV 17825792
#define OFF_P_KPE 19922944
#define OFF_P_K 20447232
#define OFF_P_V 22544384
#define OFF_P_KIDX 24641536
#define OFF_S_CKV 25690112
#define OFF_S_KPE 25821184
#define OFF_S_K 25853952
#define OFF_S_V 25985024
#define OFF_S_KIDX 26116096

#define ZC_CQ 0
#define ZC_CKV 256
#define ZC_KPE 384
#define ZC_GA 416
#define ZC_QB 928
#define ZC_KB 1440
#define ZC_VB 1568
#define ZC_QI 1696
#define ZC_KI 2208
#define ZC_WI 2272
#define ZC_GB 2280

#define LOG2E 1.4426950408889634f
#define QM_SCALE 0.14724444602590306f
#define QB_SCALE 0.18033688011112042f
#define WI_SCALE 0.04419417382415922f
#define NEGBIG (-1.0e30f)

#define SMEM_BYTES 131072
#define SC_STRIDE_P 2048
#define SC_STRIDE_S 4160
#define MASK_W 132
#define N_ITEMS 1088

struct P {
  const float *x_p, *x_s, *c_ckv, *c_kpe, *c_k, *c_v, *c_kidx, *norm_g, *w_in, *qn_g, *kvn_g, *w_uq, *w_uk, *w_uv,
      *rel_bias, *w_out, *fn_g;
  float* out;
  h16 *hX, *CQ, *Wt_in, *Wt_out, *Wq, *Wuv, *QM, *KM, *GA, *GB, *QB, *KB, *VB, *QI, *KI, *mix, *XN;
  float *WI, *ropeC, *ropeS, *scP, *scS, *RQP;
  unsigned* counters;
};

DI int crow(int i, int hh) { return (i & 3) + 8 * (i >> 2) + 4 * hh; }
DI float wave_sum(float v) {
#pragma unroll
  for (int off = 32; off > 0; off >>= 1) v += __shfl_xor(v, off);
  return v;
}
DI float wave_max(float v) {
#pragma unroll
  for (int off = 32; off > 0; off >>= 1) v = fmaxf(v, __shfl_xor(v, off));
  return v;
}
DI float wave_min(float v) {
#pragma unroll
  for (int off = 32; off > 0; off >>= 1) v = fminf(v, __shfl_xor(v, off));
  return v;
}
DI h4 trread(const h16* p) {
  s4v r = __builtin_amdgcn_ds_read_tr16_b64_v4i16((lds_s4p)(p));
  return __builtin_bit_cast(h4, r);
}
DI h8 cat8(h4 a, h4 b) { return __builtin_shufflevector(a, b, 0, 1, 2, 3, 4, 5, 6, 7); }
DI h8 cvt8(float4 a, float4 b) {
  h8 r;
  r[0] = (h16)a.x; r[1] = (h16)a.y; r[2] = (h16)a.z; r[3] = (h16)a.w;
  r[4] = (h16)b.x; r[5] = (h16)b.y; r[6] = (h16)b.z; r[7] = (h16)b.w;
  return r;
}
DI h8 zero8() { h8 r; for (int i = 0; i < 8; ++i) r[i] = (h16)0.f; return r; }
DI float fast_exp2(float x) { return __builtin_amdgcn_exp2f(x); }
DI float silu(float x) { return x * __builtin_amdgcn_rcpf(1.f + __expf(-x)); }
DI int rope_idx(int t) { return t < NP ? (t & 2047) : 2048 + ((t - NP) & 31); }
DI int opaque_tid() { int t = threadIdx.x; asm volatile("" : "+v"(t)); return t; }
#define XB_CNT(x) (256 + 64 * (x))
#define XB_ARR(x) (256 + 64 * (16 + (x)))
#define XB_GEN(x) (256 + 64 * (32 + (x)))
#define XB_TOP (256 + 64 * 48)
#define XB_WORDS (256 + 64 * 49)
DI unsigned xb_ld(unsigned* q) { return __hip_atomic_load(q, __ATOMIC_RELAXED, __HIP_MEMORY_SCOPE_AGENT); }
struct XBar { unsigned* w; unsigned x, nloc, nx; };
DI void xcd_barrier(XBar& xb, unsigned k, char* smem) {
  asm volatile("s_waitcnt vmcnt(0)" ::: "memory");
  __syncthreads();
  volatile unsigned* bc = (volatile unsigned*)(smem + SMEM_BYTES - 64);
  if (threadIdx.x == 0) {
    if (k == 1u) {
      const unsigned G = gridDim.x;
      unsigned sum, nxx;
      do {
        sum = 0u; nxx = 0u;
        for (int j = 0; j < 16; ++j) { const unsigned c = xb_ld(&xb.w[XB_CNT(j)]); sum += c; nxx += (c != 0u); }
        if (sum != G) __builtin_amdgcn_s_sleep(2);
      } while (sum != G);
      bc[0] = xb_ld(&xb.w[XB_CNT(xb.x)]);
      bc[1] = nxx;
    }
  }
  if (k == 1u) {
    __syncthreads();
    xb.nloc = (unsigned)__builtin_amdgcn_readfirstlane((int)bc[0]);
    xb.nx = (unsigned)__builtin_amdgcn_readfirstlane((int)bc[1]);
  }
  if (threadIdx.x == 0) {
    const unsigned old = __hip_atomic_fetch_add(&xb.w[XB_ARR(xb.x)], 1u, __ATOMIC_RELAXED, __HIP_MEMORY_SCOPE_AGENT);
    if (old + 1u == k * xb.nloc) {
      __builtin_amdgcn_fence(__ATOMIC_RELEASE, "agent");
      asm volatile("s_waitcnt vmcnt(0)" ::: "memory");
      __hip_atomic_fetch_add(&xb.w[XB_TOP], 1u, __ATOMIC_RELAXED, __HIP_MEMORY_SCOPE_AGENT);
      while (xb_ld(&xb.w[XB_TOP]) < k * xb.nx) __builtin_amdgcn_s_sleep(1);
      __hip_atomic_store(&xb.w[XB_GEN(xb.x)], k, __ATOMIC_RELAXED, __HIP_MEMORY_SCOPE_AGENT);
    } else {
      while (xb_ld(&xb.w[XB_GEN(xb.x)]) < k) __builtin_amdgcn_s_sleep(1);
    }
    __builtin_amdgcn_fence(__ATOMIC_ACQUIRE, "agent");
    asm volatile("s_waitcnt vmcnt(0)" ::: "memory");
  }
  __syncthreads();
}
DI void grid_barrier(unsigned* bar, unsigned target) {
  asm volatile("s_waitcnt vmcnt(0)" ::: "memory");
  __syncthreads();
  if (threadIdx.x == 0) {
    __builtin_amdgcn_fence(__ATOMIC_RELEASE, "agent");
    asm volatile("s_waitcnt vmcnt(0)" ::: "memory");
    __hip_atomic_fetch_add(bar, 1u, __ATOMIC_RELAXED, __HIP_MEMORY_SCOPE_AGENT);
    while (__hip_atomic_load(bar, __ATOMIC_RELAXED, __HIP_MEMORY_SCOPE_AGENT) < target) __builtin_amdgcn_s_sleep(2);
    __builtin_amdgcn_fence(__ATOMIC_ACQUIRE, "agent");
    asm volatile("s_waitcnt vmcnt(0)" ::: "memory");
  }
  __syncthreads();
}
typedef float f2v __attribute__((ext_vector_type(2)));
DI float max3f(float a, float b, float c) {
  float d;
  asm("v_max3_f32 %0, %1, %2, %3" : "=v"(d) : "v"(a), "v"(b), "v"(c));
  return d;
}
DI void mfma_settle() {
  __builtin_amdgcn_sched_barrier(0);
  asm volatile("s_nop 7\n\ts_nop 7");
  __builtin_amdgcn_sched_barrier(0);
}
DI void pin8(const h8& v) { asm volatile("" ::"v"(v)); }
DI void pinf(const float& v) { asm volatile("" ::"v"(v)); }
DI void wavebar() { asm volatile("s_waitcnt lgkmcnt(0)" ::: "memory"); }

__constant__ float c_inv_freq[16] = {1.000000000e+00f, 5.623413324e-01f, 3.162277639e-01f, 1.778279394e-01f,
                                     1.000000015e-01f, 5.623413250e-02f, 3.162277490e-02f, 1.778279431e-02f,
                                     9.999999776e-03f, 5.623413250e-03f, 3.162277630e-03f, 1.778279431e-03f,
                                     1.000000047e-03f, 5.623413017e-04f, 3.162277571e-04f, 1.778279402e-04f};

DI void sincos_acc(float angf, float* so, float* co) {
  const double a = (double)angf;
  const double q = rint(a * 0.6366197723675814);
  double t = fma(-q, 1.5707963267948966, a);
  t = fma(-q, 6.123233995736766e-17, t);
  const int qi = ((int)q) & 3;
  const double t2 = t * t;
  double sn = -1.0 / 1307674368000.0;
  sn = fma(sn, t2, 1.0 / 6227020800.0);
  sn = fma(sn, t2, -1.0 / 39916800.0);
  sn = fma(sn, t2, 1.0 / 362880.0);
  sn = fma(sn, t2, -1.0 / 5040.0);
  sn = fma(sn, t2, 1.0 / 120.0);
  sn = fma(sn, t2, -1.0 / 6.0);
  sn = fma(sn * t2, t, t);
  double cs = 1.0 / 20922789888000.0;
  cs = fma(cs, t2, -1.0 / 87178291200.0);
  cs = fma(cs, t2, 1.0 / 479001600.0);
  cs = fma(cs, t2, -1.0 / 3628800.0);
  cs = fma(cs, t2, 1.0 / 40320.0);
  cs = fma(cs, t2, -1.0 / 720.0);
  cs = fma(cs, t2, 1.0 / 24.0);
  cs = fma(cs, t2, -0.5);
  cs = fma(cs, t2, 1.0);
  double s, c;
  if (qi == 0) { s = sn; c = cs; }
  else if (qi == 1) { s = cs; c = -sn; }
  else if (qi == 2) { s = -sn; c = -cs; }
  else { s = -cs; c = sn; }
  *so = (float)s; *co = (float)c;
}

DI void transpose_to_h(const float* __restrict__ src, int K, int N, int Npad, h16* __restrict__ dst, char* smem) {
  float* tile = (float*)smem;
  const int tid = opaque_tid();
  const int ktn = K / 64, ntn = Npad / 64;
  for (int tix = blockIdx.x; tix < ktn * ntn; tix += gridDim.x) {
    const int k0 = (tix / ntn) * 64, n0 = (tix % ntn) * 64;
    {
      const int nn = tid & 63;
#pragma unroll
      for (int i = 0; i < 8; ++i) {
        const int kk = (tid >> 6) + 8 * i;
        const int n = n0 + nn;
        tile[kk * 65 + nn] = (n < N) ? src[(size_t)(k0 + kk) * N + n] : 0.f;
      }
    }
    __syncthreads();
    {
      const int kk = tid & 63;
#pragma unroll
      for (int i = 0; i < 8; ++i) {
        const int nn = (tid >> 6) + 8 * i;
        dst[(size_t)(n0 + nn) * K + k0 + kk] = (h16)tile[kk * 65 + nn];
      }
    }
    __syncthreads();
  }
}

DI void phase0(const P& p, char* smem) {
  const int tid = opaque_tid(), lane = tid & 63, w = tid >> 6;
  const int gw = blockIdx.x * 8 + w, nw = gridDim.x * 8;
  const int gt = blockIdx.x * NBLK_THREADS + tid, nt = gridDim.x * NBLK_THREADS;
  for (int k0 = 0; gw + nw * k0 < NTOK; k0 += 5) {
    float4 v[5][4];
    float ss[5];
#pragma unroll
    for (int rr = 0; rr < 5; ++rr) {
      const int row = gw + nw * (k0 + rr);
      if (row < NTOK) {
        const float* x = row < NP ? p.x_p + (size_t)row * DM : p.x_s + (size_t)(row - NP) * DM;
#pragma unroll
        for (int i = 0; i < 4; ++i) v[rr][i] = ((const float4*)x)[lane + 64 * i];
      } else {
#pragma unroll
        for (int i = 0; i < 4; ++i) v[rr][i] = make_float4(0.f, 0.f, 0.f, 0.f);
      }
    }
#pragma unroll
    for (int rr = 0; rr < 5; ++rr) {
      float a = 0.f;
#pragma unroll
      for (int i = 0; i < 4; ++i)
        a += v[rr][i].x * v[rr][i].x + v[rr][i].y * v[rr][i].y + v[rr][i].z * v[rr][i].z + v[rr][i].w * v[rr][i].w;
      ss[rr] = a;
    }
#pragma unroll
    for (int off = 32; off > 0; off >>= 1) {
#pragma unroll
      for (int rr = 0; rr < 5; ++rr) ss[rr] += __shfl_xor(ss[rr], off);
    }
    float4 g[4];
#pragma unroll
    for (int i = 0; i < 4; ++i) g[i] = ((const float4*)p.norm_g)[lane + 64 * i];
#pragma unroll
    for (int rr = 0; rr < 5; ++rr) {
      const int row = gw + nw * (k0 + rr);
      if (row < NTOK) {
        const float rstd = rsqrtf(ss[rr] * (1.f / 1024.f) + 1e-6f);
#pragma unroll
        for (int i = 0; i < 4; ++i) {
          h4 o;
          o[0] = (h16)(v[rr][i].x * rstd * g[i].x); o[1] = (h16)(v[rr][i].y * rstd * g[i].y);
          o[2] = (h16)(v[rr][i].z * rstd * g[i].z); o[3] = (h16)(v[rr][i].w * rstd * g[i].w);
          *(h4*)(p.hX + (size_t)row * DM + (lane + 64 * i) * 4) = o;
        }
      }
    }
  }
  transpose_to_h(p.w_in, 1024, INW, INWP, p.Wt_in, smem);
  transpose_to_h(p.w_out, 1024, 1024, 1024, p.Wt_out, smem);
  for (int wt = gw; wt < 256; wt += nw) {
    const int hd = wt >> 5, k0 = ((wt >> 2) & 7) * 32, c0 = (wt & 3) * 32;
    const int r = lane & 31, hh = lane >> 5;
    f16v D;
#pragma unroll
    for (int i = 0; i < 16; ++i) D[i] = 0.f;
#pragma unroll
    for (int t = 0; t < 4; ++t) {
      const float* ap = p.w_uq + (size_t)(k0 + r) * 768 + hd * 96 + 16 * t + 8 * hh;
      const float* bp = p.w_uk + (size_t)(c0 + r) * 512 + hd * 64 + 16 * t + 8 * hh;
      const h8 a = cvt8(*(const float4*)ap, *(const float4*)(ap + 4));
      const h8 bq = cvt8(*(const float4*)bp, *(const float4*)(bp + 4));
      D = MFMA32(a, bq, D);
    }
#pragma unroll
    for (int g4 = 0; g4 < 4; ++g4) {
      const int k = k0 + 8 * g4 + 4 * hh;
      const float4 g = *(const float4*)(p.qn_g + k);
      h4 o;
      o[0] = (h16)(D[4 * g4 + 0] * g.x); o[1] = (h16)(D[4 * g4 + 1] * g.y);
      o[2] = (h16)(D[4 * g4 + 2] * g.z); o[3] = (h16)(D[4 * g4 + 3] * g.w);
      *(h4*)(p.Wq + (size_t)(hd * 128 + c0 + r) * 256 + k) = o;
    }
  }
  for (int idx = gt; idx < 256 * 256; idx += nt) {
    const int n = 1024 + (idx >> 8), k = idx & 255;
    const int hd = (n - 1024) >> 5, rr = (n - 1024) & 31;
    p.Wq[(size_t)n * 256 + k] = (h16)(p.w_uq[(size_t)k * 768 + hd * 96 + 64 + rr] * p.qn_g[k]);
  }
  for (int idx = gt; idx < 8 * 64 * 128; idx += nt) {
    const int j = idx & 7, ln = (idx >> 3) & 63, sq = (idx >> 9) & 1, dt = (idx >> 10) & 3, vt = (idx >> 12) & 1, hd = idx >> 13;
    const int v = 32 * vt + (ln & 31);
    const int c = 32 * dt + 16 * sq + 8 * (j >> 2) + 4 * (ln >> 5) + (j & 3);
    p.Wuv[idx] = (h16)p.w_uv[(size_t)c * 512 + hd * 64 + v];
  }
  for (int idx = gt; idx < 2080 * 16; idx += nt) {
    const int pi = idx >> 4, j = idx & 15;
    const int pos = pi < 2048 ? pi : PAST + (pi - 2048);
    const float ang = (float)pos * c_inv_freq[j];
    float s, c;
    sincos_acc(ang, &s, &c);
    p.ropeC[idx] = c; p.ropeS[idx] = s;
  }
}

template <int BM, int BN, int WGM, int WGN>
DI void gemm_tile(const h16* __restrict__ A, int lda, const h16* __restrict__ B, int ldb, int K, int m0, int n0,
                  char* smem) {
  constexpr int LS = 72, TS = 136;
  constexpr int TM = BM / WGM, TN = BN / WGN, MI = TM / 32, NI = TN / 32;
  constexpr int ACH = BM * 8 / NBLK_THREADS, BCH = BN * 8 / NBLK_THREADS;
  h16* sA = (h16*)smem;
  h16* sB = sA + 2 * BM * LS;
  const int tid = opaque_tid(), lane = tid & 63, w = tid >> 6;
  const int wm = w / WGN, wn = w % WGN;
  const int r = lane & 31, hh = lane >> 5;
  f16v acc[MI][NI];
#pragma unroll
  for (int mi = 0; mi < MI; ++mi)
#pragma unroll
    for (int ni = 0; ni < NI; ++ni)
#pragma unroll
      for (int i = 0; i < 16; ++i) acc[mi][ni][i] = 0.f;
  h8 ra[ACH], rb[BCH];
  const int KT = K / 64;
#define GLOAD(kt)                                                                                   \
  {                                                                                                 \
    _Pragma("unroll") for (int i = 0; i < ACH; ++i) {                                               \
      const int q = tid + NBLK_THREADS * i;                                                         \
      ra[i] = *(const h8*)(A + (size_t)(m0 + (q >> 3)) * lda + (kt) * 64 + (q & 7) * 8);            \
    }                                                                                               \
    _Pragma("unroll") for (int i = 0; i < BCH; ++i) {                                               \
      const int q = tid + NBLK_THREADS * i;                                                         \
      rb[i] = *(const h8*)(B + (size_t)(n0 + (q >> 3)) * ldb + (kt) * 64 + (q & 7) * 8);            \
    }                                                                                               \
  }
#define SSTORE(buf)                                                                                 \
  {                                                                                                 \
    _Pragma("unroll") for (int i = 0; i < ACH; ++i) {                                               \
      const int q = tid + NBLK_THREADS * i;                                                         \
      *(h8*)(sA + ((buf) * BM + (q >> 3)) * LS + (q & 7) * 8) = ra[i];                              \
    }                                                                                               \
    _Pragma("unroll") for (int i = 0; i < BCH; ++i) {                                               \
      const int q = tid + NBLK_THREADS * i;                                                         \
      *(h8*)(sB + ((buf) * BN + (q >> 3)) * LS + (q & 7) * 8) = rb[i];                              \
    }                                                                                               \
  }
  GLOAD(0);
  SSTORE(0);
  __syncthreads();
  int buf = 0;
  for (int kt = 0; kt < KT; ++kt) {
    if (kt + 1 < KT) GLOAD(kt + 1);
    const h16* a_base = sA + (buf * BM + wm * TM + r) * LS + 8 * hh;
    const h16* b_base = sB + (buf * BN + wn * TN + r) * LS + 8 * hh;
#pragma unroll
    for (int t = 0; t < 4; ++t) {
      h8 af[MI], bf[NI];
#pragma unroll
      for (int mi = 0; mi < MI; ++mi) af[mi] = *(const h8*)(a_base + mi * 32 * LS + t * 16);
#pragma unroll
      for (int ni = 0; ni < NI; ++ni) bf[ni] = *(const h8*)(b_base + ni * 32 * LS + t * 16);
#pragma unroll
      for (int mi = 0; mi < MI; ++mi)
#pragma unroll
        for (int ni = 0; ni < NI; ++ni) acc[mi][ni] = MFMA32(bf[ni], af[mi], acc[mi][ni]);
    }
    if (kt + 1 < KT) SSTORE(buf ^ 1);
    __syncthreads();
    buf ^= 1;
  }
#undef GLOAD
#undef SSTORE
  h16* T = (h16*)smem;
#pragma unroll
  for (int mi = 0; mi < MI; ++mi)
#pragma unroll
    for (int ni = 0; ni < NI; ++ni)
#pragma unroll
      for (int g4 = 0; g4 < 4; ++g4) {
        h4 o;
#pragma unroll
        for (int jj = 0; jj < 4; ++jj) o[jj] = (h16)acc[mi][ni][4 * g4 + jj];
        *(h4*)(T + (wm * TM + mi * 32 + r) * TS + wn * TN + ni * 32 + 8 * g4 + 4 * hh) = o;
      }
  __syncthreads();
}

template <int OP>
DI void epi_simple(const h16* T, int m0, h16* dst, int ld, int col0, int tid) {
  h8 v[8];
#pragma unroll
  for (int it = 0; it < 8; ++it) {
    const int q = tid + NBLK_THREADS * it;
    v[it] = *(const h8*)(T + (q >> 4) * 136 + (q & 15) * 8);
  }
#pragma unroll
  for (int it = 0; it < 8; ++it) {
    const int q = tid + NBLK_THREADS * it;
    h8 o;
#pragma unroll
    for (int e = 0; e < 8; ++e) {
      const float x = (float)v[it][e];
      o[e] = (OP == 1) ? (h16)silu(x) : (OP == 2) ? (h16)(x * QB_SCALE) : v[it][e];
    }
    *(h8*)(dst + (size_t)(m0 + (q >> 4)) * ld + col0 + (q & 15) * 8) = o;
  }
}
DI float4 f4_lo(h8 v) { return make_float4((float)v[0], (float)v[1], (float)v[2], (float)v[3]); }
DI float4 f4_hi(h8 v) { return make_float4((float)v[4], (float)v[5], (float)v[6], (float)v[7]); }
typedef float f32x4 __attribute__((ext_vector_type(4)));
typedef __attribute__((address_space(3))) unsigned* lds_u32p;
DI int g8_lds_byte(int r, int c) {
  const int st = (r >> 4) * 2 + (c >> 5), rr = r & 15, cc = c & 31, ob = rr * 64 + cc * 2;
  return st * 1024 + (ob ^ (((ob >> 9) & 1) << 5));
}
DI void g8_stage_rc(int b, int& R, int& C) {
  const int st = b / 1024, sb = b % 1024, swz = sb ^ (((sb >> 9) & 1) << 5);
  R = (st >> 1) * 16 + swz / 64;
  C = (st & 1) * 32 + (swz % 64) / 2;
}
#define G8_HT (128 * 64)
DI void gemm8_mainloop(const h16* __restrict__ A, const h16* __restrict__ Bt, int K, int brow, int bcol, char* smem,
                       f32x4 (&acc)[2][2][4][2]) {
  h16* shm = (h16*)smem;
  const int tid = opaque_tid();
  const int wid = tid >> 6, lane = tid & 63, wr = wid >> 2, wc = wid & 3, fr = lane & 15, fq = lane >> 4;
  int so[2];
#pragma unroll
  for (int i = 0; i < 2; ++i) { int R, C; g8_stage_rc(tid * 16 + i * 8192, R, C); so[i] = R * K + C; }
#define G8_SA(b, h) (shm + ((b) * 2 + (h)) * G8_HT)
#define G8_SB(b, h) (shm + (4 + (b) * 2 + (h)) * G8_HT)
#define G8_STAGE(Pp, BASE, br, kt)                                                                        \
  do {                                                                                                    \
    const h16* _bp = (BASE) + (size_t)(br) * K + (kt) * 64;                              \
    _Pragma("unroll") for (int _i = 0; _i < 2; ++_i) {                                                    \
      const h16* _g = _bp + so[_i];                                                                       \
      __builtin_amdgcn_global_load_lds((const unsigned*)_g,                                               \
                                       (lds_u32p)((char*)(Pp) + tid * 16 + _i * 8192), 16, 0, 0);         \
    }                                                                                                     \
  } while (0)
#define G8_LDA(dst, b, h)                                                                                 \
  _Pragma("unroll") for (int m = 0; m < 4; ++m) _Pragma("unroll") for (int k = 0; k < 2; ++k)             \
    dst[m][k] = *(const h8*)((const char*)G8_SA(b, h) + g8_lds_byte(wr * 64 + m * 16 + fr, k * 32 + fq * 8))
#define G8_LDB(dst, b, h)                                                                                 \
  _Pragma("unroll") for (int n = 0; n < 2; ++n) _Pragma("unroll") for (int k = 0; k < 2; ++k)             \
    dst[n][k] = *(const h8*)((const char*)G8_SB(b, h) + g8_lds_byte(wc * 32 + n * 16 + fr, k * 32 + fq * 8))
#define G8_MMA(ai, bj, At, Bq)                                                                            \
  do {                                                                                                    \
    __builtin_amdgcn_s_setprio(1);                                                                        \
    _Pragma("unroll") for (int m = 0; m < 4; ++m) _Pragma("unroll") for (int n = 0; n < 2; ++n)           \
      _Pragma("unroll") for (int k = 0; k < 2; ++k)                                                       \
        acc[ai][bj][m][n] = __builtin_amdgcn_mfma_f32_16x16x32_f16(Bq[n][k], At[m][k], acc[ai][bj][m][n], 0, 0, 0); \
    __builtin_amdgcn_s_setprio(0);                                                                        \
  } while (0)
#define G8_WAIT_V(n) asm volatile("s_waitcnt vmcnt(" #n ")" ::: "memory")
#define G8_WAIT_L(n) asm volatile("s_waitcnt lgkmcnt(" #n ")" ::: "memory")
#define G8_BAR __builtin_amdgcn_s_barrier()
#define G8_SCHED __builtin_amdgcn_sched_barrier(0)
#pragma unroll
  for (int a = 0; a < 2; ++a)
#pragma unroll
    for (int b = 0; b < 2; ++b)
#pragma unroll
      for (int m = 0; m < 4; ++m)
#pragma unroll
        for (int n = 0; n < 2; ++n) acc[a][b][m][n] = f32x4{0.f, 0.f, 0.f, 0.f};
  h8 At[4][2], B0[2][2], B1[2][2];
  const int nt = K / 64;
  G8_STAGE(G8_SB(0, 0), Bt, bcol, 0); G8_STAGE(G8_SA(0, 0), A, brow, 0);
  G8_STAGE(G8_SB(0, 1), Bt, bcol + 128, 0); G8_STAGE(G8_SA(0, 1), A, brow + 128, 0);
  if (wr == 1) G8_BAR;
  G8_WAIT_V(4); G8_BAR;
  G8_STAGE(G8_SB(1, 0), Bt, bcol, 1); G8_STAGE(G8_SA(1, 0), A, brow, 1); G8_STAGE(G8_SB(1, 1), Bt, bcol + 128, 1);
  G8_WAIT_V(6); G8_BAR;
  for (int t = 0; t < nt - 2; t += 2) {
    G8_LDB(B0, 0, 0); G8_SCHED; G8_LDA(At, 0, 0); G8_STAGE(G8_SA(1, 1), A, brow + 128, t + 1);
    G8_WAIT_L(8); G8_BAR; G8_WAIT_L(0); G8_MMA(0, 0, At, B0); G8_BAR; G8_SCHED;
    G8_LDB(B1, 0, 1); G8_STAGE(G8_SB(0, 0), Bt, bcol, t + 2);
    G8_BAR; G8_WAIT_L(0); G8_MMA(0, 1, At, B1); G8_BAR;
    G8_LDA(At, 0, 1); G8_STAGE(G8_SA(0, 0), A, brow, t + 2);
    G8_BAR; G8_WAIT_L(0); G8_MMA(1, 0, At, B0); G8_BAR; G8_SCHED;
    G8_STAGE(G8_SB(0, 1), Bt, bcol + 128, t + 2);
    G8_WAIT_V(6); G8_BAR; G8_MMA(1, 1, At, B1); G8_BAR;
    G8_LDB(B0, 1, 0); G8_SCHED; G8_LDA(At, 1, 0); G8_STAGE(G8_SA(0, 1), A, brow + 128, t + 2);
    G8_WAIT_L(8); G8_BAR; G8_WAIT_L(0); G8_MMA(0, 0, At, B0); G8_BAR; G8_SCHED;
    G8_LDB(B1, 1, 1); G8_STAGE(G8_SB(1, 0), Bt, bcol, t + 3);
    G8_BAR; G8_WAIT_L(0); G8_MMA(0, 1, At, B1); G8_BAR;
    G8_LDA(At, 1, 1); G8_STAGE(G8_SA(1, 0), A, brow, t + 3);
    G8_BAR; G8_WAIT_L(0); G8_MMA(1, 0, At, B0); G8_BAR; G8_SCHED;
    G8_STAGE(G8_SB(1, 1), Bt, bcol + 128, t + 3);
    G8_WAIT_V(6); G8_BAR; G8_MMA(1, 1, At, B1); G8_BAR;
  }
  { G8_LDB(B0, 0, 0); G8_LDA(At, 0, 0); G8_STAGE(G8_SA(1, 1), A, brow + 128, nt - 1);
    G8_BAR; G8_WAIT_L(0); G8_MMA(0, 0, At, B0); G8_BAR;
    G8_LDB(B1, 0, 1); G8_BAR; G8_WAIT_L(0); G8_MMA(0, 1, At, B1); G8_BAR;
    G8_LDA(At, 0, 1); G8_WAIT_V(4); G8_BAR; G8_WAIT_L(0); G8_MMA(1, 0, At, B0); G8_MMA(1, 1, At, B1); G8_BAR; }
  { G8_LDB(B0, 1, 0); G8_LDA(At, 1, 0); G8_WAIT_V(2); G8_BAR; G8_WAIT_L(0); G8_MMA(0, 0, At, B0); G8_BAR;
    G8_LDB(B1, 1, 1); G8_WAIT_V(0); G8_BAR; G8_WAIT_L(0); G8_MMA(0, 1, At, B1); G8_BAR;
    G8_LDA(At, 1, 1); G8_BAR; G8_WAIT_L(0); G8_MMA(1, 0, At, B0); G8_MMA(1, 1, At, B1); G8_BAR; }
  if (wr == 0) G8_BAR;
#undef G8_SA
#undef G8_SB
#undef G8_STAGE
#undef G8_LDA
#undef G8_LDB
#undef G8_MMA
}

DI void p1_epilogue(const P& p, const h16* T, int m0, int n0, int nt, bool isP) {
  constexpr int TS = 136;
  const int tid = opaque_tid(), lane = tid & 63, w = tid >> 6;
  if (nt == 2) {
    for (int rr = w; rr < 256; rr += 8) {
      const int m = m0 + rr;
      const h2 v2 = *(const h2*)(T + rr * TS + 2 * lane);
      const float a = (float)v2[0], b = (float)v2[1];
      const float ss = wave_sum(a * a + b * b);
      const float rstd = rsqrtf(ss * (1.f / 128.f) + 1e-6f);
      const float2 g = *(const float2*)(p.kvn_g + 2 * lane);
      const float o0 = a * rstd * g.x, o1 = b * rstd * g.y;
      float* oc = isP ? p.out + OFF_P_CKV + (size_t)m * 128 : p.out + OFF_S_CKV + (size_t)(m - NP) * 128;
      *(float2*)(oc + 2 * lane) = make_float2(o0, o1);
      h2 o; o[0] = (h16)o0; o[1] = (h16)o1;
      *(h2*)(p.KM + (size_t)m * 160 + 2 * lane) = o;
    }
  } else if (nt >= 4 && nt <= 6) {
    epi_simple<1>(T, m0, p.GA, 512, n0 - ZC_GA, tid);
  } else if (nt >= 8 && nt <= 10) {
    epi_simple<2>(T, m0, p.QB, 512, n0 - ZC_QB, tid);
  } else if (nt >= 14 && nt <= 16) {
    epi_simple<0>(T, m0, p.QI, 512, n0 - ZC_QI, tid);
  } else if (nt >= 18 && nt <= 20) {
    epi_simple<1>(T, m0, p.GB, 512, n0 - ZC_GB, tid);
  } else {
#pragma unroll 1
    for (int it = 0; it < 8; ++it) {
      const int q = tid + NBLK_THREADS * it;
      const int row = q >> 4, ch = q & 15;
      const int col = n0 + ch * 8, m = m0 + row;
      const int ms = isP ? m : m - NP;
      const h8 v = *(const h8*)(T + row * TS + ch * 8);
      if (col < ZC_CKV) {
        *(h8*)(p.CQ + (size_t)m * 256 + col) = v;
        float ss = 0.f;
#pragma unroll
        for (int e = 0; e < 8; ++e) ss += (float)v[e] * (float)v[e];
        ss += __shfl_xor(ss, 1); ss += __shfl_xor(ss, 2); ss += __shfl_xor(ss, 4); ss += __shfl_xor(ss, 8);
        if (ch == 0) p.RQP[(size_t)m * 2 + nt] = ss;
      } else if (col < ZC_GA) {
        const int j0 = col - ZC_KPE;
        const bool hiHalf = j0 >= 16;
        const h8 u = *(const h8*)(T + row * TS + (hiHalf ? ch - 2 : ch + 2) * 8);
        const int ri = rope_idx(m) * 16 + (j0 & 15);
        const float4 c0 = *(const float4*)(p.ropeC + ri), c1 = *(const float4*)(p.ropeC + ri + 4);
        const float4 s0 = *(const float4*)(p.ropeS + ri), s1 = *(const float4*)(p.ropeS + ri + 4);
        const float cs[8] = {c0.x, c0.y, c0.z, c0.w, c1.x, c1.y, c1.z, c1.w};
        const float sn[8] = {s0.x, s0.y, s0.z, s0.w, s1.x, s1.y, s1.z, s1.w};
        float o[8];
        h8 oh;
#pragma unroll
        for (int e = 0; e < 8; ++e) {
          const float mine = (float)v[e], other = (float)u[e];
          o[e] = hiHalf ? (other * sn[e] + mine * cs[e]) : (mine * cs[e] - other * sn[e]);
          oh[e] = (h16)o[e];
        }
        float* oc = (isP ? p.out + OFF_P_KPE : p.out + OFF_S_KPE) + (size_t)ms * 32 + j0;
        *(float4*)oc = make_float4(o[0], o[1], o[2], o[3]);
        *(float4*)(oc + 4) = make_float4(o[4], o[5], o[6], o[7]);
        *(h8*)(p.KM + (size_t)m * 160 + 128 + j0) = oh;
      } else if (col < ZC_QB) {
        h8 o;
#pragma unroll
        for (int e = 0; e < 8; ++e) o[e] = (h16)silu((float)v[e]);
        *(h8*)(p.GA + (size_t)m * 512 + (col - ZC_GA)) = o;
      } else if (col < ZC_KB) {
        h8 o;
#pragma unroll
        for (int e = 0; e < 8; ++e) o[e] = (h16)((float)v[e] * QB_SCALE);
        *(h8*)(p.QB + (size_t)m * 512 + (col - ZC_QB)) = o;
      } else if (col < ZC_QI) {
        const bool isK = col < ZC_VB;
        const int c0 = col - (isK ? ZC_KB : ZC_VB);
        float* oc = (isK ? (isP ? p.out + OFF_P_K : p.out + OFF_S_K) : (isP ? p.out + OFF_P_V : p.out + OFF_S_V)) +
                    (size_t)ms * 128 + c0;
        *(float4*)oc = f4_lo(v);
        *(float4*)(oc + 4) = f4_hi(v);
        *(h8*)((isK ? p.KB : p.VB) + (size_t)m * 128 + c0) = v;
      } else if (col < ZC_KI) {
        *(h8*)(p.QI + (size_t)m * 512 + (col - ZC_QI)) = v;
      } else if (col < ZC_WI) {
        float* oc = (isP ? p.out + OFF_P_KIDX : p.out + OFF_S_KIDX) + (size_t)ms * 64 + (col - ZC_KI);
        *(float4*)oc = f4_lo(v);
        *(float4*)(oc + 4) = f4_hi(v);
        *(h8*)(p.KI + (size_t)m * 64 + (col - ZC_KI)) = v;
      } else if (col < ZC_GB) {
        float* oc = p.WI + (size_t)m * 8;
        const float4 a = f4_lo(v), b = f4_hi(v);
        *(float4*)oc = make_float4(a.x * WI_SCALE, a.y * WI_SCALE, a.z * WI_SCALE, a.w * WI_SCALE);
        *(float4*)(oc + 4) = make_float4(b.x * WI_SCALE, b.y * WI_SCALE, b.z * WI_SCALE, b.w * WI_SCALE);
      } else if (col < INW) {
        h8 o;
#pragma unroll
        for (int e = 0; e < 8; ++e) o[e] = (h16)silu((float)v[e]);
        *(h8*)(p.GB + (size_t)m * 512 + (col - ZC_GB)) = o;
      }
    }
  }
}

DI void phase1(const P& p, char* smem) {
  constexpr int TS = 136;
  h16* T = (h16*)smem;
  const int ntiles = 68 * 11;
  const int xcd = blockIdx.x & 7, lb = blockIdx.x >> 3, nlb = gridDim.x >> 3;
  const int per = (ntiles + 7) >> 3;
  const int tend = (xcd * per + per) < ntiles ? (xcd * per + per) : ntiles;
  for (int L = xcd * per + lb; L < tend; L += nlb) {
    const int pg = L / 44, rem = L - pg * 44;
    const int pn = rem >> 2, mt = pg * 4 + (rem & 3);
    const int m0 = mt * 256;
    const bool isP = mt < 64;
    f32x4 acc[2][2][4][2];
    gemm8_mainloop(p.hX, p.Wt_in, DM, m0, pn * 256, smem, acc);
    __syncthreads();
    const int tid = opaque_tid();
    const int wid = tid >> 6, lane = tid & 63, wr = wid >> 2, wc = wid & 3, fr = lane & 15, fq = lane >> 4;
#pragma unroll
    for (int bj = 0; bj < 2; ++bj) {
#pragma unroll
      for (int ai = 0; ai < 2; ++ai)
#pragma unroll
        for (int m = 0; m < 4; ++m)
#pragma unroll
          for (int n = 0; n < 2; ++n)
          {
            h4 o;
#pragma unroll
            for (int jj = 0; jj < 4; ++jj) o[jj] = (h16)acc[ai][bj][m][n][jj];
            *(h4*)(T + (ai * 128 + wr * 64 + m * 16 + fr) * TS + wc * 32 + n * 16 + fq * 4) = o;
          }
      __syncthreads();
      p1_epilogue(p, T, m0, pn * 256 + bj * 128, pn * 2 + bj, isP);
      __syncthreads();
    }
  }
}

DI size_t qm_index(int m, int hd, int d) {
  return ((((size_t)(m >> 5) * 8 + hd) * 10 + (d >> 4)) * 64 + (((d >> 3) & 1) * 32 + (m & 31))) * 8 + (d & 7);
}
DI void phase1b(const P& p, char* smem) {
  constexpr int TS = 136;
  h16* T = (h16*)smem;
  float* rq = (float*)(smem + 128 * 1024 - 2048);
  const int ntiles = 68 * 5;
  for (int tile = blockIdx.x; tile < ntiles; tile += gridDim.x) {
    const int mt = tile / 5, pn = tile % 5;
    const int m0 = mt * 256;
    f32x4 acc[2][2][4][2];
    gemm8_mainloop(p.CQ, p.Wq, 256, m0, pn * 256, smem, acc);
    __syncthreads();
    const int tid = opaque_tid();
    if (tid < 256) {
      const float2 pp = *(const float2*)(p.RQP + (size_t)(m0 + tid) * 2);
      rq[tid] = rsqrtf((pp.x + pp.y) * (1.f / 256.f) + 1e-6f) * QM_SCALE;
    }
    const int wid = tid >> 6, lane = tid & 63, wr = wid >> 2, wc = wid & 3, fr = lane & 15, fq = lane >> 4;
#pragma unroll
    for (int bj = 0; bj < 2; ++bj) {
      const int nt = pn * 2 + bj;
#pragma unroll
      for (int ai = 0; ai < 2; ++ai)
#pragma unroll
        for (int m = 0; m < 4; ++m)
#pragma unroll
          for (int n = 0; n < 2; ++n)
          {
            h4 o;
#pragma unroll
            for (int jj = 0; jj < 4; ++jj) o[jj] = (h16)acc[ai][bj][m][n][jj];
            *(h4*)(T + (ai * 128 + wr * 64 + m * 16 + fr) * TS + wc * 32 + n * 16 + fq * 4) = o;
          }
      __syncthreads();
#pragma unroll 2
      for (int it = 0; it < 8; ++it) {
        const int q = tid + NBLK_THREADS * it;
        const int row = q >> 4, ch = q & 15;
        const int m = m0 + row;
        const float sc = rq[row];
        const h8 v = *(const h8*)(T + row * TS + ch * 8);
        h8 o;
        int hd, d0;
        if (nt < 8) {
          hd = nt; d0 = ch * 8;
#pragma unroll
          for (int e = 0; e < 8; ++e) o[e] = (h16)((float)v[e] * sc);
        } else {
          hd = (nt - 8) * 4 + (ch >> 2);
          const int j0 = (ch & 3) * 8;
          d0 = 128 + j0;
          const bool hiHalf = j0 >= 16;
          const h8 u = *(const h8*)(T + row * TS + (hiHalf ? ch - 2 : ch + 2) * 8);
          const int ri = rope_idx(m) * 16 + (j0 & 15);
          const float4 c0 = *(const float4*)(p.ropeC + ri), c1 = *(const float4*)(p.ropeC + ri + 4);
          const float4 s0 = *(const float4*)(p.ropeS + ri), s1 = *(const float4*)(p.ropeS + ri + 4);
          const float cs[8] = {c0.x, c0.y, c0.z, c0.w, c1.x, c1.y, c1.z, c1.w};
          const float sn[8] = {s0.x, s0.y, s0.z, s0.w, s1.x, s1.y, s1.z, s1.w};
#pragma unroll
          for (int e = 0; e < 8; ++e) {
            const float mine = (float)v[e] * sc, other = (float)u[e] * sc;
            o[e] = (h16)(hiHalf ? (other * sn[e] + mine * cs[e]) : (mine * cs[e] - other * sn[e]));
          }
        }
        *(h8*)(p.QM + qm_index(m, hd, d0)) = o;
      }
      __syncthreads();
    }
  }
}

template <bool SAMPLE>
DI void mla_item(const P& p, int b, int tok0, int nkeys, char* smem, const int tid, unsigned* ctr, int& nxt) {
  constexpr int KS = 168;
  h16* sK = (h16*)smem;
  const int lane = tid & 63, w = tid >> 6;
  const int r = lane & 31, hh = lane >> 5;
  const int i16 = lane & 15, q4 = i16 >> 2, p4 = i16 & 3, blk = (lane >> 4) & 1;

  h8 qf[10];
  {
    const h16* qp = p.QM + ((size_t)((tok0 >> 5) * 8 + w) * 10 * 64 + lane) * 8;
#pragma unroll
    for (int t = 0; t < 10; ++t) qf[t] = *(const h8*)(qp + t * 512);
  }
  f16v O[4];
#pragma unroll
  for (int dt = 0; dt < 4; ++dt)
#pragma unroll
    for (int i = 0; i < 16; ++i) O[dt][i] = 0.f;
  float m = NEGBIG, l = 0.f;

  h8 sh[3];
  float4 sf[3][2];
  const int NT = (nkeys + 63) >> 6;

#define MLA_GLOAD(kt)                                                                                          \
  {                                                                                                            \
    _Pragma("unroll") for (int i = 0; i < 3; ++i) {                                                            \
      const int q = tid + NBLK_THREADS * i;                                                                    \
      const int row = q / 20, cc = q % 20;                                                                     \
      const int s = (kt) * 64 + row;                                                                           \
      if (q < 1280) {                                                                                          \
        if (!SAMPLE) {                                                                                         \
          sh[i] = *(const h8*)(p.KM + (size_t)(b * 2048 + s) * 160 + cc * 8);                                  \
        } else {                                                                                               \
          if (s < PAST) {                                                                                      \
            const float* src = (cc < 16) ? p.c_ckv + ((size_t)(b * PAST + s) * 128 + cc * 8)                   \
                                         : p.c_kpe + ((size_t)(b * PAST + s) * 32 + (cc - 16) * 8);            \
            sf[i][0] = *(const float4*)src; sf[i][1] = *(const float4*)(src + 4);                              \
          } else if (s < SKEYS) {                                                                              \
            sf[i][0] = __builtin_bit_cast(float4, *(const h8*)(p.KM + (size_t)(NP + b * 32 + (s - PAST)) * 160 + cc * 8)); \
          } else {                                                                                             \
            sf[i][0] = make_float4(0.f, 0.f, 0.f, 0.f);                                                        \
          }                                                                                                    \
        }                                                                                                      \
      }                                                                                                        \
    }                                                                                                          \
  }
#define MLA_SSTORE(kt, buf)                                                                                    \
  {                                                                                                            \
    _Pragma("unroll") for (int i = 0; i < 3; ++i) {                                                            \
      const int q = tid + NBLK_THREADS * i;                                                                    \
      const int row = q / 20, cc = q % 20;                                                                     \
      const int s = (kt) * 64 + row;                                                                           \
      if (q < 1280) {                                                                                          \
        h8 v;                                                                                                  \
        if (SAMPLE) v = (s < PAST) ? cvt8(sf[i][0], sf[i][1]) : __builtin_bit_cast(h8, sf[i][0]);              \
        else v = sh[i];                                                                                        \
        *(h8*)(sK + ((buf) * 64 + row) * KS + cc * 8) = v;                                                     \
      }                                                                                                        \
    }                                                                                                          \
  }

  MLA_GLOAD(0);
#pragma unroll
  for (int t = 0; t < 10; ++t) pin8(qf[t]);
  MLA_SSTORE(0, 0);
  __syncthreads();
  int buf = 0;
  for (int kt = 0; kt < NT; ++kt) {
    if (kt + 1 < NT) MLA_GLOAD(kt + 1);
    const bool two = (nkeys - kt * 64) > 32;
    const h16* kbase = sK + buf * 64 * KS;
    const h16* ka_ptr = kbase + r * KS + 8 * hh;
    const h16* vb_ptr = kbase + (4 * hh + q4) * KS + 16 * blk + 4 * p4;
    f16v S0, S1;
#pragma unroll
    for (int i = 0; i < 16; ++i) { S0[i] = 0.f; S1[i] = 0.f; }
    {
      h8 ka0[3], ka1[3];
#pragma unroll
      for (int t = 0; t < 3; ++t) {
        ka0[t] = *(const h8*)(ka_ptr + 16 * t);
        ka1[t] = *(const h8*)(ka_ptr + 32 * KS + 16 * t);
      }
#pragma unroll
      for (int t = 0; t < 10; ++t) {
        S0 = MFMA32(ka0[t % 3], qf[t], S0);
        S1 = MFMA32(ka1[t % 3], qf[t], S1);
        if (t + 3 < 10) {
          ka0[t % 3] = *(const h8*)(ka_ptr + 16 * (t + 3));
          ka1[t % 3] = *(const h8*)(ka_ptr + 32 * KS + 16 * (t + 3));
        }
      }
    }
    h8 vf[4];
#define MLA_VLOAD(f)                                                                   \
  {                                                                                    \
    const h16* vp = vb_ptr + ((((f) >> 3) * 32) + ((((f) >> 2) & 1) * 16)) * KS + 32 * ((f) & 3); \
    vf[(f) & 3] = cat8(trread(vp), trread(vp + 8 * KS));                               \
  }
#pragma unroll
    for (int f = 0; f < 4; ++f) MLA_VLOAD(f);
    if (!two) {
      asm volatile("" ::: "memory");
#pragma unroll
      for (int i = 0; i < 16; ++i) S1[i] = NEGBIG;
    }
    mfma_settle();
    float mx = max3f(S0[0], S0[1], S1[0]);
    mx = max3f(mx, S1[1], S0[2]);
#pragma unroll
    for (int i = 2; i < 15; ++i) mx = max3f(mx, S1[i], S0[i + 1]);
    mx = fmaxf(mx, S1[15]);
    mx = fmaxf(mx, __shfl_xor(mx, 32));
    if (__any(mx > m)) {
      const float mn = fmaxf(m, mx);
      const float alpha = fast_exp2(m - mn);
      m = mn;
      l *= alpha;
#pragma unroll
      for (int dt = 0; dt < 4; ++dt)
#pragma unroll
        for (int i = 0; i < 16; ++i) O[dt][i] *= alpha;
    }
    {
      const f2v m2 = {m, m};
      f2v rs2 = {0.f, 0.f};
#pragma unroll
      for (int i = 0; i < 16; i += 2) {
        f2v a = {S0[i], S0[i + 1]};
        f2v b = {S1[i], S1[i + 1]};
        a -= m2; b -= m2;
        a[0] = fast_exp2(a[0]); a[1] = fast_exp2(a[1]);
        b[0] = fast_exp2(b[0]); b[1] = fast_exp2(b[1]);
        rs2 += a; rs2 += b;
        S0[i] = a[0]; S0[i + 1] = a[1]; S1[i] = b[0]; S1[i + 1] = b[1];
      }
      l += rs2[0] + rs2[1];
    }
    h8 pb[4];
#pragma unroll
    for (int g = 0; g < 4; ++g)
#pragma unroll
      for (int jj = 0; jj < 8; ++jj) pb[g][jj] = (h16)((g < 2) ? S0[8 * (g & 1) + jj] : S1[8 * (g & 1) + jj]);
#pragma unroll
    for (int f = 0; f < 16; ++f) {
      O[f & 3] = MFMA32(vf[f & 3], pb[f >> 2], O[f & 3]);
      if (f + 4 < 16) MLA_VLOAD(f + 4);
    }
#undef MLA_VLOAD
    if (kt + 1 < NT) MLA_SSTORE(kt + 1, buf ^ 1);
    __syncthreads();
    buf ^= 1;
  }
#undef MLA_GLOAD
#undef MLA_SSTORE
  if (threadIdx.x == 0) nxt = (int)atomicAdd(ctr, 1u);
  const float inv = 1.f / (l + __shfl_xor(l, 32));
  f16v Y[2];
#pragma unroll
  for (int vt = 0; vt < 2; ++vt)
#pragma unroll
    for (int i = 0; i < 16; ++i) Y[vt][i] = 0.f;
#pragma unroll
  for (int dt = 0; dt < 4; ++dt) {
#pragma unroll
    for (int s = 0; s < 2; ++s) {
      h8 ob;
#pragma unroll
      for (int j = 0; j < 8; ++j) ob[j] = (h16)(O[dt][8 * s + j] * inv);
#pragma unroll
      for (int vt = 0; vt < 2; ++vt) {
        const h8 a = *(const h8*)(p.Wuv + ((size_t)((((w * 2 + vt) * 4 + dt) * 2 + s) * 64 + lane)) * 8);
        Y[vt] = MFMA32(a, ob, Y[vt]);
      }
    }
  }
  h16* Yt = (h16*)smem + w * (32 * 72);
#pragma unroll
  for (int vt = 0; vt < 2; ++vt) {
#pragma unroll
    for (int g4 = 0; g4 < 4; ++g4) {
      h4 o;
#pragma unroll
      for (int j = 0; j < 4; ++j) o[j] = (h16)Y[vt][4 * g4 + j];
      *(h4*)(Yt + r * 72 + 32 * vt + 8 * g4 + 4 * hh) = o;
    }
  }
  wavebar();
#pragma unroll
  for (int i = 0; i < 4; ++i) {
    const int q = lane + 64 * i;
    const int row = q >> 3, ch = q & 7;
    const h8 y = *(const h8*)(Yt + row * 72 + ch * 8);
    const h8 ga = *(const h8*)(p.GA + (size_t)(tok0 + row) * 512 + w * 64 + ch * 8);
    h8 o;
#pragma unroll
    for (int j = 0; j < 8; ++j) o[j] = (h16)((float)y[j] * (float)ga[j]);
    *(h8*)(p.mix + (size_t)(tok0 + row) * 1024 + w * 64 + ch * 8) = o;
  }
  __syncthreads();
}

#define SEL_CAP 256
DI int sel_bin(float v, float lo, float scale, bool degen) {
  if (degen) return v > lo ? 1023 : 0;
  int b = (int)((v - lo) * scale);
  return b > 1023 ? 1023 : b;
}
template <int NR, int NH>
DI void wave_select(const float* sc, int N, unsigned* maskrow, unsigned* hist, float* candv, int* candi, int lane,
                 float (&vpre)[NR], const float* scnext) {
  const int nwords = N >> 5;
  if (lane == 0) maskrow[nwords] = 0u;
  if (N <= 256) {
    for (int wd = lane; wd < nwords; wd += 64) maskrow[wd] = 0xffffffffu;
    return;
  }
  float v[NR];
#define SEL_LOAD(hf)                                                     \
  {                                                                      \
    _Pragma("unroll") for (int i = 0; i < NR; ++i) {                     \
      const int e = 64 * ((hf) * NR + i) + lane;                         \
      v[i] = (e < N) ? sc[e] : -INFINITY;                                \
    }                                                                    \
  }
  if (NH == 1) {
#pragma unroll
    for (int i = 0; i < NR; ++i) v[i] = vpre[i];
    if (scnext) {
#pragma unroll
      for (int i = 0; i < NR; ++i) {
        const int e = 64 * i + lane;
        vpre[i] = (e < N) ? scnext[e] : -INFINITY;
      }
    }
  }
  float lo = INFINITY, hi = -INFINITY;
#pragma unroll 1
  for (int hf = 0; hf < NH; ++hf) {
    if (NH > 1) SEL_LOAD(hf);
#pragma unroll
    for (int i = 0; i < NR; ++i) {
      hi = fmaxf(hi, v[i]);
      lo = fminf(lo, (v[i] == -INFINITY) ? INFINITY : v[i]);
    }
  }
  lo = wave_min(lo); hi = wave_max(hi);
  int need = 256;
  int T = 0, above = 0;
  float scale = 0.f;
  bool degen = false;
  bool rankmode = false;
  bool first = true;
  for (int iter = 0; iter < 64; ++iter) {
    if (!(lo < hi)) break;
    scale = 1024.f / (hi - lo);
    degen = !(scale < 1.0e37f);
    for (int i = lane; i < 1024; i += 64) hist[i] = 0u;
    wavebar();
    if (first && !degen) {
#pragma unroll 1
      for (int hf = 0; hf < NH; ++hf) {
        if (NH > 1) SEL_LOAD(hf);
#pragma unroll
        for (int i = 0; i < NR; ++i) {
          const int eb = 64 * (hf * NR + i);
          if (eb < N) {
            int bn = (int)((v[i] - lo) * scale);
            bn = bn > 1023 ? 1023 : bn;
            if (eb + 64 <= N) atomicAdd(&hist[bn], 1u);
            else if (eb + lane < N) atomicAdd(&hist[bn], 1u);
          }
        }
      }
    } else {
#pragma unroll 1
      for (int hf = 0; hf < NH; ++hf) {
        if (NH > 1) SEL_LOAD(hf);
#pragma unroll
        for (int i = 0; i < NR; ++i) {
          if (v[i] >= lo && v[i] <= hi) atomicAdd(&hist[sel_bin(v[i], lo, scale, degen)], 1u);
          if ((i & 7) == 7) __builtin_amdgcn_sched_barrier(0);
        }
      }
    }
    wavebar();
    unsigned ssum = 0;
#pragma unroll
    for (int i = 0; i < 16; ++i) ssum += hist[16 * lane + i];
    unsigned x = ssum;
#pragma unroll
    for (int off = 1; off < 64; off <<= 1) {
      const unsigned y = __shfl_down(x, off);
      if (lane + off < 64) x += y;
    }
    const unsigned sufx = x - ssum;
    const bool cross = (sufx < (unsigned)need) && (x >= (unsigned)need);
    int myT = 0, myAbove = 0, myC = 0;
    if (cross) {
      unsigned run = sufx;
      for (int i = 15; i >= 0; --i) {
        const unsigned c = hist[16 * lane + i];
        if (run + c >= (unsigned)need) { myT = 16 * lane + i; myAbove = (int)run; myC = (int)c; break; }
        run += c;
      }
    }
    const unsigned long long bal = __ballot(cross);
    const int src = bal ? (int)__builtin_ctzll(bal) : 0;
    T = __shfl(myT, src); above = __shfl(myAbove, src);
    const int cT = __shfl(myC, src);
    if (cT <= SEL_CAP) { rankmode = true; break; }
    first = false;
    need -= above;
    float nlo = INFINITY, nhi = -INFINITY;
#pragma unroll 1
    for (int hf = 0; hf < NH; ++hf) {
      if (NH > 1) SEL_LOAD(hf);
#pragma unroll
      for (int i = 0; i < NR; ++i) {
        if (v[i] >= lo && v[i] <= hi && sel_bin(v[i], lo, scale, degen) == T) { nlo = fminf(nlo, v[i]); nhi = fmaxf(nhi, v[i]); }
      }
    }
    lo = wave_min(nlo); hi = wave_max(nhi);
  }
  const int pick = rankmode ? need - above : need;
  int running = 0;
  const unsigned long long ltmask = (lane == 0) ? 0ull : (~0ull >> (64 - lane));
  const bool fastfinal = rankmode && first && !degen;
#pragma unroll 1
  for (int hf = 0; hf < NH; ++hf) {
    if (NH > 1) SEL_LOAD(hf);
    int mlo = 0, mhi = 0;
#pragma unroll
    for (int i = 0; i < NR; ++i) {
      const int eb = 64 * (hf * NR + i);
      if (eb < N) {
        const float vv = v[i];
        unsigned long long bs, bc;
        if (fastfinal) {
          int bn = (int)((vv - lo) * scale);
          bn = bn > 1023 ? 1023 : bn;
          bs = __ballot(bn > T);
          bc = __ballot(bn == T);
        } else {
          bool s = vv > hi;
          bool c;
          if (rankmode) {
            const bool inr = (vv >= lo && vv <= hi);
            const int bn = inr ? sel_bin(vv, lo, scale, degen) : -1;
            s = s || (bn > T);
            c = (bn == T);
          } else {
            c = (vv == hi);
          }
          bc = __ballot(c);
          if (!rankmode) {
            const int pos = running + __popcll(bc & ltmask);
            s = s || (c && pos < pick);
          }
          bs = __ballot(s);
        }
        if (bc != 0ull) {
          if (rankmode) {
            const bool c = (bc >> lane) & 1ull;
            const int pos = running + __popcll(bc & ltmask);
            if (c) { candv[pos] = vv; candi[pos] = eb + lane; }
          }
          running += __popcll(bc);
        }
        if (lane == i) { mlo = (int)(unsigned)bs; mhi = (int)(unsigned)(bs >> 32); }
      }
      if ((i & 7) == 7) __builtin_amdgcn_sched_barrier(0);
    }
    {
      const int wd = 2 * (hf * NR + lane);
      if (lane < NR && wd < nwords) {
        maskrow[wd] = (unsigned)mlo;
        if (wd + 1 < nwords) maskrow[wd + 1] = (unsigned)mhi;
      }
    }
  }
#undef SEL_LOAD
  if (rankmode) {
    wavebar();
    const int ncand = running;
    for (int i = lane; i < ncand; i += 64) {
      const float vi = candv[i];
      const int ii = candi[i];
      int rank = 0;
      for (int j = 0; j < ncand; ++j) {
        const float vj = candv[j];
        const int ij = candi[j];
        rank += ((vj > vi) || (vj == vi && ij < ii)) ? 1 : 0;
      }
      if (rank < pick) atomicOr(&maskrow[ii >> 5], 1u << (ii & 31));
    }
  }
  wavebar();
}

template <bool SAMPLE>
DI void dsa_item(const P& p, int b, int tok0, int qpos0, int nkeys, float* sc, int scs,
                         char* smem, const int tid, unsigned* ctr, int& nxt) {
  const int lane = tid & 63, w = tid >> 6;
  const int r = lane & 31, hh = lane >> 5;
  const int NT = (nkeys + 63) >> 6;
  unsigned* sMask = (unsigned*)(smem + 73728);
  float* sBias = (float*)(smem + 73728 + 32 * MASK_W * 4);
  if (tid < 256) sBias[tid] = p.rel_bias[tid] * LOG2E;
  {
    constexpr int LS = 72;
    h16* sKI = (h16*)smem;
    const int NTA = (nkeys + 127) >> 7;
    h8 ai[4];
    {
      const int aq = ((r >> 2) & 1) * 2 + (r >> 4), ah = (r & 3) + 4 * ((r >> 3) & 1);
      const h16* qp = p.QI + ((size_t)(tok0 + 4 * w + aq) * 8 + ah) * 64 + 8 * hh;
#pragma unroll
      for (int t = 0; t < 4; ++t) ai[t] = *(const h8*)(qp + 16 * t);
    }
    float w16[16];
#pragma unroll
    for (int i = 0; i < 16; ++i)
      w16[i] = p.WI[(size_t)(tok0 + 4 * w + 2 * hh + (i >> 3)) * 8 + (i & 3) + 4 * ((i >> 2) & 1)];
    h8 sh[2];
    float4 sf[2][2];
#define KI_GLOAD(kt)                                                                                  \
  {                                                                                                   \
    _Pragma("unroll") for (int i = 0; i < 2; ++i) {                                                   \
      const int q = tid + NBLK_THREADS * i;                                                           \
      const int s = (kt) * 128 + (q >> 3), lcc = q & 7;                                               \
      if (!SAMPLE) {                                                                                  \
        sh[i] = (s < nkeys) ? *(const h8*)(p.KI + (size_t)(b * 2048 + s) * 64 + lcc * 8) : zero8();   \
      } else if (s < PAST) {                                                                          \
        const float* src = p.c_kidx + ((size_t)(b * PAST + s) * 64 + lcc * 8);                        \
        sf[i][0] = *(const float4*)src; sf[i][1] = *(const float4*)(src + 4);                         \
      } else if (s < SKEYS) {                                                                         \
        sf[i][0] = __builtin_bit_cast(float4, *(const h8*)(p.KI + (size_t)(NP + b * 32 + (s - PAST)) * 64 + lcc * 8)); \
      } else {                                                                                        \
        sf[i][0] = make_float4(0.f, 0.f, 0.f, 0.f);                                                   \
      }                                                                                               \
    }                                                                                                 \
  }
#define KI_SSTORE(kt, buf)                                                                            \
  {                                                                                                   \
    _Pragma("unroll") for (int i = 0; i < 2; ++i) {                                                   \
      const int q = tid + NBLK_THREADS * i;                                                           \
      const int s = (kt) * 128 + (q >> 3), lcc = q & 7;                                               \
      h8 v;                                                                                           \
      if (SAMPLE) v = (s < PAST) ? cvt8(sf[i][0], sf[i][1]) : __builtin_bit_cast(h8, sf[i][0]);       \
      else v = sh[i];                                                                                 \
      *(h8*)(sKI + ((buf) * 128 + (q >> 3)) * LS + lcc * 8) = v;                                      \
    }                                                                                                 \
  }
    KI_GLOAD(0);
#pragma unroll
    for (int t = 0; t < 4; ++t) pin8(ai[t]);
#pragma unroll
    for (int i = 0; i < 16; ++i) pinf(w16[i]);
    KI_SSTORE(0, 0);
    __syncthreads();
    int buf = 0;
    for (int kt = 0; kt < NTA; ++kt) {
      if (kt + 1 < NTA) KI_GLOAD(kt + 1);
      const h16* kbase = sKI + buf * 128 * LS + r * LS + 8 * hh;
#pragma unroll
      for (int sub = 0; sub < 4; ++sub) {
        const int key0 = kt * 128 + 32 * sub;
        if (key0 < nkeys) {
          f16v D;
#pragma unroll
          for (int i = 0; i < 16; ++i) D[i] = 0.f;
#pragma unroll
          for (int t = 0; t < 4; ++t) {
            const h8 bf = *(const h8*)(kbase + 32 * sub * LS + 16 * t);
            D = MFMA32(ai[t], bf, D);
          }
          float ps0 = 0.f, ps1 = 0.f;
#pragma unroll
          for (int i = 0; i < 8; ++i) {
            ps0 = fmaf(fmaxf(D[i], 0.f), w16[i], ps0);
            ps1 = fmaf(fmaxf(D[8 + i], 0.f), w16[8 + i], ps1);
          }
          float* so = sc + (size_t)(4 * w + 2 * hh) * scs + key0 + r;
          so[0] = ps0;
          so[scs] = ps1;
        }
      }
      if (kt + 1 < NTA) KI_SSTORE(kt + 1, buf ^ 1);
      __syncthreads();
      buf ^= 1;
    }
#undef KI_GLOAD
#undef KI_SSTORE
  }
    constexpr int LS = 136;
    h16* sKb = (h16*)smem;
    h16* sVb = sKb + 2 * 64 * LS;
    const int kv = w >> 2, ql = 8 * (w & 3) + (r >> 2), g = r & 3, head = 4 * kv + g;
    const int i16 = lane & 15, q4 = i16 >> 2, p4 = i16 & 3, blk = (lane >> 4) & 1;
    const int tq = tok0 + ql;
    const int pq = qpos0 + ql;
    h8 qf[4];
#define DSA_QLOAD                                                                  \
    {                                                                              \
      const h16* qp = p.QB + (size_t)tq * 512 + head * 64 + 8 * hh;                \
      _Pragma("unroll") for (int t = 0; t < 4; ++t) qf[t] = *(const h8*)(qp + 16 * t); \
    }
    if (!SAMPLE) DSA_QLOAD;
    h8 sh[4];
    float4 sf[4][2];
#define KV_GLOAD(kt)                                                                                   \
  {                                                                                                    \
    _Pragma("unroll") for (int i = 0; i < 4; ++i) {                                                    \
      const int q = tid + NBLK_THREADS * i;                                                            \
      const int row = q >> 5, cc = q & 31, c16 = cc & 15;                                              \
      const int s = (kt) * 64 + row;                                                                   \
      if (!SAMPLE) {                                                                                   \
        sh[i] = *(const h8*)(((cc < 16) ? p.KB : p.VB) + (size_t)(b * 2048 + s) * 128 + c16 * 8);      \
      } else if (s < PAST) {                                                                           \
        const float* src = ((cc < 16) ? p.c_k : p.c_v) + ((size_t)(b * PAST + s) * 128 + c16 * 8);     \
        sf[i][0] = *(const float4*)src; sf[i][1] = *(const float4*)(src + 4);                          \
      } else if (s < SKEYS) {                                                                          \
        sf[i][0] = __builtin_bit_cast(float4, *(const h8*)(((cc < 16) ? p.KB : p.VB) + (size_t)(NP + b * 32 + (s - PAST)) * 128 + c16 * 8)); \
      } else {                                                                                         \
        sf[i][0] = make_float4(0.f, 0.f, 0.f, 0.f);                                                    \
      }                                                                                                \
    }                                                                                                  \
  }
#define KV_SSTORE(kt, buf)                                                                             \
  {                                                                                                    \
    _Pragma("unroll") for (int i = 0; i < 4; ++i) {                                                    \
      const int q = tid + NBLK_THREADS * i;                                                            \
      const int row = q >> 5, cc = q & 31, c16 = cc & 15;                                              \
      const int s = (kt) * 64 + row;                                                                   \
      h8 v;                                                                                            \
      if (SAMPLE) v = (s < PAST) ? cvt8(sf[i][0], sf[i][1]) : __builtin_bit_cast(h8, sf[i][0]);        \
      else v = sh[i];                                                                                  \
      *(h8*)(((cc < 16) ? sKb : sVb) + ((buf) * 64 + row) * LS + c16 * 8) = v;                         \
    }                                                                                                  \
  }
    if (!SAMPLE) KV_GLOAD(0);
  __syncthreads();
  {
    unsigned* hist = (unsigned*)(smem + w * 8192);
    float* candv = (float*)(smem + w * 8192 + 4096);
    int* candi = (int*)(smem + w * 8192 + 4096 + 1024);
    constexpr int SNR = SAMPLE ? 33 : 32;
    float vpre[SNR];
    if (!SAMPLE && nkeys > 256) {
#pragma unroll
      for (int i = 0; i < SNR; ++i) {
        const int e = 64 * i + lane;
        vpre[i] = (e < nkeys) ? sc[(size_t)(4 * w) * scs + e] : -INFINITY;
      }
    } else {
#pragma unroll
      for (int i = 0; i < SNR; ++i) vpre[i] = 0.f;
    }
#pragma unroll 1
    for (int qw = 0; qw < 4; ++qw) {
      const int ql = 4 * w + qw;
      wave_select<SNR, SAMPLE ? 2 : 1>(sc + (size_t)ql * scs, nkeys, sMask + ql * MASK_W, hist, candv, candi, lane, vpre,
                                      (qw < 3) ? sc + (size_t)(ql + 1) * scs : (const float*)nullptr);
    }
  }
  __syncthreads();
  {
    const float bias_far = sBias[15 * 8 + head];
    f16v O[2];
#pragma unroll
    for (int dt = 0; dt < 2; ++dt)
#pragma unroll
      for (int i = 0; i < 16; ++i) O[dt][i] = 0.f;
    float m = -1.0e29f, l = 0.f;
    if (SAMPLE) { DSA_QLOAD; KV_GLOAD(0); }
#undef DSA_QLOAD
#pragma unroll
    for (int t = 0; t < 4; ++t) pin8(qf[t]);
    KV_SSTORE(0, 0);
    __syncthreads();
    int buf = 0;
    for (int kt = 0; kt < NT; ++kt) {
      if (kt + 1 < NT) KV_GLOAD(kt + 1);
      const h16* ka_ptr = sKb + buf * 64 * LS + 64 * kv + r * LS + 8 * hh;
      const h16* vb_ptr = sVb + buf * 64 * LS + 64 * kv + (4 * hh + q4) * LS + 16 * blk + 4 * p4;
      const bool nearb = (qpos0 - (kt * 64 + 63)) < 91;
      const unsigned mw0 = sMask[ql * MASK_W + kt * 2] >> (4 * hh);
      const unsigned mw1 = sMask[ql * MASK_W + kt * 2 + 1] >> (4 * hh);
      f16v S0, S1;
      if (!nearb) {
        const int bb = __float_as_int(bias_far), nb = __float_as_int(NEGBIG);
#pragma unroll
        for (int i = 0; i < 16; ++i) {
          const int t0 = __builtin_amdgcn_sbfe((int)mw0, (i & 3) + 8 * (i >> 2), 1);
          const int t1 = __builtin_amdgcn_sbfe((int)mw1, (i & 3) + 8 * (i >> 2), 1);
          S0[i] = __int_as_float((t0 & bb) | (~t0 & nb));
          S1[i] = __int_as_float((t1 & bb) | (~t1 & nb));
        }
      } else {
#pragma unroll
        for (int ks = 0; ks < 2; ++ks) {
#pragma unroll
          for (int i = 0; i < 16; ++i) {
            const int pk = kt * 64 + 32 * ks + crow(i, hh);
            const int rel = pk - pq;
            const int n = rel < 0 ? -rel : rel;
            int bk = n;
            if (n >= 8)
              bk = 8 + (n >= 12) + (n >= 16) + (n >= 23) + (n >= 32) + (n >= 46) + (n >= 64) + (n >= 91);
            if (rel > 0) bk += 16;
            const bool sel = ((ks ? mw1 : mw0) >> ((i & 3) + 8 * (i >> 2))) & 1u;
            const float v = sel ? sBias[bk * 8 + head] : NEGBIG;
            if (ks) S1[i] = v; else S0[i] = v;
          }
        }
      }
      {
        h8 ka0[2], ka1[2];
#pragma unroll
        for (int t = 0; t < 2; ++t) {
          ka0[t] = *(const h8*)(ka_ptr + 16 * t);
          ka1[t] = *(const h8*)(ka_ptr + 32 * LS + 16 * t);
        }
#pragma unroll
        for (int t = 0; t < 4; ++t) {
          S0 = MFMA32(ka0[t & 1], qf[t], S0);
          S1 = MFMA32(ka1[t & 1], qf[t], S1);
          if (t + 2 < 4) {
            ka0[t & 1] = *(const h8*)(ka_ptr + 16 * (t + 2));
            ka1[t & 1] = *(const h8*)(ka_ptr + 32 * LS + 16 * (t + 2));
          }
        }
      }
      h8 vf[4];
#define DSA_VLOAD(f)                                                                              \
  {                                                                                               \
    const h16* vp = vb_ptr + ((((f) >> 2) * 32) + ((((f) >> 1) & 1) * 16)) * LS + 32 * ((f) & 1); \
    vf[(f) & 3] = cat8(trread(vp), trread(vp + 8 * LS));                                          \
  }
#pragma unroll
      for (int f = 0; f < 4; ++f) DSA_VLOAD(f);
      mfma_settle();
      float mx = max3f(S0[0], S0[1], S1[0]);
      mx = max3f(mx, S1[1], S0[2]);
#pragma unroll
      for (int i = 2; i < 15; ++i) mx = max3f(mx, S1[i], S0[i + 1]);
      mx = fmaxf(mx, S1[15]);
      mx = fmaxf(mx, __shfl_xor(mx, 32));
      if (__any(mx > m)) {
        const float mn = fmaxf(m, mx);
        const float alpha = fast_exp2(m - mn);
        m = mn;
        l *= alpha;
#pragma unroll
        for (int dt = 0; dt < 2; ++dt)
#pragma unroll
          for (int i = 0; i < 16; ++i) O[dt][i] *= alpha;
      }
      {
        const f2v m2 = {m, m};
        f2v rs2 = {0.f, 0.f};
#pragma unroll
        for (int i = 0; i < 16; i += 2) {
          f2v a = {S0[i], S0[i + 1]};
          f2v c = {S1[i], S1[i + 1]};
          a -= m2; c -= m2;
          a[0] = fast_exp2(a[0]); a[1] = fast_exp2(a[1]);
          c[0] = fast_exp2(c[0]); c[1] = fast_exp2(c[1]);
          rs2 += a; rs2 += c;
          S0[i] = a[0]; S0[i + 1] = a[1]; S1[i] = c[0]; S1[i + 1] = c[1];
        }
        l += rs2[0] + rs2[1];
      }
      h8 pb[4];
#pragma unroll
      for (int gg = 0; gg < 4; ++gg)
#pragma unroll
        for (int jj = 0; jj < 8; ++jj) pb[gg][jj] = (h16)((gg < 2) ? S0[8 * (gg & 1) + jj] : S1[8 * (gg & 1) + jj]);
#pragma unroll
      for (int f = 0; f < 8; ++f) {
        O[f & 1] = MFMA32(vf[f & 3], pb[f >> 1], O[f & 1]);
        if (f + 4 < 8) DSA_VLOAD(f + 4);
      }
#undef DSA_VLOAD
      if (kt + 1 < NT) KV_SSTORE(kt + 1, buf ^ 1);
      __syncthreads();
      buf ^= 1;
    }
#undef KV_GLOAD
#undef KV_SSTORE
    if (threadIdx.x == 0) nxt = (int)atomicAdd(ctr, 1u);
    const float inv = 1.f / (l + __shfl_xor(l, 32));
    h16* Ot = (h16*)smem + w * (8 * 264);
    {
      const int q8 = r >> 2;
#pragma unroll
      for (int dt = 0; dt < 2; ++dt) {
#pragma unroll
        for (int g4 = 0; g4 < 4; ++g4) {
          h4 o;
#pragma unroll
          for (int j = 0; j < 4; ++j) o[j] = (h16)(O[dt][4 * g4 + j] * inv);
          *(h4*)(Ot + q8 * 264 + g * 64 + 32 * dt + 8 * g4 + 4 * hh) = o;
        }
      }
    }
    wavebar();
#pragma unroll
    for (int i = 0; i < 4; ++i) {
      const int q = lane + 64 * i;
      const int row = q >> 5, ch = q & 31;
      const int tk = tok0 + 8 * (w & 3) + row;
      const h8 y = *(const h8*)(Ot + row * 264 + ch * 8);
      const h8 gb = *(const h8*)(p.GB + (size_t)tk * 512 + kv * 256 + ch * 8);
      h8 o;
#pragma unroll
      for (int j = 0; j < 8; ++j) o[j] = (h16)((float)y[j] * (float)gb[j]);
      *(h8*)(p.mix + (size_t)tk * 1024 + 512 + kv * 256 + ch * 8) = o;
    }
  }
  __syncthreads();
}

#define ITEMS_PER_Q 136
DI void phase2(const P& p, char* smem, int cidx = 0) {
  volatile int& s_item = *(volatile int*)(smem + SMEM_BYTES - 16);
  const int xq = blockIdx.x & 7;
  unsigned* ctr = &p.counters[cidx * 8 + xq];
  if (threadIdx.x == 0) s_item = (int)atomicAdd(ctr, 1u);
  __syncthreads();
  int item = s_item;
  while (item < ITEMS_PER_Q) {
    int nxt = 0;
    const int tid = opaque_tid();
    if (item < 4) {
      const int b = xq + 8 * item;
      mla_item<true>(p, b, NP + b * 32, SKEYS, smem, tid, ctr, nxt);
    } else if (item < 8) {
      const int b = xq + 8 * (item - 4);
      dsa_item<true>(p, b, NP + b * 32, PAST, SKEYS, p.scS + (size_t)b * 32 * SC_STRIDE_S, SC_STRIDE_S, smem, tid, ctr, nxt);
    } else {
      const int k = item - 8;
      const int kind = k & 1, sub = (k >> 1) & 1, b = xq, c = 31 - (k >> 2);
      const int tok0 = b * 2048 + c * 64 + sub * 32;
      const int nkeys = 64 * (c + 1);
      if (kind == 0) mla_item<false>(p, b, tok0, nkeys, smem, tid, ctr, nxt);
      else dsa_item<false>(p, b, tok0, c * 64 + sub * 32, nkeys, p.scP + (size_t)blockIdx.x * 32 * SC_STRIDE_P,
                           SC_STRIDE_P, smem, tid, ctr, nxt);
    }
    if (threadIdx.x == 0) s_item = nxt;
    __syncthreads();
    item = s_item;
    __syncthreads();
  }
}

template <int BM>
DI void p3_epilogue(const P& p, const h16* T, int m0, int n0) {
  constexpr int TS = 136;
  const int tid = opaque_tid();
  constexpr int NIT = BM / 32;
  float4 x0[NIT], x1[NIT];
#pragma unroll
  for (int it = 0; it < NIT; ++it) {
    const int q = tid + NBLK_THREADS * it;
    const int m = m0 + (q >> 4), n = n0 + (q & 15) * 8;
    const float* xr = (m < NP ? p.x_p + (size_t)m * DM : p.x_s + (size_t)(m - NP) * DM) + n;
    x0[it] = *(const float4*)xr; x1[it] = *(const float4*)(xr + 4);
  }
#pragma unroll
  for (int it = 0; it < NIT; ++it) {
    const int q = tid + NBLK_THREADS * it;
    const int row = q >> 4, ch = q & 15;
    const int m = m0 + row, n = n0 + ch * 8;
    const h8 v = *(const h8*)(T + row * TS + ch * 8);
    h8 o;
    o[0] = (h16)(x0[it].x + (float)v[0]); o[1] = (h16)(x0[it].y + (float)v[1]);
    o[2] = (h16)(x0[it].z + (float)v[2]); o[3] = (h16)(x0[it].w + (float)v[3]);
    o[4] = (h16)(x1[it].x + (float)v[4]); o[5] = (h16)(x1[it].y + (float)v[5]);
    o[6] = (h16)(x1[it].z + (float)v[6]); o[7] = (h16)(x1[it].w + (float)v[7]);
    *(h8*)(p.XN + (size_t)m * DM + n) = o;
  }
}
DI void phase3(const P& p, char* smem) {
  constexpr int TS = 136;
  h16* T = (h16*)smem;
  for (int tile = blockIdx.x; tile < 256; tile += gridDim.x) {
    const int xcd = tile & 7, idx = tile >> 3;
    const int mt = xcd * 8 + (idx >> 2), pn = idx & 3;
    const int m0 = mt * 256;
    f32x4 acc[2][2][4][2];
    gemm8_mainloop(p.mix, p.Wt_out, DM, m0, pn * 256, smem, acc);
    __syncthreads();
    const int tid = opaque_tid();
    const int wid = tid >> 6, lane = tid & 63, wr = wid >> 2, wc = wid & 3, fr = lane & 15, fq = lane >> 4;
#pragma unroll
    for (int bj = 0; bj < 2; ++bj) {
#pragma unroll
      for (int ai = 0; ai < 2; ++ai)
#pragma unroll
        for (int m = 0; m < 4; ++m)
#pragma unroll
          for (int n = 0; n < 2; ++n)
          {
            h4 o;
#pragma unroll
            for (int jj = 0; jj < 4; ++jj) o[jj] = (h16)acc[ai][bj][m][n][jj];
            *(h4*)(T + (ai * 128 + wr * 64 + m * 16 + fr) * TS + wc * 32 + n * 16 + fq * 4) = o;
          }
      __syncthreads();
      p3_epilogue<256>(p, T, m0, pn * 256 + bj * 128);
      __syncthreads();
    }
  }
  for (int tile = blockIdx.x; tile < 128; tile += gridDim.x) {
    const int m0 = NP + (tile >> 3) * 64, n0 = (tile & 7) * 128;
    gemm_tile<64, 128, 2, 4>(p.mix, 1024, p.Wt_out, 1024, 1024, m0, n0, smem);
    p3_epilogue<64>(p, T, m0, n0);
    __syncthreads();
  }
}

DI void phase4(const P& p) {
  const int tid = opaque_tid(), lane = tid & 63, w = tid >> 6;
  const int gw = blockIdx.x * 8 + w, nw = gridDim.x * 8;
  for (int k0 = 0; gw + nw * k0 < NTOK; k0 += 5) {
    h4 v[5][4];
    float ss[5];
#pragma unroll
    for (int rr = 0; rr < 5; ++rr) {
      const int row = gw + nw * (k0 + rr);
#pragma unroll
      for (int k = 0; k < 4; ++k) {
        if (row < NTOK) v[rr][k] = *(const h4*)(p.XN + (size_t)row * DM + 4 * lane + 256 * k);
        else { v[rr][k][0] = (h16)0.f; v[rr][k][1] = (h16)0.f; v[rr][k][2] = (h16)0.f; v[rr][k][3] = (h16)0.f; }
      }
    }
#pragma unroll
    for (int rr = 0; rr < 5; ++rr) {
      float a = 0.f;
#pragma unroll
      for (int k = 0; k < 4; ++k)
#pragma unroll
        for (int e = 0; e < 4; ++e) a += (float)v[rr][k][e] * (float)v[rr][k][e];
      ss[rr] = a;
    }
#pragma unroll
    for (int off = 32; off > 0; off >>= 1) {
#pragma unroll
      for (int rr = 0; rr < 5; ++rr) ss[rr] += __shfl_xor(ss[rr], off);
    }
    float4 g[4];
#pragma unroll
    for (int k = 0; k < 4; ++k) g[k] = *(const float4*)(p.fn_g + 4 * lane + 256 * k);
#pragma unroll
    for (int rr = 0; rr < 5; ++rr) {
      const int row = gw + nw * (k0 + rr);
      if (row < NTOK) {
        const float rstd = rsqrtf(ss[rr] * (1.f / 1024.f) + 1e-6f);
        float* o = p.out + (size_t)row * DM;
#pragma unroll
        for (int k = 0; k < 4; ++k)
          *(float4*)(o + 4 * lane + 256 * k) = make_float4((float)v[rr][k][0] * rstd * g[k].x, (float)v[rr][k][1] * rstd * g[k].y,
                                                           (float)v[rr][k][2] * rstd * g[k].z, (float)v[rr][k][3] * rstd * g[k].w);
      }
    }
  }
}

__global__ void __launch_bounds__(NBLK_THREADS) mega_kernel(P p) {
  __shared__ __attribute__((aligned(16))) char smem[SMEM_BYTES];
  XBar xb;
  xb.w = p.counters;
  xb.x = (unsigned)__builtin_amdgcn_s_getreg((3 << 11) | 20) & 0xFu;
  xb.nloc = 0u; xb.nx = 0u;
  if (threadIdx.x == 0) __hip_atomic_fetch_add(&xb.w[XB_CNT(xb.x)], 1u, __ATOMIC_RELAXED, __HIP_MEMORY_SCOPE_AGENT);
  phase0(p, smem);
  xcd_barrier(xb, 1u, smem);
  phase1(p, smem);
  xcd_barrier(xb, 2u, smem);
  phase1b(p, smem);
  xcd_barrier(xb, 3u, smem);
  phase2(p, smem);
  xcd_barrier(xb, 4u, smem);
  phase3(p, smem);
  xcd_barrier(xb, 5u, smem);
  phase4(p);
}

extern "C" void kernel_launch(void* const* d_in, const int* in_sizes, int n_in, void* d_out, int out_size, void* d_ws,
                              size_t ws_size, hipStream_t stream) {
  P p{};
  p.x_p = (const float*)d_in[0];
  p.x_s = (const float*)d_in[1];
  p.c_ckv = (const float*)d_in[2];
  p.c_kpe = (const float*)d_in[3];
  p.c_k = (const float*)d_in[4];
  p.c_v = (const float*)d_in[5];
  p.c_kidx = (const float*)d_in[6];
  p.norm_g = (const float*)d_in[7];
  p.w_in = (const float*)d_in[8];
  p.qn_g = (const float*)d_in[9];
  p.kvn_g = (const float*)d_in[10];
  p.w_uq = (const float*)d_in[11];
  p.w_uk = (const float*)d_in[12];
  p.w_uv = (const float*)d_in[13];
  p.rel_bias = (const float*)d_in[14];
  p.w_out = (const float*)d_in[15];
  p.fn_g = (const float*)d_in[16];
  p.out = (float*)d_out;

  char* ws = (char*)d_ws;
  size_t off = 0;
  auto carve = [&](size_t bytes) {
    char* r = ws + off;
    off += (bytes + 255) & ~(size_t)255;
    return r;
  };
  p.counters = (unsigned*)carve(XB_WORDS * 4);
  p.hX = (h16*)carve((size_t)NTOK * DM * 2);
  p.mix = p.hX;
  p.scP = (float*)carve((size_t)256 * 32 * SC_STRIDE_P * 4);
  p.CQ = (h16*)carve((size_t)NTOK * 256 * 2);
  p.Wt_in = (h16*)carve((size_t)INWP * DM * 2);
  p.Wt_out = (h16*)carve((size_t)DM * DM * 2);
  p.Wq = (h16*)carve((size_t)1280 * 256 * 2);
  p.Wuv = (h16*)carve((size_t)8 * 64 * 128 * 2);
  p.QM = (h16*)carve((size_t)NTOK * 1280 * 2);
  p.XN = (h16*)carve((size_t)NTOK * DM * 2);
  p.KM = (h16*)carve((size_t)NTOK * 160 * 2);
  p.GA = (h16*)carve((size_t)NTOK * 512 * 2);
  p.GB = (h16*)carve((size_t)NTOK * 512 * 2);
  p.QB = (h16*)carve((size_t)NTOK * 512 * 2);
  p.KB = (h16*)carve((size_t)NTOK * 128 * 2);
  p.VB = (h16*)carve((size_t)NTOK * 128 * 2);
  p.QI = (h16*)carve((size_t)NTOK * 512 * 2);
  p.KI = (h16*)carve((size_t)NTOK * 64 * 2);
  p.WI = (float*)carve((size_t)NTOK * 8 * 4);
  p.RQP = (float*)carve((size_t)NTOK * 2 * 4);
  p.ropeC = (float*)carve((size_t)2080 * 16 * 4);
  p.ropeS = (float*)carve((size_t)2080 * 16 * 4);
  p.scS = (float*)carve((size_t)32 * 32 * SC_STRIDE_S * 4);
  if (off > ws_size) {
    fprintf(stderr, "workspace too small: need %zu have %zu\n", off, ws_size);
    return;
  }
  static int grid_blocks = 0;
  if (!grid_blocks) {
    int dev = 0, cus = 0, per_cu = 0;
    hipGetDevice(&dev);
    hipDeviceGetAttribute(&cus, hipDeviceAttributeMultiprocessorCount, dev);
    hipOccupancyMaxActiveBlocksPerMultiprocessor(&per_cu, mega_kernel, NBLK_THREADS, 0);
    if (per_cu > 1) per_cu = 1;
    grid_blocks = cus * per_cu;
    if (grid_blocks > 256) grid_blocks = 256;
  }
  hipMemsetAsync(p.counters, 0, XB_WORDS * 4, stream);
  hipLaunchKernelGGL(mega_kernel, dim3(grid_blocks), dim3(NBLK_THREADS), 0, stream, p);
}
```

```cpp
#include <hip/hip_runtime.h>
#include <stdint.h>
#include <stdio.h>

typedef _Float16 h16;
typedef h16 h8 __attribute__((ext_vector_type(8)));
typedef h16 h4 __attribute__((ext_vector_type(4)));
typedef h16 h2 __attribute__((ext_vector_type(2)));
typedef float f16v __attribute__((ext_vector_type(16)));
typedef short s4v __attribute__((vector_size(8)));
typedef __attribute__((address_space(3))) s4v* lds_s4p;

#define DI __device__ __forceinline__
#define MFMA32(a, b, c) __builtin_amdgcn_mfma_f32_32x32x16_f16((a), (b), (c), 0, 0, 0)

#define NTOK 17408
#define NP 16384
#define DM 1024
#define INW 2792
#define INWP 2816
#define PAST 4096
#define SKEYS 4128
#define NBLK_THREADS 512

#define OFF_Y 0
#define OFF_P_CKV 17825792
#define OFF_P_KPE 19922944
#define OFF_P_K 20447232
#define OFF_P_V 22544384
#define OFF_P_KIDX 24641536
#define OFF_S_CKV 25690112
#define OFF_S_KPE 25821184
#define OFF_S_K 25853952
#define OFF_S_V 25985024
#define OFF_S_KIDX 26116096

#define ZC_CQ 0
#define ZC_CKV 256
#define ZC_KPE 384
#define ZC_GA 416
#define ZC_QB 928
#define ZC_KB 1440
#define ZC_VB 1568
#define ZC_QI 1696
#define ZC_KI 2208
#define ZC_WI 2272
#define ZC_GB 2280

#define LOG2E 1.4426950408889634f
#define QM_SCALE 0.14724444602590306f
#define QB_SCALE 0.18033688011112042f
#define WI_SCALE 0.04419417382415922f
#define NEGBIG (-1.0e30f)

#define SMEM_BYTES 131072
#define SC_STRIDE_P 2048
#define SC_STRIDE_S 4160
#define MASK_W 132
#define N_ITEMS 1088

struct P {
  const float *x_p, *x_s, *c_ckv, *c_kpe, *c_k, *c_v, *c_kidx, *norm_g, *w_in, *qn_g, *kvn_g, *w_uq, *w_uk, *w_uv,
      *rel_bias, *w_out, *fn_g;
  float* out;
  h16 *hX, *CQ, *Wt_in, *Wt_out, *Wq, *Wuv, *QM, *KM, *GA, *GB, *QB, *KB, *VB, *QI, *KI, *mix, *XN;
  float *WI, *ropeC, *ropeS, *scP, *scS, *RQP;
  unsigned* counters;
};

DI int crow(int i, int hh) { return (i & 3) + 8 * (i >> 2) + 4 * hh; }
DI float wave_sum(float v) {
#pragma unroll
  for (int off = 32; off > 0; off >>= 1) v += __shfl_xor(v, off);
  return v;
}
DI float wave_max(float v) {
#pragma unroll
  for (int off = 32; off > 0; off >>= 1) v = fmaxf(v, __shfl_xor(v, off));
  return v;
}
DI float wave_min(float v) {
#pragma unroll
  for (int off = 32; off > 0; off >>= 1) v = fminf(v, __shfl_xor(v, off));
  return v;
}
DI h4 trread(const h16* p) {
  s4v r = __builtin_amdgcn_ds_read_tr16_b64_v4i16((lds_s4p)(p));
  return __builtin_bit_cast(h4, r);
}
DI h8 cat8(h4 a, h4 b) { return __builtin_shufflevector(a, b, 0, 1, 2, 3, 4, 5, 6, 7); }
DI h8 cvt8(float4 a, float4 b) {
  h8 r;
  r[0] = (h16)a.x; r[1] = (h16)a.y; r[2] = (h16)a.z; r[3] = (h16)a.w;
  r[4] = (h16)b.x; r[5] = (h16)b.y; r[6] = (h16)b.z; r[7] = (h16)b.w;
  return r;
}
DI h8 zero8() { h8 r; for (int i = 0; i < 8; ++i) r[i] = (h16)0.f; return r; }
DI float fast_exp2(float x) { return __builtin_amdgcn_exp2f(x); }
DI float silu(float x) { return x * __builtin_amdgcn_rcpf(1.f + __expf(-x)); }
DI int rope_idx(int t) { return t < NP ? (t & 2047) : 2048 + ((t - NP) & 31); }
DI int opaque_tid() { int t = threadIdx.x; asm volatile("" : "+v"(t)); return t; }
#define XB_CNT(x) (256 + 64 * (x))
#define XB_ARR(x) (256 + 64 * (16 + (x)))
#define XB_GEN(x) (256 + 64 * (32 + (x)))
#define XB_TOP (256 + 64 * 48)
#define XB_WORDS (256 + 64 * 49)
DI unsigned xb_ld(unsigned* q) { return __hip_atomic_load(q, __ATOMIC_RELAXED, __HIP_MEMORY_SCOPE_AGENT); }
struct XBar { unsigned* w; unsigned x, nloc, nx; };
DI void xcd_barrier(XBar& xb, unsigned k, char* smem) {
  asm volatile("s_waitcnt vmcnt(0)" ::: "memory");
  __syncthreads();
  volatile unsigned* bc = (volatile unsigned*)(smem + SMEM_BYTES - 64);
  if (threadIdx.x == 0) {
    if (k == 1u) {
      const unsigned G = gridDim.x;
      unsigned sum, nxx;
      do {
        sum = 0u; nxx = 0u;
        for (int j = 0; j < 16; ++j) { const unsigned c = xb_ld(&xb.w[XB_CNT(j)]); sum += c; nxx += (c != 0u); }
        if (sum != G) __builtin_amdgcn_s_sleep(2);
      } while (sum != G);
      bc[0] = xb_ld(&xb.w[XB_CNT(xb.x)]);
      bc[1] = nxx;
    }
  }
  if (k == 1u) {
    __syncthreads();
    xb.nloc = (unsigned)__builtin_amdgcn_readfirstlane((int)bc[0]);
    xb.nx = (unsigned)__builtin_amdgcn_readfirstlane((int)bc[1]);
  }
  if (threadIdx.x == 0) {
    const unsigned old = __hip_atomic_fetch_add(&xb.w[XB_ARR(xb.x)], 1u, __ATOMIC_RELAXED, __HIP_MEMORY_SCOPE_AGENT);
    if (old + 1u == k * xb.nloc) {
      __builtin_amdgcn_fence(__ATOMIC_RELEASE, "agent");
      asm volatile("s_waitcnt vmcnt(0)" ::: "memory");
      __hip_atomic_fetch_add(&xb.w[XB_TOP], 1u, __ATOMIC_RELAXED, __HIP_MEMORY_SCOPE_AGENT);
      while (xb_ld(&xb.w[XB_TOP]) < k * xb.nx) __builtin_amdgcn_s_sleep(1);
      __hip_atomic_store(&xb.w[XB_GEN(xb.x)], k, __ATOMIC_RELAXED, __HIP_MEMORY_SCOPE_AGENT);
    } else {
      while (xb_ld(&xb.w[XB_GEN(xb.x)]) < k) __builtin_amdgcn_s_sleep(1);
    }
    __builtin_amdgcn_fence(__ATOMIC_ACQUIRE, "agent");
    asm volatile("s_waitcnt vmcnt(0)" ::: "memory");
  }
  __syncthreads();
}
DI void grid_barrier(unsigned* bar, unsigned target) {
  asm volatile("s_waitcnt vmcnt(0)" ::: "memory");
  __syncthreads();
  if (threadIdx.x == 0) {
    __builtin_amdgcn_fence(__ATOMIC_RELEASE, "agent");
    asm volatile("s_waitcnt vmcnt(0)" ::: "memory");
    __hip_atomic_fetch_add(bar, 1u, __ATOMIC_RELAXED, __HIP_MEMORY_SCOPE_AGENT);
    while (__hip_atomic_load(bar, __ATOMIC_RELAXED, __HIP_MEMORY_SCOPE_AGENT) < target) __builtin_amdgcn_s_sleep(2);
    __builtin_amdgcn_fence(__ATOMIC_ACQUIRE, "agent");
    asm volatile("s_waitcnt vmcnt(0)" ::: "memory");
  }
  __syncthreads();
}
typedef float f2v __attribute__((ext_vector_type(2)));
DI float max3f(float a, float b, float c) {
  float d;
  asm("v_max3_f32 %0, %1, %2, %3" : "=v"(d) : "v"(a), "v"(b), "v"(c));
  return d;
}
DI void mfma_settle() {
  __builtin_amdgcn_sched_barrier(0);
  asm volatile("s_nop 7\n\ts_nop 7");
  __builtin_amdgcn_sched_barrier(0);
}
DI void pin8(const h8& v) { asm volatile("" ::"v"(v)); }
DI void pinf(const float& v) { asm volatile("" ::"v"(v)); }
DI void wavebar() { asm volatile("s_waitcnt lgkmcnt(0)" ::: "memory"); }

__constant__ float c_inv_freq[16] = {1.000000000e+00f, 5.623413324e-01f, 3.162277639e-01f, 1.778279394e-01f,
                                     1.000000015e-01f, 5.623413250e-02f, 3.162277490e-02f, 1.778279431e-02f,
                                     9.999999776e-03f, 5.623413250e-03f, 3.162277630e-03f, 1.778279431e-03f,
                                     1.000000047e-03f, 5.623413017e-04f, 3.162277571e-04f, 1.778279402e-04f};

DI void sincos_acc(float angf, float* so, float* co) {
  const double a = (double)angf;
  const double q = rint(a * 0.6366197723675814);
  double t = fma(-q, 1.5707963267948966, a);
  t = fma(-q, 6.123233995736766e-17, t);
  const int qi = ((int)q) & 3;
  const double t2 = t * t;
  double sn = -1.0 / 1307674368000.0;
  sn = fma(sn, t2, 1.0 / 6227020800.0);
  sn = fma(sn, t2, -1.0 / 39916800.0);
  sn = fma(sn, t2, 1.0 / 362880.0);
  sn = fma(sn, t2, -1.0 / 5040.0);
  sn = fma(sn, t2, 1.0 / 120.0);
  sn = fma(sn, t2, -1.0 / 6.0);
  sn = fma(sn * t2, t, t);
  double cs = 1.0 / 20922789888000.0;
  cs = fma(cs, t2, -1.0 / 87178291200.0);
  cs = fma(cs, t2, 1.0 / 479001600.0);
  cs = fma(cs, t2, -1.0 / 3628800.0);
  cs = fma(cs, t2, 1.0 / 40320.0);
  cs = fma(cs, t2, -1.0 / 720.0);
  cs = fma(cs, t2, 1.0 / 24.0);
  cs = fma(cs, t2, -0.5);
  cs = fma(cs, t2, 1.0);
  double s, c;
  if (qi == 0) { s = sn; c = cs; }
  else if (qi == 1) { s = cs; c = -sn; }
  else if (qi == 2) { s = -sn; c = -cs; }
  else { s = -cs; c = sn; }
  *so = (float)s; *co = (float)c;
}

DI void transpose_to_h(const float* __restrict__ src, int K, int N, int Npad, h16* __restrict__ dst, char* smem) {
  float* tile = (float*)smem;
  const int tid = opaque_tid();
  const int ktn = K / 64, ntn = Npad / 64;
  for (int tix = blockIdx.x; tix < ktn * ntn; tix += gridDim.x) {
    const int k0 = (tix / ntn) * 64, n0 = (tix % ntn) * 64;
    {
      const int nn = tid & 63;
#pragma unroll
      for (int i = 0; i < 8; ++i) {
        const int kk = (tid >> 6) + 8 * i;
        const int n = n0 + nn;
        tile[kk * 65 + nn] = (n < N) ? src[(size_t)(k0 + kk) * N + n] : 0.f;
      }
    }
    __syncthreads();
    {
      const int kk = tid & 63;
#pragma unroll
      for (int i = 0; i < 8; ++i) {
        const int nn = (tid >> 6) + 8 * i;
        dst[(size_t)(n0 + nn) * K + k0 + kk] = (h16)tile[kk * 65 + nn];
      }
    }
    __syncthreads();
  }
}

DI void phase0(const P& p, char* smem) {
  const int tid = opaque_tid(), lane = tid & 63, w = tid >> 6;
  const int gw = blockIdx.x * 8 + w, nw = gridDim.x * 8;
  const int gt = blockIdx.x * NBLK_THREADS + tid, nt = gridDim.x * NBLK_THREADS;
  for (int k0 = 0; gw + nw * k0 < NTOK; k0 += 5) {
    float4 v[5][4];
    float ss[5];
#pragma unroll
    for (int rr = 0; rr < 5; ++rr) {
      const int row = gw + nw * (k0 + rr);
      if (row < NTOK) {
        const float* x = row < NP ? p.x_p + (size_t)row * DM : p.x_s + (size_t)(row - NP) * DM;
#pragma unroll
        for (int i = 0; i < 4; ++i) v[rr][i] = ((const float4*)x)[lane + 64 * i];
      } else {
#pragma unroll
        for (int i = 0; i < 4; ++i) v[rr][i] = make_float4(0.f, 0.f, 0.f, 0.f);
      }
    }
#pragma unroll
    for (int rr = 0; rr < 5; ++rr) {
      float a = 0.f;
#pragma unroll
      for (int i = 0; i < 4; ++i)
        a += v[rr][i].x * v[rr][i].x + v[rr][i].y * v[rr][i].y + v[rr][i].z * v[rr][i].z + v[rr][i].w * v[rr][i].w;
      ss[rr] = a;
    }
#pragma unroll
    for (int off = 32; off > 0; off >>= 1) {
#pragma unroll
      for (int rr = 0; rr < 5; ++rr) ss[rr] += __shfl_xor(ss[rr], off);
    }
    float4 g[4];
#pragma unroll
    for (int i = 0; i < 4; ++i) g[i] = ((const float4*)p.norm_g)[lane + 64 * i];
#pragma unroll
    for (int rr = 0; rr < 5; ++rr) {
      const int row = gw + nw * (k0 + rr);
      if (row < NTOK) {
        const float rstd = rsqrtf(ss[rr] * (1.f / 1024.f) + 1e-6f);
#pragma unroll
        for (int i = 0; i < 4; ++i) {
          h4 o;
          o[0] = (h16)(v[rr][i].x * rstd * g[i].x); o[1] = (h16)(v[rr][i].y * rstd * g[i].y);
          o[2] = (h16)(v[rr][i].z * rstd * g[i].z); o[3] = (h16)(v[rr][i].w * rstd * g[i].w);
          *(h4*)(p.hX + (size_t)row * DM + (lane + 64 * i) * 4) = o;
        }
      }
    }
  }
  transpose_to_h(p.w_in, 1024, INW, INWP, p.Wt_in, smem);
  transpose_to_h(p.w_out, 1024, 1024, 1024, p.Wt_out, smem);
  for (int wt = gw; wt < 256; wt += nw) {
    const int hd = wt >> 5, k0 = ((wt >> 2) & 7) * 32, c0 = (wt & 3) * 32;
    const int r = lane & 31, hh = lane >> 5;
    f16v D;
#pragma unroll
    for (int i = 0; i < 16; ++i) D[i] = 0.f;
#pragma unroll
    for (int t = 0; t < 4; ++t) {
      const float* ap = p.w_uq + (size_t)(k0 + r) * 768 + hd * 96 + 16 * t + 8 * hh;
      const float* bp = p.w_uk + (size_t)(c0 + r) * 512 + hd * 64 + 16 * t + 8 * hh;
      const h8 a = cvt8(*(const float4*)ap, *(const float4*)(ap + 4));
      const h8 bq = cvt8(*(const float4*)bp, *(const float4*)(bp + 4));
      D = MFMA32(a, bq, D);
    }
#pragma unroll
    for (int g4 = 0; g4 < 4; ++g4) {
      const int k = k0 + 8 * g4 + 4 * hh;
      const float4 g = *(const float4*)(p.qn_g + k);
      h4 o;
      o[0] = (h16)(D[4 * g4 + 0] * g.x); o[1] = (h16)(D[4 * g4 + 1] * g.y);
      o[2] = (h16)(D[4 * g4 + 2] * g.z); o[3] = (h16)(D[4 * g4 + 3] * g.w);
      *(h4*)(p.Wq + (size_t)(hd * 128 + c0 + r) * 256 + k) = o;
    }
  }
  for (int idx = gt; idx < 256 * 256; idx += nt) {
    const int n = 1024 + (idx >> 8), k = idx & 255;
    const int hd = (n - 1024) >> 5, rr = (n - 1024) & 31;
    p.Wq[(size_t)n * 256 + k] = (h16)(p.w_uq[(size_t)k * 768 + hd * 96 + 64 + rr] * p.qn_g[k]);
  }
  for (int idx = gt; idx < 8 * 64 * 128; idx += nt) {
    const int j = idx & 7, ln = (idx >> 3) & 63, sq = (idx >> 9) & 1, dt = (idx >> 10) & 3, vt = (idx >> 12) & 1, hd = idx >> 13;
    const int v = 32 * vt + (ln & 31);
    const int c = 32 * dt + 16 * sq + 8 * (j >> 2) + 4 * (ln >> 5) + (j & 3);
    p.Wuv[idx] = (h16)p.w_uv[(size_t)c * 512 + hd * 64 + v];
  }
  for (int idx = gt; idx < 2080 * 16; idx += nt) {
    const int pi = idx >> 4, j = idx & 15;
    const int pos = pi < 2048 ? pi : PAST + (pi - 2048);
    const float ang = (float)pos * c_inv_freq[j];
    float s, c;
    sincos_acc(ang, &s, &c);
    p.ropeC[idx] = c; p.ropeS[idx] = s;
  }
}

template <int BM, int BN, int WGM, int WGN>
DI void gemm_tile(const h16* __restrict__ A, int lda, const h16* __restrict__ B, int ldb, int K, int m0, int n0,
                  char* smem) {
  constexpr int LS = 72, TS = 136;
  constexpr int TM = BM / WGM, TN = BN / WGN, MI = TM / 32, NI = TN / 32;
  constexpr int ACH = BM * 8 / NBLK_THREADS, BCH = BN * 8 / NBLK_THREADS;
  h16* sA = (h16*)smem;
  h16* sB = sA + 2 * BM * LS;
  const int tid = opaque_tid(), lane = tid & 63, w = tid >> 6;
  const int wm = w / WGN, wn = w % WGN;
  const int r = lane & 31, hh = lane >> 5;
  f16v acc[MI][NI];
#pragma unroll
  for (int mi = 0; mi < MI; ++mi)
#pragma unroll
    for (int ni = 0; ni < NI; ++ni)
#pragma unroll
      for (int i = 0; i < 16; ++i) acc[mi][ni][i] = 0.f;
  h8 ra[ACH], rb[BCH];
  const int KT = K / 64;
#define GLOAD(kt)                                                                                   \
  {                                                                                                 \
    _Pragma("unroll") for (int i = 0; i < ACH; ++i) {                                               \
      const int q = tid + NBLK_THREADS * i;                                                         \
      ra[i] = *(const h8*)(A + (size_t)(m0 + (q >> 3)) * lda + (kt) * 64 + (q & 7) * 8);            \
    }                                                                                               \
    _Pragma("unroll") for (int i = 0; i < BCH; ++i) {                                               \
      const int q = tid + NBLK_THREADS * i;                                                         \
      rb[i] = *(const h8*)(B + (size_t)(n0 + (q >> 3)) * ldb + (kt) * 64 + (q & 7) * 8);            \
    }                                                                                               \
  }
#define SSTORE(buf)                                                                                 \
  {                                                                                                 \
    _Pragma("unroll") for (int i = 0; i < ACH; ++i) {                                               \
      const int q = tid + NBLK_THREADS * i;                                                         \
      *(h8*)(sA + ((buf) * BM + (q >> 3)) * LS + (q & 7) * 8) = ra[i];                              \
    }                                                                                               \
    _Pragma("unroll") for (int i = 0; i < BCH; ++i) {                                               \
      const int q = tid + NBLK_THREADS * i;                                                         \
      *(h8*)(sB + ((buf) * BN + (q >> 3)) * LS + (q & 7) * 8) = rb[i];                              \
    }                                                                                               \
  }
  GLOAD(0);
  SSTORE(0);
  __syncthreads();
  int buf = 0;
  for (int kt = 0; kt < KT; ++kt) {
    if (kt + 1 < KT) GLOAD(kt + 1);
    const h16* a_base = sA + (buf * BM + wm * TM + r) * LS + 8 * hh;
    const h16* b_base = sB + (buf * BN + wn * TN + r) * LS + 8 * hh;
#pragma unroll
    for (int t = 0; t < 4; ++t) {
      h8 af[MI], bf[NI];
#pragma unroll
      for (int mi = 0; mi < MI; ++mi) af[mi] = *(const h8*)(a_base + mi * 32 * LS + t * 16);
#pragma unroll
      for (int ni = 0; ni < NI; ++ni) bf[ni] = *(const h8*)(b_base + ni * 32 * LS + t * 16);
#pragma unroll
      for (int mi = 0; mi < MI; ++mi)
#pragma unroll
        for (int ni = 0; ni < NI; ++ni) acc[mi][ni] = MFMA32(bf[ni], af[mi], acc[mi][ni]);
    }
    if (kt + 1 < KT) SSTORE(buf ^ 1);
    __syncthreads();
    buf ^= 1;
  }
#undef GLOAD
#undef SSTORE
  h16* T = (h16*)smem;
#pragma unroll
  for (int mi = 0; mi < MI; ++mi)
#pragma unroll
    for (int ni = 0; ni < NI; ++ni)
#pragma unroll
      for (int g4 = 0; g4 < 4; ++g4) {
        h4 o;
#pragma unroll
        for (int jj = 0; jj < 4; ++jj) o[jj] = (h16)acc[mi][ni][4 * g4 + jj];
        *(h4*)(T + (wm * TM + mi * 32 + r) * TS + wn * TN + ni * 32 + 8 * g4 + 4 * hh) = o;
      }
  __syncthreads();
}

template <int OP>
DI void epi_simple(const h16* T, int m0, h16* dst, int ld, int col0, int tid) {
  h8 v[8];
#pragma unroll
  for (int it = 0; it < 8; ++it) {
    const int q = tid + NBLK_THREADS * it;
    v[it] = *(const h8*)(T + (q >> 4) * 136 + (q & 15) * 8);
  }
#pragma unroll
  for (int it = 0; it < 8; ++it) {
    const int q = tid + NBLK_THREADS * it;
    h8 o;
#pragma unroll
    for (int e = 0; e < 8; ++e) {
      const float x = (float)v[it][e];
      o[e] = (OP == 1) ? (h16)silu(x) : (OP == 2) ? (h16)(x * QB_SCALE) : v[it][e];
    }
    *(h8*)(dst + (size_t)(m0 + (q >> 4)) * ld + col0 + (q & 15) * 8) = o;
  }
}
DI float4 f4_lo(h8 v) { return make_float4((float)v[0], (float)v[1], (float)v[2], (float)v[3]); }
DI float4 f4_hi(h8 v) { return make_float4((float)v[4], (float)v[5], (float)v[6], (float)v[7]); }
typedef float f32x4 __attribute__((ext_vector_type(4)));
typedef __attribute__((address_space(3))) unsigned* lds_u32p;
DI int g8_lds_byte(int r, int c) {
  const int st = (r >> 4) * 2 + (c >> 5), rr = r & 15, cc = c & 31, ob = rr * 64 + cc * 2;
  return st * 1024 + (ob ^ (((ob >> 9) & 1) << 5));
}
DI void g8_stage_rc(int b, int& R, int& C) {
  const int st = b / 1024, sb = b % 1024, swz = sb ^ (((sb >> 9) & 1) << 5);
  R = (st >> 1) * 16 + swz / 64;
  C = (st & 1) * 32 + (swz % 64) / 2;
}
#define G8_HT (128 * 64)
DI void gemm8_mainloop(const h16* __restrict__ A, const h16* __restrict__ Bt, int K, int brow, int bcol, char* smem,
                       f32x4 (&acc)[2][2][4][2]) {
  h16* shm = (h16*)smem;
  const int tid = opaque_tid();
  const int wid = tid >> 6, lane = tid & 63, wr = wid >> 2, wc = wid & 3, fr = lane & 15, fq = lane >> 4;
  int so[2];
#pragma unroll
  for (int i = 0; i < 2; ++i) { int R, C; g8_stage_rc(tid * 16 + i * 8192, R, C); so[i] = R * K + C; }
#define G8_SA(b, h) (shm + ((b) * 2 + (h)) * G8_HT)
#define G8_SB(b, h) (shm + (4 + (b) * 2 + (h)) * G8_HT)
#define G8_STAGE(Pp, BASE, br, kt)                                                                        \
  do {                                                                                                    \
    const h16* _bp = (BASE) + (size_t)(br) * K + (kt) * 64;                              \
    _Pragma("unroll") for (int _i = 0; _i < 2; ++_i) {                                                    \
      const h16* _g = _bp + so[_i];                                                                       \
      __builtin_amdgcn_global_load_lds((const unsigned*)_g,                                               \
                                       (lds_u32p)((char*)(Pp) + tid * 16 + _i * 8192), 16, 0, 0);         \
    }                                                                                                     \
  } while (0)
#define G8_LDA(dst, b, h)                                                                                 \
  _Pragma("unroll") for (int m = 0; m < 4; ++m) _Pragma("unroll") for (int k = 0; k < 2; ++k)             \
    dst[m][k] = *(const h8*)((const char*)G8_SA(b, h) + g8_lds_byte(wr * 64 + m * 16 + fr, k * 32 + fq * 8))
#define G8_LDB(dst, b, h)                                                                                 \
  _Pragma("unroll") for (int n = 0; n < 2; ++n) _Pragma("unroll") for (int k = 0; k < 2; ++k)             \
    dst[n][k] = *(const h8*)((const char*)G8_SB(b, h) + g8_lds_byte(wc * 32 + n * 16 + fr, k * 32 + fq * 8))
#define G8_MMA(ai, bj, At, Bq)                                                                            \
  do {                                                                                                    \
    __builtin_amdgcn_s_setprio(1);                                                                        \
    _Pragma("unroll") for (int m = 0; m < 4; ++m) _Pragma("unroll") for (int n = 0; n < 2; ++n)           \
      _Pragma("unroll") for (int k = 0; k < 2; ++k)                                                       \
        acc[ai][bj][m][n] = __builtin_amdgcn_mfma_f32_16x16x32_f16(Bq[n][k], At[m][k], acc[ai][bj][m][n], 0, 0, 0); \
    __builtin_amdgcn_s_setprio(0);                                                                        \
  } while (0)
#define G8_WAIT_V(n) asm volatile("s_waitcnt vmcnt(" #n ")" ::: "memory")
#define G8_WAIT_L(n) asm volatile("s_waitcnt lgkmcnt(" #n ")" ::: "memory")
#define G8_BAR __builtin_amdgcn_s_barrier()
#define G8_SCHED __builtin_amdgcn_sched_barrier(0)
#pragma unroll
  for (int a = 0; a < 2; ++a)
#pragma unroll
    for (int b = 0; b < 2; ++b)
#pragma unroll
      for (int m = 0; m < 4; ++m)
#pragma unroll
        for (int n = 0; n < 2; ++n) acc[a][b][m][n] = f32x4{0.f, 0.f, 0.f, 0.f};
  h8 At[4][2], B0[2][2], B1[2][2];
  const int nt = K / 64;
  G8_STAGE(G8_SB(0, 0), Bt, bcol, 0); G8_STAGE(G8_SA(0, 0), A, brow, 0);
  G8_STAGE(G8_SB(0, 1), Bt, bcol + 128, 0); G8_STAGE(G8_SA(0, 1), A, brow + 128, 0);
  if (wr == 1) G8_BAR;
  G8_WAIT_V(4); G8_BAR;
  G8_STAGE(G8_SB(1, 0), Bt, bcol, 1); G8_STAGE(G8_SA(1, 0), A, brow, 1); G8_STAGE(G8_SB(1, 1), Bt, bcol + 128, 1);
  G8_WAIT_V(6); G8_BAR;
  for (int t = 0; t < nt - 2; t += 2) {
    G8_LDB(B0, 0, 0); G8_SCHED; G8_LDA(At, 0, 0); G8_STAGE(G8_SA(1, 1), A, brow + 128, t + 1);
    G8_WAIT_L(8); G8_BAR; G8_WAIT_L(0); G8_MMA(0, 0, At, B0); G8_BAR; G8_SCHED;
    G8_LDB(B1, 0, 1); G8_STAGE(G8_SB(0, 0), Bt, bcol, t + 2);
    G8_BAR; G8_WAIT_L(0); G8_MMA(0, 1, At, B1); G8_BAR;
    G8_LDA(At, 0, 1); G8_STAGE(G8_SA(0, 0), A, brow, t + 2);
    G8_BAR; G8_WAIT_L(0); G8_MMA(1, 0, At, B0); G8_BAR; G8_SCHED;
    G8_STAGE(G8_SB(0, 1), Bt, bcol + 128, t + 2);
    G8_WAIT_V(6); G8_BAR; G8_MMA(1, 1, At, B1); G8_BAR;
    G8_LDB(B0, 1, 0); G8_SCHED; G8_LDA(At, 1, 0); G8_STAGE(G8_SA(0, 1), A, brow + 128, t + 2);
    G8_WAIT_L(8); G8_BAR; G8_WAIT_L(0); G8_MMA(0, 0, At, B0); G8_BAR; G8_SCHED;
    G8_LDB(B1, 1, 1); G8_STAGE(G8_SB(1, 0), Bt, bcol, t + 3);
    G8_BAR; G8_WAIT_L(0); G8_MMA(0, 1, At, B1); G8_BAR;
    G8_LDA(At, 1, 1); G8_STAGE(G8_SA(1, 0), A, brow, t + 3);
    G8_BAR; G8_WAIT_L(0); G8_MMA(1, 0, At, B0); G8_BAR; G8_SCHED;
    G8_STAGE(G8_SB(1, 1), Bt, bcol + 128, t + 3);
    G8_WAIT_V(6); G8_BAR; G8_MMA(1, 1, At, B1); G8_BAR;
  }
  { G8_LDB(B0, 0, 0); G8_LDA(At, 0, 0); G8_STAGE(G8_SA(1, 1), A, brow + 128, nt - 1);
    G8_BAR; G8_WAIT_L(0); G8_MMA(0, 0, At, B0); G8_BAR;
    G8_LDB(B1, 0, 1); G8_BAR; G8_WAIT_L(0); G8_MMA(0, 1, At, B1); G8_BAR;
    G8_LDA(At, 0, 1); G8_WAIT_V(4); G8_BAR; G8_WAIT_L(0); G8_MMA(1, 0, At, B0); G8_MMA(1, 1, At, B1); G8_BAR; }
  { G8_LDB(B0, 1, 0); G8_LDA(At, 1, 0); G8_WAIT_V(2); G8_BAR; G8_WAIT_L(0); G8_MMA(0, 0, At, B0); G8_BAR;
    G8_LDB(B1, 1, 1); G8_WAIT_V(0); G8_BAR; G8_WAIT_L(0); G8_MMA(0, 1, At, B1); G8_BAR;
    G8_LDA(At, 1, 1); G8_BAR; G8_WAIT_L(0); G8_MMA(1, 0, At, B0); G8_MMA(1, 1, At, B1); G8_BAR; }
  if (wr == 0) G8_BAR;
#undef G8_SA
#undef G8_SB
#undef G8_STAGE
#undef G8_LDA
#undef G8_LDB
#undef G8_MMA
}

DI void p1_epilogue(const P& p, const h16* T, int m0, int n0, int nt, bool isP) {
  constexpr int TS = 136;
  const int tid = opaque_tid(), lane = tid & 63, w = tid >> 6;
  if (nt == 2) {
    for (int rr = w; rr < 256; rr += 8) {
      const int m = m0 + rr;
      const h2 v2 = *(const h2*)(T + rr * TS + 2 * lane);
      const float a = (float)v2[0], b = (float)v2[1];
      const float ss = wave_sum(a * a + b * b);
      const float rstd = rsqrtf(ss * (1.f / 128.f) + 1e-6f);
      const float2 g = *(const float2*)(p.kvn_g + 2 * lane);
      const float o0 = a * rstd * g.x, o1 = b * rstd * g.y;
      float* oc = isP ? p.out + OFF_P_CKV + (size_t)m * 128 : p.out + OFF_S_CKV + (size_t)(m - NP) * 128;
      *(float2*)(oc + 2 * lane) = make_float2(o0, o1);
      h2 o; o[0] = (h16)o0; o[1] = (h16)o1;
      *(h2*)(p.KM + (size_t)m * 160 + 2 * lane) = o;
    }
  } else if (nt >= 4 && nt <= 6) {
    epi_simple<1>(T, m0, p.GA, 512, n0 - ZC_GA, tid);
  } else if (nt >= 8 && nt <= 10) {
    epi_simple<2>(T, m0, p.QB, 512, n0 - ZC_QB, tid);
  } else if (nt >= 14 && nt <= 16) {
    epi_simple<0>(T, m0, p.QI, 512, n0 - ZC_QI, tid);
  } else if (nt >= 18 && nt <= 20) {
    epi_simple<1>(T, m0, p.GB, 512, n0 - ZC_GB, tid);
  } else {
#pragma unroll 1
    for (int it = 0; it < 8; ++it) {
      const int q = tid + NBLK_THREADS * it;
      const int row = q >> 4, ch = q & 15;
      const int col = n0 + ch * 8, m = m0 + row;
      const int ms = isP ? m : m - NP;
      const h8 v = *(const h8*)(T + row * TS + ch * 8);
      if (col < ZC_CKV) {
        *(h8*)(p.CQ + (size_t)m * 256 + col) = v;
        float ss = 0.f;
#pragma unroll
        for (int e = 0; e < 8; ++e) ss += (float)v[e] * (float)v[e];
        ss += __shfl_xor(ss, 1); ss += __shfl_xor(ss, 2); ss += __shfl_xor(ss, 4); ss += __shfl_xor(ss, 8);
        if (ch == 0) p.RQP[(size_t)m * 2 + nt] = ss;
      } else if (col < ZC_GA) {
        const int j0 = col - ZC_KPE;
        const bool hiHalf = j0 >= 16;
        const h8 u = *(const h8*)(T + row * TS + (hiHalf ? ch - 2 : ch + 2) * 8);
        const int ri = rope_idx(m) * 16 + (j0 & 15);
        const float4 c0 = *(const float4*)(p.ropeC + ri), c1 = *(const float4*)(p.ropeC + ri + 4);
        const float4 s0 = *(const float4*)(p.ropeS + ri), s1 = *(const float4*)(p.ropeS + ri + 4);
        const float cs[8] = {c0.x, c0.y, c0.z, c0.w, c1.x, c1.y, c1.z, c1.w};
        const float sn[8] = {s0.x, s0.y, s0.z, s0.w, s1.x, s1.y, s1.z, s1.w};
        float o[8];
        h8 oh;
#pragma unroll
        for (int e = 0; e < 8; ++e) {
          const float mine = (float)v[e], other = (float)u[e];
          o[e] = hiHalf ? (other * sn[e] + mine * cs[e]) : (mine * cs[e] - other * sn[e]);
          oh[e] = (h16)o[e];
        }
        float* oc = (isP ? p.out + OFF_P_KPE : p.out + OFF_S_KPE) + (size_t)ms * 32 + j0;
        *(float4*)oc = make_float4(o[0], o[1], o[2], o[3]);
        *(float4*)(oc + 4) = make_float4(o[4], o[5], o[6], o[7]);
        *(h8*)(p.KM + (size_t)m * 160 + 128 + j0) = oh;
      } else if (col < ZC_QB) {
        h8 o;
#pragma unroll
        for (int e = 0; e < 8; ++e) o[e] = (h16)silu((float)v[e]);
        *(h8*)(p.GA + (size_t)m * 512 + (col - ZC_GA)) = o;
      } else if (col < ZC_KB) {
        h8 o;
#pragma unroll
        for (int e = 0; e < 8; ++e) o[e] = (h16)((float)v[e] * QB_SCALE);
        *(h8*)(p.QB + (size_t)m * 512 + (col - ZC_QB)) = o;
      } else if (col < ZC_QI) {
        const bool isK = col < ZC_VB;
        const int c0 = col - (isK ? ZC_KB : ZC_VB);
        float* oc = (isK ? (isP ? p.out + OFF_P_K : p.out + OFF_S_K) : (isP ? p.out + OFF_P_V : p.out + OFF_S_V)) +
                    (size_t)ms * 128 + c0;
        *(float4*)oc = f4_lo(v);
        *(float4*)(oc + 4) = f4_hi(v);
        *(h8*)((isK ? p.KB : p.VB) + (size_t)m * 128 + c0) = v;
      } else if (col < ZC_KI) {
        *(h8*)(p.QI + (size_t)m * 512 + (col - ZC_QI)) = v;
      } else if (col < ZC_WI) {
        float* oc = (isP ? p.out + OFF_P_KIDX : p.out + OFF_S_KIDX) + (size_t)ms * 64 + (col - ZC_KI);
        *(float4*)oc = f4_lo(v);
        *(float4*)(oc + 4) = f4_hi(v);
        *(h8*)(p.KI + (size_t)m * 64 + (col - ZC_KI)) = v;
      } else if (col < ZC_GB) {
        float* oc = p.WI + (size_t)m * 8;
        const float4 a = f4_lo(v), b = f4_hi(v);
        *(float4*)oc = make_float4(a.x * WI_SCALE, a.y * WI_SCALE, a.z * WI_SCALE, a.w * WI_SCALE);
        *(float4*)(oc + 4) = make_float4(b.x * WI_SCALE, b.y * WI_SCALE, b.z * WI_SCALE, b.w * WI_SCALE);
      } else if (col < INW) {
        h8 o;
#pragma unroll
        for (int e = 0; e < 8; ++e) o[e] = (h16)silu((float)v[e]);
        *(h8*)(p.GB + (size_t)m * 512 + (col - ZC_GB)) = o;
      }
    }
  }
}

DI void phase1(const P& p, char* smem) {
  constexpr int TS = 136;
  h16* T = (h16*)smem;
  const int ntiles = 68 * 11;
  const int xcd = blockIdx.x & 7, lb = blockIdx.x >> 3, nlb = gridDim.x >> 3;
  const int per = (ntiles + 7) >> 3;
  const int tend = (xcd * per + per) < ntiles ? (xcd * per + per) : ntiles;
  for (int L = xcd * per + lb; L < tend; L += nlb) {
    const int pg = L / 44, rem = L - pg * 44;
    const int pn = rem >> 2, mt = pg * 4 + (rem & 3);
    const int m0 = mt * 256;
    const bool isP = mt < 64;
    f32x4 acc[2][2][4][2];
    gemm8_mainloop(p.hX, p.Wt_in, DM, m0, pn * 256, smem, acc);
    __syncthreads();
    const int tid = opaque_tid();
    const int wid = tid >> 6, lane = tid & 63, wr = wid >> 2, wc = wid & 3, fr = lane & 15, fq = lane >> 4;
#pragma unroll
    for (int bj = 0; bj < 2; ++bj) {
#pragma unroll
      for (int ai = 0; ai < 2; ++ai)
#pragma unroll
        for (int m = 0; m < 4; ++m)
#pragma unroll
          for (int n = 0; n < 2; ++n)
          {
            h4 o;
#pragma unroll
            for (int jj = 0; jj < 4; ++jj) o[jj] = (h16)acc[ai][bj][m][n][jj];
            *(h4*)(T + (ai * 128 + wr * 64 + m * 16 + fr) * TS + wc * 32 + n * 16 + fq * 4) = o;
          }
      __syncthreads();
      p1_epilogue(p, T, m0, pn * 256 + bj * 128, pn * 2 + bj, isP);
      __syncthreads();
    }
  }
}

DI size_t qm_index(int m, int hd, int d) {
  return ((((size_t)(m >> 5) * 8 + hd) * 10 + (d >> 4)) * 64 + (((d >> 3) & 1) * 32 + (m & 31))) * 8 + (d & 7);
}
DI void phase1b(const P& p, char* smem) {
  constexpr int TS = 136;
  h16* T = (h16*)smem;
  float* rq = (float*)(smem + 128 * 1024 - 2048);
  const int ntiles = 68 * 5;
  for (int tile = blockIdx.x; tile < ntiles; tile += gridDim.x) {
    const int mt = tile / 5, pn = tile % 5;
    const int m0 = mt * 256;
    f32x4 acc[2][2][4][2];
    gemm8_mainloop(p.CQ, p.Wq, 256, m0, pn * 256, smem, acc);
    __syncthreads();
    const int tid = opaque_tid();
    if (tid < 256) {
      const float2 pp = *(const float2*)(p.RQP + (size_t)(m0 + tid) * 2);
      rq[tid] = rsqrtf((pp.x + pp.y) * (1.f / 256.f) + 1e-6f) * QM_SCALE;
    }
    const int wid = tid >> 6, lane = tid & 63, wr = wid >> 2, wc = wid & 3, fr = lane & 15, fq = lane >> 4;
#pragma unroll
    for (int bj = 0; bj < 2; ++bj) {
      const int nt = pn * 2 + bj;
#pragma unroll
      for (int ai = 0; ai < 2; ++ai)
#pragma unroll
        for (int m = 0; m < 4; ++m)
#pragma unroll
          for (int n = 0; n < 2; ++n)
          {
            h4 o;
#pragma unroll
            for (int jj = 0; jj < 4; ++jj) o[jj] = (h16)acc[ai][bj][m][n][jj];
            *(h4*)(T + (ai * 128 + wr * 64 + m * 16 + fr) * TS + wc * 32 + n * 16 + fq * 4) = o;
          }
      __syncthreads();
#pragma unroll 2
      for (int it = 0; it < 8; ++it) {
        const int q = tid + NBLK_THREADS * it;
        const int row = q >> 4, ch = q & 15;
        const int m = m0 + row;
        const float sc = rq[row];
        const h8 v = *(const h8*)(T + row * TS + ch * 8);
        h8 o;
        int hd, d0;
        if (nt < 8) {
          hd = nt; d0 = ch * 8;
#pragma unroll
          for (int e = 0; e < 8; ++e) o[e] = (h16)((float)v[e] * sc);
        } else {
          hd = (nt - 8) * 4 + (ch >> 2);
          const int j0 = (ch & 3) * 8;
          d0 = 128 + j0;
          const bool hiHalf = j0 >= 16;
          const h8 u = *(const h8*)(T + row * TS + (hiHalf ? ch - 2 : ch + 2) * 8);
          const int ri = rope_idx(m) * 16 + (j0 & 15);
          const float4 c0 = *(const float4*)(p.ropeC + ri), c1 = *(const float4*)(p.ropeC + ri + 4);
          const float4 s0 = *(const float4*)(p.ropeS + ri), s1 = *(const float4*)(p.ropeS + ri + 4);
          const float cs[8] = {c0.x, c0.y, c0.z, c0.w, c1.x, c1.y, c1.z, c1.w};
          const float sn[8] = {s0.x, s0.y, s0.z, s0.w, s1.x, s1.y, s1.z, s1.w};
#pragma unroll
          for (int e = 0; e < 8; ++e) {
            const float mine = (float)v[e] * sc, other = (float)u[e] * sc;
            o[e] = (h16)(hiHalf ? (other * sn[e] + mine * cs[e]) : (mine * cs[e] - other * sn[e]));
          }
        }
        *(h8*)(p.QM + qm_index(m, hd, d0)) = o;
      }
      __syncthreads();
    }
  }
}

template <bool SAMPLE>
DI void mla_item(const P& p, int b, int tok0, int nkeys, char* smem, const int tid, unsigned* ctr, int& nxt) {
  constexpr int KS = 168;
  h16* sK = (h16*)smem;
  const int lane = tid & 63, w = tid >> 6;
  const int r = lane & 31, hh = lane >> 5;
  const int i16 = lane & 15, q4 = i16 >> 2, p4 = i16 & 3, blk = (lane >> 4) & 1;

  h8 qf[10];
  {
    const h16* qp = p.QM + ((size_t)((tok0 >> 5) * 8 + w) * 10 * 64 + lane) * 8;
#pragma unroll
    for (int t = 0; t < 10; ++t) qf[t] = *(const h8*)(qp + t * 512);
  }
  f16v O[4];
#pragma unroll
  for (int dt = 0; dt < 4; ++dt)
#pragma unroll
    for (int i = 0; i < 16; ++i) O[dt][i] = 0.f;
  float m = NEGBIG, l = 0.f;

  h8 sh[3];
  float4 sf[3][2];
  const int NT = (nkeys + 63) >> 6;

#define MLA_GLOAD(kt)                                                                                          \
  {                                                                                                            \
    _Pragma("unroll") for (int i = 0; i < 3; ++i) {                                                            \
      const int q = tid + NBLK_THREADS * i;                                                                    \
      const int row = q / 20, cc = q % 20;                                                                     \
      const int s = (kt) * 64 + row;                                                                           \
      if (q < 1280) {                                                                                          \
        if (!SAMPLE) {                                                                                         \
          sh[i] = *(const h8*)(p.KM + (size_t)(b * 2048 + s) * 160 + cc * 8);                                  \
        } else {                                                                                               \
          if (s < PAST) {                                                                                      \
            const float* src = (cc < 16) ? p.c_ckv + ((size_t)(b * PAST + s) * 128 + cc * 8)                   \
                                         : p.c_kpe + ((size_t)(b * PAST + s) * 32 + (cc - 16) * 8);            \
            sf[i][0] = *(const float4*)src; sf[i][1] = *(const float4*)(src + 4);                              \
          } else if (s < SKEYS) {                                                                              \
            sf[i][0] = __builtin_bit_cast(float4, *(const h8*)(p.KM + (size_t)(NP + b * 32 + (s - PAST)) * 160 + cc * 8)); \
          } else {                                                                                             \
            sf[i][0] = make_float4(0.f, 0.f, 0.f, 0.f);                                                        \
          }                                                                                                    \
        }                                                                                                      \
      }                                                                                                        \
    }                                                                                                          \
  }
#define MLA_SSTORE(kt, buf)                                                                                    \
  {                                                                                                            \
    _Pragma("unroll") for (int i = 0; i < 3; ++i) {                                                            \
      const int q = tid + NBLK_THREADS * i;                                                                    \
      const int row = q / 20, cc = q % 20;                                                                     \
      const int s = (kt) * 64 + row;                                                                           \
      if (q < 1280) {                                                                                          \
        h8 v;                                                                                                  \
        if (SAMPLE) v = (s < PAST) ? cvt8(sf[i][0], sf[i][1]) : __builtin_bit_cast(h8, sf[i][0]);              \
        else v = sh[i];                                                                                        \
        *(h8*)(sK + ((buf) * 64 + row) * KS + cc * 8) = v;                                                     \
      }                                                                                                        \
    }                                                                                                          \
  }

  MLA_GLOAD(0);
#pragma unroll
  for (int t = 0; t < 10; ++t) pin8(qf[t]);
  MLA_SSTORE(0, 0);
  __syncthreads();
  int buf = 0;
  for (int kt = 0; kt < NT; ++kt) {
    if (kt + 1 < NT) MLA_GLOAD(kt + 1);
    const bool two = (nkeys - kt * 64) > 32;
    const h16* kbase = sK + buf * 64 * KS;
    const h16* ka_ptr = kbase + r * KS + 8 * hh;
    const h16* vb_ptr = kbase + (4 * hh + q4) * KS + 16 * blk + 4 * p4;
    f16v S0, S1;
#pragma unroll
    for (int i = 0; i < 16; ++i) { S0[i] = 0.f; S1[i] = 0.f; }
    {
      h8 ka0[3], ka1[3];
#pragma unroll
      for (int t = 0; t < 3; ++t) {
        ka0[t] = *(const h8*)(ka_ptr + 16 * t);
        ka1[t] = *(const h8*)(ka_ptr + 32 * KS + 16 * t);
      }
#pragma unroll
      for (int t = 0; t < 10; ++t) {
        S0 = MFMA32(ka0[t % 3], qf[t], S0);
        S1 = MFMA32(ka1[t % 3], qf[t], S1);
        if (t + 3 < 10) {
          ka0[t % 3] = *(const h8*)(ka_ptr + 16 * (t + 3));
          ka1[t % 3] = *(const h8*)(ka_ptr + 32 * KS + 16 * (t + 3));
        }
      }
    }
    h8 vf[4];
#define MLA_VLOAD(f)                                                                   \
  {                                                                                    \
    const h16* vp = vb_ptr + ((((f) >> 3) * 32) + ((((f) >> 2) & 1) * 16)) * KS + 32 * ((f) & 3); \
    vf[(f) & 3] = cat8(trread(vp), trread(vp + 8 * KS));                               \
  }
#pragma unroll
    for (int f = 0; f < 4; ++f) MLA_VLOAD(f);
    if (!two) {
      asm volatile("" ::: "memory");
#pragma unroll
      for (int i = 0; i < 16; ++i) S1[i] = NEGBIG;
    }
    mfma_settle();
    float mx = max3f(S0[0], S0[1], S1[0]);
    mx = max3f(mx, S1[1], S0[2]);
#pragma unroll
    for (int i = 2; i < 15; ++i) mx = max3f(mx, S1[i], S0[i + 1]);
    mx = fmaxf(mx, S1[15]);
    mx = fmaxf(mx, __shfl_xor(mx, 32));
    if (__any(mx > m)) {
      const float mn = fmaxf(m, mx);
      const float alpha = fast_exp2(m - mn);
      m = mn;
      l *= alpha;
#pragma unroll
      for (int dt = 0; dt < 4; ++dt)
#pragma unroll
        for (int i = 0; i < 16; ++i) O[dt][i] *= alpha;
    }
    {
      const f2v m2 = {m, m};
      f2v rs2 = {0.f, 0.f};
#pragma unroll
      for (int i = 0; i < 16; i += 2) {
        f2v a = {S0[i], S0[i + 1]};
        f2v b = {S1[i], S1[i + 1]};
        a -= m2; b -= m2;
        a[0] = fast_exp2(a[0]); a[1] = fast_exp2(a[1]);
        b[0] = fast_exp2(b[0]); b[1] = fast_exp2(b[1]);
        rs2 += a; rs2 += b;
        S0[i] = a[0]; S0[i + 1] = a[1]; S1[i] = b[0]; S1[i + 1] = b[1];
      }
      l += rs2[0] + rs2[1];
    }
    h8 pb[4];
#pragma unroll
    for (int g = 0; g < 4; ++g)
#pragma unroll
      for (int jj = 0; jj < 8; ++jj) pb[g][jj] = (h16)((g < 2) ? S0[8 * (g & 1) + jj] : S1[8 * (g & 1) + jj]);
#pragma unroll
    for (int f = 0; f < 16; ++f) {
      O[f & 3] = MFMA32(vf[f & 3], pb[f >> 2], O[f & 3]);
      if (f + 4 < 16) MLA_VLOAD(f + 4);
    }
#undef MLA_VLOAD
    if (kt + 1 < NT) MLA_SSTORE(kt + 1, buf ^ 1);
    __syncthreads();
    buf ^= 1;
  }
#undef MLA_GLOAD
#undef MLA_SSTORE
  if (threadIdx.x == 0) nxt = (int)atomicAdd(ctr, 1u);
  const float inv = 1.f / (l + __shfl_xor(l, 32));
  f16v Y[2];
#pragma unroll
  for (int vt = 0; vt < 2; ++vt)
#pragma unroll
    for (int i = 0; i < 16; ++i) Y[vt][i] = 0.f;
#pragma unroll
  for (int dt = 0; dt < 4; ++dt) {
#pragma unroll
    for (int s = 0; s < 2; ++s) {
      h8 ob;
#pragma unroll
      for (int j = 0; j < 8; ++j) ob[j] = (h16)(O[dt][8 * s + j] * inv);
#pragma unroll
      for (int vt = 0; vt < 2; ++vt) {
        const h8 a = *(const h8*)(p.Wuv + ((size_t)((((w * 2 + vt) * 4 + dt) * 2 + s) * 64 + lane)) * 8);
        Y[vt] = MFMA32(a, ob, Y[vt]);
      }
    }
  }
  h16* Yt = (h16*)smem + w * (32 * 72);
#pragma unroll
  for (int vt = 0; vt < 2; ++vt) {
#pragma unroll
    for (int g4 = 0; g4 < 4; ++g4) {
      h4 o;
#pragma unroll
      for (int j = 0; j < 4; ++j) o[j] = (h16)Y[vt][4 * g4 + j];
      *(h4*)(Yt + r * 72 + 32 * vt + 8 * g4 + 4 * hh) = o;
    }
  }
  wavebar();
#pragma unroll
  for (int i = 0; i < 4; ++i) {
    const int q = lane + 64 * i;
    const int row = q >> 3, ch = q & 7;
    const h8 y = *(const h8*)(Yt + row * 72 + ch * 8);
    const h8 ga = *(const h8*)(p.GA + (size_t)(tok0 + row) * 512 + w * 64 + ch * 8);
    h8 o;
#pragma unroll
    for (int j = 0; j < 8; ++j) o[j] = (h16)((float)y[j] * (float)ga[j]);
    *(h8*)(p.mix + (size_t)(tok0 + row) * 1024 + w * 64 + ch * 8) = o;
  }
  __syncthreads();
}

#define SEL_CAP 256
DI int sel_bin(float v, float lo, float scale, bool degen) {
  if (degen) return v > lo ? 1023 : 0;
  int b = (int)((v - lo) * scale);
  return b > 1023 ? 1023 : b;
}
template <int NR, int NH>
DI void wave_select(const float* sc, int N, unsigned* maskrow, unsigned* hist, float* candv, int* candi, int lane,
                 float (&vpre)[NR], const float* scnext) {
  const int nwords = N >> 5;
  if (lane == 0) maskrow[nwords] = 0u;
  if (N <= 256) {
    for (int wd = lane; wd < nwords; wd += 64) maskrow[wd] = 0xffffffffu;
    return;
  }
  float v[NR];
#define SEL_LOAD(hf)                                                     \
  {                                                                      \
    _Pragma("unroll") for (int i = 0; i < NR; ++i) {                     \
      const int e = 64 * ((hf) * NR + i) + lane;                         \
      v[i] = (e < N) ? sc[e] : -INFINITY;                                \
    }                                                                    \
  }
  if (NH == 1) {
#pragma unroll
    for (int i = 0; i < NR; ++i) v[i] = vpre[i];
    if (scnext) {
#pragma unroll
      for (int i = 0; i < NR; ++i) {
        const int e = 64 * i + lane;
        vpre[i] = (e < N) ? scnext[e] : -INFINITY;
      }
    }
  }
  float lo = INFINITY, hi = -INFINITY;
#pragma unroll 1
  for (int hf = 0; hf < NH; ++hf) {
    if (NH > 1) SEL_LOAD(hf);
#pragma unroll
    for (int i = 0; i < NR; ++i) {
      hi = fmaxf(hi, v[i]);
      lo = fminf(lo, (v[i] == -INFINITY) ? INFINITY : v[i]);
    }
  }
  lo = wave_min(lo); hi = wave_max(hi);
  int need = 256;
  int T = 0, above = 0;
  float scale = 0.f;
  bool degen = false;
  bool rankmode = false;
  bool first = true;
  for (int iter = 0; iter < 64; ++iter) {
    if (!(lo < hi)) break;
    scale = 1024.f / (hi - lo);
    degen = !(scale < 1.0e37f);
    for (int i = lane; i < 1024; i += 64) hist[i] = 0u;
    wavebar();
    if (first && !degen) {
#pragma unroll 1
      for (int hf = 0; hf < NH; ++hf) {
        if (NH > 1) SEL_LOAD(hf);
#pragma unroll
        for (int i = 0; i < NR; ++i) {
          const int eb = 64 * (hf * NR + i);
          if (eb < N) {
            int bn = (int)((v[i] - lo) * scale);
            bn = bn > 1023 ? 1023 : bn;
            if (eb + 64 <= N) atomicAdd(&hist[bn], 1u);
            else if (eb + lane < N) atomicAdd(&hist[bn], 1u);
          }
        }
      }
    } else {
#pragma unroll 1
      for (int hf = 0; hf < NH; ++hf) {
        if (NH > 1) SEL_LOAD(hf);
#pragma unroll
        for (int i = 0; i < NR; ++i) {
          if (v[i] >= lo && v[i] <= hi) atomicAdd(&hist[sel_bin(v[i], lo, scale, degen)], 1u);
          if ((i & 7) == 7) __builtin_amdgcn_sched_barrier(0);
        }
      }
    }
    wavebar();
    unsigned ssum = 0;
#pragma unroll
    for (int i = 0; i < 16; ++i) ssum += hist[16 * lane + i];
    unsigned x = ssum;
#pragma unroll
    for (int off = 1; off < 64; off <<= 1) {
      const unsigned y = __shfl_down(x, off);
      if (lane + off < 64) x += y;
    }
    const unsigned sufx = x - ssum;
    const bool cross = (sufx < (unsigned)need) && (x >= (unsigned)need);
    int myT = 0, myAbove = 0, myC = 0;
    if (cross) {
      unsigned run = sufx;
      for (int i = 15; i >= 0; --i) {
        const unsigned c = hist[16 * lane + i];
        if (run + c >= (unsigned)need) { myT = 16 * lane + i; myAbove = (int)run; myC = (int)c; break; }
        run += c;
      }
    }
    const unsigned long long bal = __ballot(cross);
    const int src = bal ? (int)__builtin_ctzll(bal) : 0;
    T = __shfl(myT, src); above = __shfl(myAbove, src);
    const int cT = __shfl(myC, src);
    if (cT <= SEL_CAP) { rankmode = true; break; }
    first = false;
    need -= above;
    float nlo = INFINITY, nhi = -INFINITY;
#pragma unroll 1
    for (int hf = 0; hf < NH; ++hf) {
      if (NH > 1) SEL_LOAD(hf);
#pragma unroll
      for (int i = 0; i < NR; ++i) {
        if (v[i] >= lo && v[i] <= hi && sel_bin(v[i], lo, scale, degen) == T) { nlo = fminf(nlo, v[i]); nhi = fmaxf(nhi, v[i]); }
      }
    }
    lo = wave_min(nlo); hi = wave_max(nhi);
  }
  const int pick = rankmode ? need - above : need;
  int running = 0;
  const unsigned long long ltmask = (lane == 0) ? 0ull : (~0ull >> (64 - lane));
  const bool fastfinal = rankmode && first && !degen;
#pragma unroll 1
  for (int hf = 0; hf < NH; ++hf) {
    if (NH > 1) SEL_LOAD(hf);
    int mlo = 0, mhi = 0;
#pragma unroll
    for (int i = 0; i < NR; ++i) {
      const int eb = 64 * (hf * NR + i);
      if (eb < N) {
        const float vv = v[i];
        unsigned long long bs, bc;
        if (fastfinal) {
          int bn = (int)((vv - lo) * scale);
          bn = bn > 1023 ? 1023 : bn;
          bs = __ballot(bn > T);
          bc = __ballot(bn == T);
        } else {
          bool s = vv > hi;
          bool c;
          if (rankmode) {
            const bool inr = (vv >= lo && vv <= hi);
            const int bn = inr ? sel_bin(vv, lo, scale, degen) : -1;
            s = s || (bn > T);
            c = (bn == T);
          } else {
            c = (vv == hi);
          }
          bc = __ballot(c);
          if (!rankmode) {
            const int pos = running + __popcll(bc & ltmask);
            s = s || (c && pos < pick);
          }
          bs = __ballot(s);
        }
        if (bc != 0ull) {
          if (rankmode) {
            const bool c = (bc >> lane) & 1ull;
            const int pos = running + __popcll(bc & ltmask);
            if (c) { candv[pos] = vv; candi[pos] = eb + lane; }
          }
          running += __popcll(bc);
        }
        if (lane == i) { mlo = (int)(unsigned)bs; mhi = (int)(unsigned)(bs >> 32); }
      }
      if ((i & 7) == 7) __builtin_amdgcn_sched_barrier(0);
    }
    {
      const int wd = 2 * (hf * NR + lane);
      if (lane < NR && wd < nwords) {
        maskrow[wd] = (unsigned)mlo;
        if (wd + 1 < nwords) maskrow[wd + 1] = (unsigned)mhi;
      }
    }
  }
#undef SEL_LOAD
  if (rankmode) {
    wavebar();
    const int ncand = running;
    for (int i = lane; i < ncand; i += 64) {
      const float vi = candv[i];
      const int ii = candi[i];
      int rank = 0;
      for (int j = 0; j < ncand; ++j) {
        const float vj = candv[j];
        const int ij = candi[j];
        rank += ((vj > vi) || (vj == vi && ij < ii)) ? 1 : 0;
      }
      if (rank < pick) atomicOr(&maskrow[ii >> 5], 1u << (ii & 31));
    }
  }
  wavebar();
}

template <bool SAMPLE>
DI void dsa_item(const P& p, int b, int tok0, int qpos0, int nkeys, float* sc, int scs,
                         char* smem, const int tid, unsigned* ctr, int& nxt) {
  const int lane = tid & 63, w = tid >> 6;
  const int r = lane & 31, hh = lane >> 5;
  const int NT = (nkeys + 63) >> 6;
  unsigned* sMask = (unsigned*)(smem + 73728);
  float* sBias = (float*)(smem + 73728 + 32 * MASK_W * 4);
  if (tid < 256) sBias[tid] = p.rel_bias[tid] * LOG2E;
  float* sBT = sBias + 256;
  for (int e = tid; e < 249 * 8; e += NBLK_THREADS) {
    const int rel = (e >> 3) - 185;
    const int n = rel < 0 ? -rel : rel;
    int bk = n;
    if (n >= 8) bk = 8 + (n >= 12) + (n >= 16) + (n >= 23) + (n >= 32) + (n >= 46) + (n >= 64) + (n >= 91);
    if (rel > 0) bk += 16;
    sBT[e] = p.rel_bias[bk * 8 + (e & 7)] * LOG2E;
  }
  {
    constexpr int LS = 72;
    h16* sKI = (h16*)smem;
    const int NTA = (nkeys + 127) >> 7;
    h8 ai[4];
    {
      const int aq = ((r >> 2) & 1) * 2 + (r >> 4), ah = (r & 3) + 4 * ((r >> 3) & 1);
      const h16* qp = p.QI + ((size_t)(tok0 + 4 * w + aq) * 8 + ah) * 64 + 8 * hh;
#pragma unroll
      for (int t = 0; t < 4; ++t) ai[t] = *(const h8*)(qp + 16 * t);
    }
    float w16[16];
#pragma unroll
    for (int i = 0; i < 16; ++i)
      w16[i] = p.WI[(size_t)(tok0 + 4 * w + 2 * hh + (i >> 3)) * 8 + (i & 3) + 4 * ((i >> 2) & 1)];
    h8 sh[2];
    float4 sf[2][2];
#define KI_GLOAD(kt)                                                                                  \
  {                                                                                                   \
    _Pragma("unroll") for (int i = 0; i < 2; ++i) {                                                   \
      const int q = tid + NBLK_THREADS * i;                                                           \
      const int s = (kt) * 128 + (q >> 3), lcc = q & 7;                                               \
      if (!SAMPLE) {                                                                                  \
        sh[i] = (s < nkeys) ? *(const h8*)(p.KI + (size_t)(b * 2048 + s) * 64 + lcc * 8) : zero8();   \
      } else if (s < PAST) {                                                                          \
        const float* src = p.c_kidx + ((size_t)(b * PAST + s) * 64 + lcc * 8);                        \
        sf[i][0] = *(const float4*)src; sf[i][1] = *(const float4*)(src + 4);                         \
      } else if (s < SKEYS) {                                                                         \
        sf[i][0] = __builtin_bit_cast(float4, *(const h8*)(p.KI + (size_t)(NP + b * 32 + (s - PAST)) * 64 + lcc * 8)); \
      } else {                                                                                        \
        sf[i][0] = make_float4(0.f, 0.f, 0.f, 0.f);                                                   \
      }                                                                                               \
    }                                                                                                 \
  }
#define KI_SSTORE(kt, buf)                                                                            \
  {                                                                                                   \
    _Pragma("unroll") for (int i = 0; i < 2; ++i) {                                                   \
      const int q = tid + NBLK_THREADS * i;                                                           \
      const int s = (kt) * 128 + (q >> 3), lcc = q & 7;                                               \
      h8 v;                                                                                           \
      if (SAMPLE) v = (s < PAST) ? cvt8(sf[i][0], sf[i][1]) : __builtin_bit_cast(h8, sf[i][0]);       \
      else v = sh[i];                                                                                 \
      *(h8*)(sKI + ((buf) * 128 + (q >> 3)) * LS + lcc * 8) = v;                                      \
    }                                                                                                 \
  }
    KI_GLOAD(0);
#pragma unroll
    for (int t = 0; t < 4; ++t) pin8(ai[t]);
#pragma unroll
    for (int i = 0; i < 16; ++i) pinf(w16[i]);
    KI_SSTORE(0, 0);
    __syncthreads();
    int buf = 0;
    for (int kt = 0; kt < NTA; ++kt) {
      if (kt + 1 < NTA) KI_GLOAD(kt + 1);
      const h16* kbase = sKI + buf * 128 * LS + r * LS + 8 * hh;
#pragma unroll
      for (int sub = 0; sub < 4; ++sub) {
        const int key0 = kt * 128 + 32 * sub;
        if (key0 < nkeys) {
          f16v D;
#pragma unroll
          for (int i = 0; i < 16; ++i) D[i] = 0.f;
#pragma unroll
          for (int t = 0; t < 4; ++t) {
            const h8 bf = *(const h8*)(kbase + 32 * sub * LS + 16 * t);
            D = MFMA32(ai[t], bf, D);
          }
          float ps0 = 0.f, ps1 = 0.f;
#pragma unroll
          for (int i = 0; i < 8; ++i) {
            ps0 = fmaf(fmaxf(D[i], 0.f), w16[i], ps0);
            ps1 = fmaf(fmaxf(D[8 + i], 0.f), w16[8 + i], ps1);
          }
          float* so = sc + (size_t)(4 * w + 2 * hh) * scs + key0 + r;
          so[0] = ps0;
          so[scs] = ps1;
        }
      }
      if (kt + 1 < NTA) KI_SSTORE(kt + 1, buf ^ 1);
      __syncthreads();
      buf ^= 1;
    }
#undef KI_GLOAD
#undef KI_SSTORE
  }
    constexpr int LS = 136;
    h16* sKb = (h16*)smem;
    h16* sVb = sKb + 2 * 64 * LS;
    const int kv = w >> 2, ql = 8 * (w & 3) + (r >> 2), g = r & 3, head = 4 * kv + g;
    const int i16 = lane & 15, q4 = i16 >> 2, p4 = i16 & 3, blk = (lane >> 4) & 1;
    const int tq = tok0 + ql;
    const int pq = qpos0 + ql;
    h8 qf[4];
#define DSA_QLOAD                                                                  \
    {                                                                              \
      const h16* qp = p.QB + (size_t)tq * 512 + head * 64 + 8 * hh;                \
      _Pragma("unroll") for (int t = 0; t < 4; ++t) qf[t] = *(const h8*)(qp + 16 * t); \
    }
    if (!SAMPLE) DSA_QLOAD;
    h8 sh[4];
    float4 sf[4][2];
#define KV_GLOAD(kt)                                                                                   \
  {                                                                                                    \
    _Pragma("unroll") for (int i = 0; i < 4; ++i) {                                                    \
      const int q = tid + NBLK_THREADS * i;                                                            \
      const int row = q >> 5, cc = q & 31, c16 = cc & 15;                                              \
      const int s = (kt) * 64 + row;                                                                   \
      if (!SAMPLE) {                                                                                   \
        sh[i] = *(const h8*)(((cc < 16) ? p.KB : p.VB) + (size_t)(b * 2048 + s) * 128 + c16 * 8);      \
      } else if (s < PAST) {                                                                           \
        const float* src = ((cc < 16) ? p.c_k : p.c_v) + ((size_t)(b * PAST + s) * 128 + c16 * 8);     \
        sf[i][0] = *(const float4*)src; sf[i][1] = *(const float4*)(src + 4);                          \
      } else if (s < SKEYS) {                                                                          \
        sf[i][0] = __builtin_bit_cast(float4, *(const h8*)(((cc < 16) ? p.KB : p.VB) + (size_t)(NP + b * 32 + (s - PAST)) * 128 + c16 * 8)); \
      } else {                                                                                         \
        sf[i][0] = make_float4(0.f, 0.f, 0.f, 0.f);                                                    \
      }                                                                                                \
    }                                                                                                  \
  }
#define KV_SSTORE(kt, buf)                                                                             \
  {                                                                                                    \
    _Pragma("unroll") for (int i = 0; i < 4; ++i) {                                                    \
      const int q = tid + NBLK_THREADS * i;                                                            \
      const int row = q >> 5, cc = q & 31, c16 = cc & 15;                                              \
      const int s = (kt) * 64 + row;                                                                   \
      h8 v;                                                                                            \
      if (SAMPLE) v = (s < PAST) ? cvt8(sf[i][0], sf[i][1]) : __builtin_bit_cast(h8, sf[i][0]);        \
      else v = sh[i];                                                                                  \
      *(h8*)(((cc < 16) ? sKb : sVb) + ((buf) * 64 + row) * LS + c16 * 8) = v;                         \
    }                                                                                                  \
  }
    if (!SAMPLE) KV_GLOAD(0);
  __syncthreads();
  {
    unsigned* hist = (unsigned*)(smem + w * 8192);
    float* candv = (float*)(smem + w * 8192 + 4096);
    int* candi = (int*)(smem + w * 8192 + 4096 + 1024);
    constexpr int SNR = SAMPLE ? 33 : 32;
    float vpre[SNR];
    if (!SAMPLE && nkeys > 256) {
#pragma unroll
      for (int i = 0; i < SNR; ++i) {
        const int e = 64 * i + lane;
        vpre[i] = (e < nkeys) ? sc[(size_t)(4 * w) * scs + e] : -INFINITY;
      }
    } else {
#pragma unroll
      for (int i = 0; i < SNR; ++i) vpre[i] = 0.f;
    }
#pragma unroll 1
    for (int qw = 0; qw < 4; ++qw) {
      const int ql = 4 * w + qw;
      wave_select<SNR, SAMPLE ? 2 : 1>(sc + (size_t)ql * scs, nkeys, sMask + ql * MASK_W, hist, candv, candi, lane, vpre,
                                      (qw < 3) ? sc + (size_t)(ql + 1) * scs : (const float*)nullptr);
    }
  }
  __syncthreads();
  {
    const float bias_far = sBias[15 * 8 + head];
    f16v O[2];
#pragma unroll
    for (int dt = 0; dt < 2; ++dt)
#pragma unroll
      for (int i = 0; i < 16; ++i) O[dt][i] = 0.f;
    float m = -1.0e29f, l = 0.f;
    if (SAMPLE) { DSA_QLOAD; KV_GLOAD(0); }
#undef DSA_QLOAD
#pragma unroll
    for (int t = 0; t < 4; ++t) pin8(qf[t]);
    KV_SSTORE(0, 0);
    __syncthreads();
    int buf = 0;
    for (int kt = 0; kt < NT; ++kt) {
      if (kt + 1 < NT) KV_GLOAD(kt + 1);
      const h16* ka_ptr = sKb + buf * 64 * LS + 64 * kv + r * LS + 8 * hh;
      const h16* vb_ptr = sVb + buf * 64 * LS + 64 * kv + (4 * hh + q4) * LS + 16 * blk + 4 * p4;
      const bool nearb = (qpos0 - (kt * 64 + 63)) < 91;
      const unsigned mw0 = sMask[ql * MASK_W + kt * 2] >> (4 * hh);
      const unsigned mw1 = sMask[ql * MASK_W + kt * 2 + 1] >> (4 * hh);
      f16v S0, S1;
      if (!nearb) {
        const int bb = __float_as_int(bias_far), nb = __float_as_int(NEGBIG);
#pragma unroll
        for (int i = 0; i < 16; ++i) {
          const int t0 = __builtin_amdgcn_sbfe((int)mw0, (i & 3) + 8 * (i >> 2), 1);
          const int t1 = __builtin_amdgcn_sbfe((int)mw1, (i & 3) + 8 * (i >> 2), 1);
          S0[i] = __int_as_float((t0 & bb) | (~t0 & nb));
          S1[i] = __int_as_float((t1 & bb) | (~t1 & nb));
        }
      } else {
        const float* bt = sBT + (kt * 64 + 4 * hh - pq + 185) * 8 + head;
        const int nb = __float_as_int(NEGBIG);
#pragma unroll
        for (int i = 0; i < 16; ++i) {
          const int t0 = __builtin_amdgcn_sbfe((int)mw0, (i & 3) + 8 * (i >> 2), 1);
          const int t1 = __builtin_amdgcn_sbfe((int)mw1, (i & 3) + 8 * (i >> 2), 1);
          const int b0 = __float_as_int(bt[((i & 3) + 8 * (i >> 2)) * 8]);
          const int b1 = __float_as_int(bt[(32 + (i & 3) + 8 * (i >> 2)) * 8]);
          S0[i] = __int_as_float((t0 & b0) | (~t0 & nb));
          S1[i] = __int_as_float((t1 & b1) | (~t1 & nb));
        }
      }
      {
        h8 ka0[2], ka1[2];
#pragma unroll
        for (int t = 0; t < 2; ++t) {
          ka0[t] = *(const h8*)(ka_ptr + 16 * t);
          ka1[t] = *(const h8*)(ka_ptr + 32 * LS + 16 * t);
        }
#pragma unroll
        for (int t = 0; t < 4; ++t) {
          S0 = MFMA32(ka0[t & 1], qf[t], S0);
          S1 = MFMA32(ka1[t & 1], qf[t], S1);
          if (t + 2 < 4) {
            ka0[t & 1] = *(const h8*)(ka_ptr + 16 * (t + 2));
            ka1[t & 1] = *(const h8*)(ka_ptr + 32 * LS + 16 * (t + 2));
          }
        }
      }
      h8 vf[4];
#define DSA_VLOAD(f)                                                                              \
  {                                                                                               \
    const h16* vp = vb_ptr + ((((f) >> 2) * 32) + ((((f) >> 1) & 1) * 16)) * LS + 32 * ((f) & 1); \
    vf[(f) & 3] = cat8(trread(vp), trread(vp + 8 * LS));                                          \
  }
#pragma unroll
      for (int f = 0; f < 4; ++f) DSA_VLOAD(f);
      mfma_settle();
      float mx = max3f(S0[0], S0[1], S1[0]);
      mx = max3f(mx, S1[1], S0[2]);
#pragma unroll
      for (int i = 2; i < 15; ++i) mx = max3f(mx, S1[i], S0[i + 1]);
      mx = fmaxf(mx, S1[15]);
      mx = fmaxf(mx, __shfl_xor(mx, 32));
      if (__any(mx > m)) {
        const float mn = fmaxf(m, mx);
        const float alpha = fast_exp2(m - mn);
        m = mn;
        l *= alpha;
#pragma unroll
        for (int dt = 0; dt < 2; ++dt)
#pragma unroll
          for (int i = 0; i < 16; ++i) O[dt][i] *= alpha;
      }
      {
        const f2v m2 = {m, m};
        f2v rs2 = {0.f, 0.f};
#pragma unroll
        for (int i = 0; i < 16; i += 2) {
          f2v a = {S0[i], S0[i + 1]};
          f2v c = {S1[i], S1[i + 1]};
          a -= m2; c -= m2;
          a[0] = fast_exp2(a[0]); a[1] = fast_exp2(a[1]);
          c[0] = fast_exp2(c[0]); c[1] = fast_exp2(c[1]);
          rs2 += a; rs2 += c;
          S0[i] = a[0]; S0[i + 1] = a[1]; S1[i] = c[0]; S1[i + 1] = c[1];
        }
        l += rs2[0] + rs2[1];
      }
      h8 pb[4];
#pragma unroll
      for (int gg = 0; gg < 4; ++gg)
#pragma unroll
        for (int jj = 0; jj < 8; ++jj) pb[gg][jj] = (h16)((gg < 2) ? S0[8 * (gg & 1) + jj] : S1[8 * (gg & 1) + jj]);
#pragma unroll
      for (int f = 0; f < 8; ++f) {
        O[f & 1] = MFMA32(vf[f & 3], pb[f >> 1], O[f & 1]);
        if (f + 4 < 8) DSA_VLOAD(f + 4);
      }
#undef DSA_VLOAD
      if (kt + 1 < NT) KV_SSTORE(kt + 1, buf ^ 1);
      __syncthreads();
      buf ^= 1;
    }
#undef KV_GLOAD
#undef KV_SSTORE
    if (threadIdx.x == 0) nxt = (int)atomicAdd(ctr, 1u);
    const float inv = 1.f / (l + __shfl_xor(l, 32));
    h16* Ot = (h16*)smem + w * (8 * 264);
    {
      const int q8 = r >> 2;
#pragma unroll
      for (int dt = 0; dt < 2; ++dt) {
#pragma unroll
        for (int g4 = 0; g4 < 4; ++g4) {
          h4 o;
#pragma unroll
          for (int j = 0; j < 4; ++j) o[j] = (h16)(O[dt][4 * g4 + j] * inv);
          *(h4*)(Ot + q8 * 264 + g * 64 + 32 * dt + 8 * g4 + 4 * hh) = o;
        }
      }
    }
    wavebar();
#pragma unroll
    for (int i = 0; i < 4; ++i) {
      const int q = lane + 64 * i;
      const int row = q >> 5, ch = q & 31;
      const int tk = tok0 + 8 * (w & 3) + row;
      const h8 y = *(const h8*)(Ot + row * 264 + ch * 8);
      const h8 gb = *(const h8*)(p.GB + (size_t)tk * 512 + kv * 256 + ch * 8);
      h8 o;
#pragma unroll
      for (int j = 0; j < 8; ++j) o[j] = (h16)((float)y[j] * (float)gb[j]);
      *(h8*)(p.mix + (size_t)tk * 1024 + 512 + kv * 256 + ch * 8) = o;
    }
  }
  __syncthreads();
}

#define ITEMS_PER_Q 136
DI void phase2(const P& p, char* smem, int cidx = 0) {
  volatile int& s_item = *(volatile int*)(smem + SMEM_BYTES - 16);
  const int xq = blockIdx.x & 7;
  unsigned* ctr = &p.counters[cidx * 8 + xq];
  if (threadIdx.x == 0) s_item = (int)atomicAdd(ctr, 1u);
  __syncthreads();
  int item = s_item;
  while (item < ITEMS_PER_Q) {
    int nxt = 0;
    const int tid = opaque_tid();
    if (item < 4) {
      const int b = xq + 8 * item;
      mla_item<true>(p, b, NP + b * 32, SKEYS, smem, tid, ctr, nxt);
    } else if (item < 8) {
      const int b = xq + 8 * (item - 4);
      dsa_item<true>(p, b, NP + b * 32, PAST, SKEYS, p.scS + (size_t)b * 32 * SC_STRIDE_S, SC_STRIDE_S, smem, tid, ctr, nxt);
    } else {
      const int k = item - 8;
      const int kind = k & 1, sub = (k >> 1) & 1, b = xq, c = 31 - (k >> 2);
      const int tok0 = b * 2048 + c * 64 + sub * 32;
      const int nkeys = 64 * (c + 1);
      if (kind == 0) mla_item<false>(p, b, tok0, nkeys, smem, tid, ctr, nxt);
      else dsa_item<false>(p, b, tok0, c * 64 + sub * 32, nkeys, p.scP + (size_t)blockIdx.x * 32 * SC_STRIDE_P,
                           SC_STRIDE_P, smem, tid, ctr, nxt);
    }
    if (threadIdx.x == 0) s_item = nxt;
    __syncthreads();
    item = s_item;
    __syncthreads();
  }
}

template <int BM>
DI void p3_epilogue(const P& p, const h16* T, int m0, int n0) {
  constexpr int TS = 136;
  const int tid = opaque_tid();
  constexpr int NIT = BM / 32;
  float4 x0[NIT], x1[NIT];
#pragma unroll
  for (int it = 0; it < NIT; ++it) {
    const int q = tid + NBLK_THREADS * it;
    const int m = m0 + (q >> 4), n = n0 + (q & 15) * 8;
    const float* xr = (m < NP ? p.x_p + (size_t)m * DM : p.x_s + (size_t)(m - NP) * DM) + n;
    x0[it] = *(const float4*)xr; x1[it] = *(const float4*)(xr + 4);
  }
#pragma unroll
  for (int it = 0; it < NIT; ++it) {
    const int q = tid + NBLK_THREADS * it;
    const int row = q >> 4, ch = q & 15;
    const int m = m0 + row, n = n0 + ch * 8;
    const h8 v = *(const h8*)(T + row * TS + ch * 8);
    h8 o;
    o[0] = (h16)(x0[it].x + (float)v[0]); o[1] = (h16)(x0[it].y + (float)v[1]);
    o[2] = (h16)(x0[it].z + (float)v[2]); o[3] = (h16)(x0[it].w + (float)v[3]);
    o[4] = (h16)(x1[it].x + (float)v[4]); o[5] = (h16)(x1[it].y + (float)v[5]);
    o[6] = (h16)(x1[it].z + (float)v[6]); o[7] = (h16)(x1[it].w + (float)v[7]);
    *(h8*)(p.XN + (size_t)m * DM + n) = o;
  }
}
DI void phase3(const P& p, char* smem) {
  constexpr int TS = 136;
  h16* T = (h16*)smem;
  for (int tile = blockIdx.x; tile < 256; tile += gridDim.x) {
    const int xcd = tile & 7, idx = tile >> 3;
    const int mt = xcd * 8 + (idx >> 2), pn = idx & 3;
    const int m0 = mt * 256;
    f32x4 acc[2][2][4][2];
    gemm8_mainloop(p.mix, p.Wt_out, DM, m0, pn * 256, smem, acc);
    __syncthreads();
    const int tid = opaque_tid();
    const int wid = tid >> 6, lane = tid & 63, wr = wid >> 2, wc = wid & 3, fr = lane & 15, fq = lane >> 4;
#pragma unroll
    for (int bj = 0; bj < 2; ++bj) {
#pragma unroll
      for (int ai = 0; ai < 2; ++ai)
#pragma unroll
        for (int m = 0; m < 4; ++m)
#pragma unroll
          for (int n = 0; n < 2; ++n)
          {
            h4 o;
#pragma unroll
            for (int jj = 0; jj < 4; ++jj) o[jj] = (h16)acc[ai][bj][m][n][jj];
            *(h4*)(T + (ai * 128 + wr * 64 + m * 16 + fr) * TS + wc * 32 + n * 16 + fq * 4) = o;
          }
      __syncthreads();
      p3_epilogue<256>(p, T, m0, pn * 256 + bj * 128);
      __syncthreads();
    }
  }
  for (int tile = blockIdx.x; tile < 128; tile += gridDim.x) {
    const int m0 = NP + (tile >> 3) * 64, n0 = (tile & 7) * 128;
    gemm_tile<64, 128, 2, 4>(p.mix, 1024, p.Wt_out, 1024, 1024, m0, n0, smem);
    p3_epilogue<64>(p, T, m0, n0);
    __syncthreads();
  }
}

DI void phase4(const P& p) {
  const int tid = opaque_tid(), lane = tid & 63, w = tid >> 6;
  const int gw = blockIdx.x * 8 + w, nw = gridDim.x * 8;
  for (int k0 = 0; gw + nw * k0 < NTOK; k0 += 5) {
    h4 v[5][4];
    float ss[5];
#pragma unroll
    for (int rr = 0; rr < 5; ++rr) {
      const int row = gw + nw * (k0 + rr);
#pragma unroll
      for (int k = 0; k < 4; ++k) {
        if (row < NTOK) v[rr][k] = *(const h4*)(p.XN + (size_t)row * DM + 4 * lane + 256 * k);
        else { v[rr][k][0] = (h16)0.f; v[rr][k][1] = (h16)0.f; v[rr][k][2] = (h16)0.f; v[rr][k][3] = (h16)0.f; }
      }
    }
#pragma unroll
    for (int rr = 0; rr < 5; ++rr) {
      float a = 0.f;
#pragma unroll
      for (int k = 0; k < 4; ++k)
#pragma unroll
        for (int e = 0; e < 4; ++e) a += (float)v[rr][k][e] * (float)v[rr][k][e];
      ss[rr] = a;
    }
#pragma unroll
    for (int off = 32; off > 0; off >>= 1) {
#pragma unroll
      for (int rr = 0; rr < 5; ++rr) ss[rr] += __shfl_xor(ss[rr], off);
    }
    float4 g[4];
#pragma unroll
    for (int k = 0; k < 4; ++k) g[k] = *(const float4*)(p.fn_g + 4 * lane + 256 * k);
#pragma unroll
    for (int rr = 0; rr < 5; ++rr) {
      const int row = gw + nw * (k0 + rr);
      if (row < NTOK) {
        const float rstd = rsqrtf(ss[rr] * (1.f / 1024.f) + 1e-6f);
        float* o = p.out + (size_t)row * DM;
#pragma unroll
        for (int k = 0; k < 4; ++k)
          *(float4*)(o + 4 * lane + 256 * k) = make_float4((float)v[rr][k][0] * rstd * g[k].x, (float)v[rr][k][1] * rstd * g[k].y,
                                                           (float)v[rr][k][2] * rstd * g[k].z, (float)v[rr][k][3] * rstd * g[k].w);
      }
    }
  }
}

__global__ void __launch_bounds__(NBLK_THREADS) mega_kernel(P p) {
  __shared__ __attribute__((aligned(16))) char smem[SMEM_BYTES];
  XBar xb;
  xb.w = p.counters;
  xb.x = (unsigned)__builtin_amdgcn_s_getreg((3 << 11) | 20) & 0xFu;
  xb.nloc = 0u; xb.nx = 0u;
  if (threadIdx.x == 0) __hip_atomic_fetch_add(&xb.w[XB_CNT(xb.x)], 1u, __ATOMIC_RELAXED, __HIP_MEMORY_SCOPE_AGENT);
  phase0(p, smem);
  xcd_barrier(xb, 1u, smem);
  phase1(p, smem);
  xcd_barrier(xb, 2u, smem);
  phase1b(p, smem);
  xcd_barrier(xb, 3u, smem);
  phase2(p, smem);
  xcd_barrier(xb, 4u, smem);
  phase3(p, smem);
  xcd_barrier(xb, 5u, smem);
  phase4(p);
}

extern "C" void kernel_launch(void* const* d_in, const int* in_sizes, int n_in, void* d_out, int out_size, void* d_ws,
                              size_t ws_size, hipStream_t stream) {
  P p{};
  p.x_p = (const float*)d_in[0];
  p.x_s = (const float*)d_in[1];
  p.c_ckv = (const float*)d_in[2];
  p.c_kpe = (const float*)d_in[3];
  p.c_k = (const float*)d_in[4];
  p.c_v = (const float*)d_in[5];
  p.c_kidx = (const float*)d_in[6];
  p.norm_g = (const float*)d_in[7];
  p.w_in = (const float*)d_in[8];
  p.qn_g = (const float*)d_in[9];
  p.kvn_g = (const float*)d_in[10];
  p.w_uq = (const float*)d_in[11];
  p.w_uk = (const float*)d_in[12];
  p.w_uv = (const float*)d_in[13];
  p.rel_bias = (const float*)d_in[14];
  p.w_out = (const float*)d_in[15];
  p.fn_g = (const float*)d_in[16];
  p.out = (float*)d_out;

  char* ws = (char*)d_ws;
  size_t off = 0;
  auto carve = [&](size_t bytes) {
    char* r = ws + off;
    off += (bytes + 255) & ~(size_t)255;
    return r;
  };
  p.counters = (unsigned*)carve(XB_WORDS * 4);
  p.hX = (h16*)carve((size_t)NTOK * DM * 2);
  p.mix = p.hX;
  p.scP = (float*)carve((size_t)256 * 32 * SC_STRIDE_P * 4);
  p.CQ = (h16*)carve((size_t)NTOK * 256 * 2);
  p.Wt_in = (h16*)carve((size_t)INWP * DM * 2);
  p.Wt_out = (h16*)carve((size_t)DM * DM * 2);
  p.Wq = (h16*)carve((size_t)1280 * 256 * 2);
  p.Wuv = (h16*)carve((size_t)8 * 64 * 128 * 2);
  p.QM = (h16*)carve((size_t)NTOK * 1280 * 2);
  p.XN = (h16*)carve((size_t)NTOK * DM * 2);
  p.KM = (h16*)carve((size_t)NTOK * 160 * 2);
  p.GA = (h16*)carve((size_t)NTOK * 512 * 2);
  p.GB = (h16*)carve((size_t)NTOK * 512 * 2);
  p.QB = (h16*)carve((size_t)NTOK * 512 * 2);
  p.KB = (h16*)carve((size_t)NTOK * 128 * 2);
  p.VB = (h16*)carve((size_t)NTOK * 128 * 2);
  p.QI = (h16*)carve((size_t)NTOK * 512 * 2);
  p.KI = (h16*)carve((size_t)NTOK * 64 * 2);
  p.WI = (float*)carve((size_t)NTOK * 8 * 4);
  p.RQP = (float*)carve((size_t)NTOK * 2 * 4);
  p.ropeC = (float*)carve((size_t)2080 * 16 * 4);
  p.ropeS = (float*)carve((size_t)2080 * 16 * 4);
  p.scS = (float*)carve((size_t)32 * 32 * SC_STRIDE_S * 4);
  if (off > ws_size) {
    fprintf(stderr, "workspace too small: need %zu have %zu\n", off, ws_size);
    return;
  }
  static int grid_blocks = 0;
  if (!grid_blocks) {
    int dev = 0, cus = 0, per_cu = 0;
    hipGetDevice(&dev);
    hipDeviceGetAttribute(&cus, hipDeviceAttributeMultiprocessorCount, dev);
    hipOccupancyMaxActiveBlocksPerMultiprocessor(&per_cu, mega_kernel, NBLK_THREADS, 0);
    if (per_cu > 1) per_cu = 1;
    grid_blocks = cus * per_cu;
    if (grid_blocks > 256) grid_blocks = 256;
  }
  hipMemsetAsync(p.counters, 0, XB_WORDS * 4, stream);
  hipLaunchKernelGGL(mega_kernel, dim3(grid_blocks), dim3(NBLK_THREADS), 0, stream, p);
}
```

```cpp
#include <hip/hip_runtime.h>
#include <stdint.h>
#include <stdio.h>

typedef _Float16 h16;
typedef h16 h8 __attribute__((ext_vector_type(8)));
typedef h16 h4 __attribute__((ext_vector_type(4)));
typedef h16 h2 __attribute__((ext_vector_type(2)));
typedef float f16v __attribute__((ext_vector_type(16)));
typedef short s4v __attribute__((vector_size(8)));
typedef __attribute__((address_space(3))) s4v* lds_s4p;

#define DI __device__ __forceinline__
#define MFMA32(a, b, c) __builtin_amdgcn_mfma_f32_32x32x16_f16((a), (b), (c), 0, 0, 0)

#define NTOK 17408
#define NP 16384
#define DM 1024
#define INW 2792
#define INWP 2816
#define PAST 4096
#define SKEYS 4128
#define NBLK_THREADS 512

#define OFF_Y 0
#define OFF_P_CKV 17825792
#define OFF_P_KPE 19922944
#define OFF_P_K 20447232
#define OFF_P_V 22544384
#define OFF_P_KIDX 24641536
#define OFF_S_CKV 25690112
#define OFF_S_KPE 25821184
#define OFF_S_K 25853952
#define OFF_S_V 25985024
#define OFF_S_KIDX 26116096

#define ZC_CQ 0
#define ZC_CKV 256
#define ZC_KPE 384
#define ZC_GA 416
#define ZC_QB 928
#define ZC_KB 1440
#define ZC_VB 1568
#define ZC_QI 1696
#define ZC_KI 2208
#define ZC_WI 2272
#define ZC_GB 2280

#define LOG2E 1.4426950408889634f
#define QM_SCALE 0.14724444602590306f
#define QB_SCALE 0.18033688011112042f
#define WI_SCALE 0.04419417382415922f
#define NEGBIG (-1.0e30f)

#define SMEM_BYTES 131072
#define SC_STRIDE_P 2048
#define SC_STRIDE_S 4160
#define MASK_W 132
#define N_ITEMS 1088

struct P {
  const float *x_p, *x_s, *c_ckv, *c_kpe, *c_k, *c_v, *c_kidx, *norm_g, *w_in, *qn_g, *kvn_g, *w_uq, *w_uk, *w_uv,
      *rel_bias, *w_out, *fn_g;
  float* out;
  h16 *hX, *CQ, *Wt_in, *Wt_out, *Wq, *Wuv, *QM, *KM, *GA, *GB, *QB, *KB, *VB, *QI, *KI, *mix, *XN;
  float *WI, *ropeC, *ropeS, *scP, *scS, *RQP;
  unsigned* counters;
};

DI int crow(int i, int hh) { return (i & 3) + 8 * (i >> 2) + 4 * hh; }
DI float wave_sum(float v) {
#pragma unroll
  for (int off = 32; off > 0; off >>= 1) v += __shfl_xor(v, off);
  return v;
}
DI float wave_max(float v) {
#pragma unroll
  for (int off = 32; off > 0; off >>= 1) v = fmaxf(v, __shfl_xor(v, off));
  return v;
}
DI float wave_min(float v) {
#pragma unroll
  for (int off = 32; off > 0; off >>= 1) v = fminf(v, __shfl_xor(v, off));
  return v;
}
DI h4 trread(const h16* p) {
  s4v r = __builtin_amdgcn_ds_read_tr16_b64_v4i16((lds_s4p)(p));
  return __builtin_bit_cast(h4, r);
}
DI h8 cat8(h4 a, h4 b) { return __builtin_shufflevector(a, b, 0, 1, 2, 3, 4, 5, 6, 7); }
DI h8 cvt8(float4 a, float4 b) {
  h8 r;
  r[0] = (h16)a.x; r[1] = (h16)a.y; r[2] = (h16)a.z; r[3] = (h16)a.w;
  r[4] = (h16)b.x; r[5] = (h16)b.y; r[6] = (h16)b.z; r[7] = (h16)b.w;
  return r;
}
DI h8 zero8() { h8 r; for (int i = 0; i < 8; ++i) r[i] = (h16)0.f; return r; }
DI float fast_exp2(float x) { return __builtin_amdgcn_exp2f(x); }
DI float silu(float x) { return x * __builtin_amdgcn_rcpf(1.f + __expf(-x)); }
DI int rope_idx(int t) { return t < NP ? (t & 2047) : 2048 + ((t - NP) & 31); }
DI int opaque_tid() { int t = threadIdx.x; asm volatile("" : "+v"(t)); return t; }
#define XB_CNT(x) (256 + 64 * (x))
#define XB_ARR(x) (256 + 64 * (16 + (x)))
#define XB_GEN(x) (256 + 64 * (32 + (x)))
#define XB_TOP (256 + 64 * 48)
#define XB_WORDS (256 + 64 * 49)
DI unsigned xb_ld(unsigned* q) { return __hip_atomic_load(q, __ATOMIC_RELAXED, __HIP_MEMORY_SCOPE_AGENT); }
struct XBar { unsigned* w; unsigned x, nloc, nx; };
DI void xcd_barrier(XBar& xb, unsigned k, char* smem) {
  asm volatile("s_waitcnt vmcnt(0)" ::: "memory");
  __syncthreads();
  volatile unsigned* bc = (volatile unsigned*)(smem + SMEM_BYTES - 64);
  if (threadIdx.x == 0) {
    if (k == 1u) {
      const unsigned G = gridDim.x;
      unsigned sum, nxx;
      do {
        sum = 0u; nxx = 0u;
        for (int j = 0; j < 16; ++j) { const unsigned c = xb_ld(&xb.w[XB_CNT(j)]); sum += c; nxx += (c != 0u); }
        if (sum != G) __builtin_amdgcn_s_sleep(2);
      } while (sum != G);
      bc[0] = xb_ld(&xb.w[XB_CNT(xb.x)]);
      bc[1] = nxx;
    }
  }
  if (k == 1u) {
    __syncthreads();
    xb.nloc = (unsigned)__builtin_amdgcn_readfirstlane((int)bc[0]);
    xb.nx = (unsigned)__builtin_amdgcn_readfirstlane((int)bc[1]);
  }
  if (threadIdx.x == 0) {
    const unsigned old = __hip_atomic_fetch_add(&xb.w[XB_ARR(xb.x)], 1u, __ATOMIC_RELAXED, __HIP_MEMORY_SCOPE_AGENT);
    if (old + 1u == k * xb.nloc) {
      __builtin_amdgcn_fence(__ATOMIC_RELEASE, "agent");
      asm volatile("s_waitcnt vmcnt(0)" ::: "memory");
      __hip_atomic_fetch_add(&xb.w[XB_TOP], 1u, __ATOMIC_RELAXED, __HIP_MEMORY_SCOPE_AGENT);
      while (xb_ld(&xb.w[XB_TOP]) < k * xb.nx) __builtin_amdgcn_s_sleep(1);
      __hip_atomic_store(&xb.w[XB_GEN(xb.x)], k, __ATOMIC_RELAXED, __HIP_MEMORY_SCOPE_AGENT);
    } else {
      while (xb_ld(&xb.w[XB_GEN(xb.x)]) < k) __builtin_amdgcn_s_sleep(1);
    }
    __builtin_amdgcn_fence(__ATOMIC_ACQUIRE, "agent");
    asm volatile("s_waitcnt vmcnt(0)" ::: "memory");
  }
  __syncthreads();
}
DI void grid_barrier(unsigned* bar, unsigned target) {
  asm volatile("s_waitcnt vmcnt(0)" ::: "memory");
  __syncthreads();
  if (threadIdx.x == 0) {
    __builtin_amdgcn_fence(__ATOMIC_RELEASE, "agent");
    asm volatile("s_waitcnt vmcnt(0)" ::: "memory");
    __hip_atomic_fetch_add(bar, 1u, __ATOMIC_RELAXED, __HIP_MEMORY_SCOPE_AGENT);
    while (__hip_atomic_load(bar, __ATOMIC_RELAXED, __HIP_MEMORY_SCOPE_AGENT) < target) __builtin_amdgcn_s_sleep(2);
    __builtin_amdgcn_fence(__ATOMIC_ACQUIRE, "agent");
    asm volatile("s_waitcnt vmcnt(0)" ::: "memory");
  }
  __syncthreads();
}
typedef float f2v __attribute__((ext_vector_type(2)));
DI float max3f(float a, float b, float c) {
  float d;
  asm("v_max3_f32 %0, %1, %2, %3" : "=v"(d) : "v"(a), "v"(b), "v"(c));
  return d;
}
DI void mfma_settle() {
  __builtin_amdgcn_sched_barrier(0);
  asm volatile("s_nop 7\n\ts_nop 7");
  __builtin_amdgcn_sched_barrier(0);
}
DI float relu1(float x) { float d; asm("v_max_f32 %0, 0, %1" : "=v"(d) : "v"(x)); return d; }
#define MASKINIT(dst, im, BIT, nbv) asm volatile("v_bfe_i32 %0, %1, " #BIT ", 1\n\tv_and_b32 %0, %0, %2" : "=&v"(dst) : "v"(im), "v"(nbv))
#define MASKINIT16(S, im, nbv)                                                                                  \
  { float _t;                                                                                                   \
    MASKINIT(_t, im, 0, nbv); S[0] = _t; MASKINIT(_t, im, 1, nbv); S[1] = _t; MASKINIT(_t, im, 2, nbv); S[2] = _t;     \
    MASKINIT(_t, im, 3, nbv); S[3] = _t; MASKINIT(_t, im, 8, nbv); S[4] = _t; MASKINIT(_t, im, 9, nbv); S[5] = _t;     \
    MASKINIT(_t, im, 10, nbv); S[6] = _t; MASKINIT(_t, im, 11, nbv); S[7] = _t; MASKINIT(_t, im, 16, nbv); S[8] = _t;  \
    MASKINIT(_t, im, 17, nbv); S[9] = _t; MASKINIT(_t, im, 18, nbv); S[10] = _t; MASKINIT(_t, im, 19, nbv); S[11] = _t; \
    MASKINIT(_t, im, 24, nbv); S[12] = _t; MASKINIT(_t, im, 25, nbv); S[13] = _t; MASKINIT(_t, im, 26, nbv); S[14] = _t; \
    MASKINIT(_t, im, 27, nbv); S[15] = _t; }
DI void pin8(const h8& v) { asm volatile("" ::"v"(v)); }
DI void pinf(const float& v) { asm volatile("" ::"v"(v)); }
DI void wavebar() { asm volatile("s_waitcnt lgkmcnt(0)" ::: "memory"); }

__constant__ float c_inv_freq[16] = {1.000000000e+00f, 5.623413324e-01f, 3.162277639e-01f, 1.778279394e-01f,
                                     1.000000015e-01f, 5.623413250e-02f, 3.162277490e-02f, 1.778279431e-02f,
                                     9.999999776e-03f, 5.623413250e-03f, 3.162277630e-03f, 1.778279431e-03f,
                                     1.000000047e-03f, 5.623413017e-04f, 3.162277571e-04f, 1.778279402e-04f};

DI void sincos_acc(float angf, float* so, float* co) {
  const double a = (double)angf;
  const double q = rint(a * 0.6366197723675814);
  double t = fma(-q, 1.5707963267948966, a);
  t = fma(-q, 6.123233995736766e-17, t);
  const int qi = ((int)q) & 3;
  const double t2 = t * t;
  double sn = -1.0 / 1307674368000.0;
  sn = fma(sn, t2, 1.0 / 6227020800.0);
  sn = fma(sn, t2, -1.0 / 39916800.0);
  sn = fma(sn, t2, 1.0 / 362880.0);
  sn = fma(sn, t2, -1.0 / 5040.0);
  sn = fma(sn, t2, 1.0 / 120.0);
  sn = fma(sn, t2, -1.0 / 6.0);
  sn = fma(sn * t2, t, t);
  double cs = 1.0 / 20922789888000.0;
  cs = fma(cs, t2, -1.0 / 87178291200.0);
  cs = fma(cs, t2, 1.0 / 479001600.0);
  cs = fma(cs, t2, -1.0 / 3628800.0);
  cs = fma(cs, t2, 1.0 / 40320.0);
  cs = fma(cs, t2, -1.0 / 720.0);
  cs = fma(cs, t2, 1.0 / 24.0);
  cs = fma(cs, t2, -0.5);
  cs = fma(cs, t2, 1.0);
  double s, c;
  if (qi == 0) { s = sn; c = cs; }
  else if (qi == 1) { s = cs; c = -sn; }
  else if (qi == 2) { s = -sn; c = -cs; }
  else { s = -cs; c = sn; }
  *so = (float)s; *co = (float)c;
}

DI void transpose_to_h(const float* __restrict__ src, int K, int N, int Npad, h16* __restrict__ dst, char* smem) {
  float* tile = (float*)smem;
  const int tid = opaque_tid();
  const int ktn = K / 64, ntn = Npad / 64;
  for (int tix = blockIdx.x; tix < ktn * ntn; tix += gridDim.x) {
    const int k0 = (tix / ntn) * 64, n0 = (tix % ntn) * 64;
    {
      const int nn = tid & 63;
#pragma unroll
      for (int i = 0; i < 8; ++i) {
        const int kk = (tid >> 6) + 8 * i;
        const int n = n0 + nn;
        tile[kk * 65 + nn] = (n < N) ? src[(size_t)(k0 + kk) * N + n] : 0.f;
      }
    }
    __syncthreads();
    {
      const int kk = tid & 63;
#pragma unroll
      for (int i = 0; i < 8; ++i) {
        const int nn = (tid >> 6) + 8 * i;
        dst[(size_t)(n0 + nn) * K + k0 + kk] = (h16)tile[kk * 65 + nn];
      }
    }
    __syncthreads();
  }
}

DI void phase0(const P& p, char* smem) {
  const int tid = opaque_tid(), lane = tid & 63, w = tid >> 6;
  const int gw = blockIdx.x * 8 + w, nw = gridDim.x * 8;
  const int gt = blockIdx.x * NBLK_THREADS + tid, nt = gridDim.x * NBLK_THREADS;
  for (int k0 = 0; gw + nw * k0 < NTOK; k0 += 5) {
    float4 v[5][4];
    float ss[5];
#pragma unroll
    for (int rr = 0; rr < 5; ++rr) {
      const int row = gw + nw * (k0 + rr);
      if (row < NTOK) {
        const float* x = row < NP ? p.x_p + (size_t)row * DM : p.x_s + (size_t)(row - NP) * DM;
#pragma unroll
        for (int i = 0; i < 4; ++i) v[rr][i] = ((const float4*)x)[lane + 64 * i];
      } else {
#pragma unroll
        for (int i = 0; i < 4; ++i) v[rr][i] = make_float4(0.f, 0.f, 0.f, 0.f);
      }
    }
#pragma unroll
    for (int rr = 0; rr < 5; ++rr) {
      float a = 0.f;
#pragma unroll
      for (int i = 0; i < 4; ++i)
        a += v[rr][i].x * v[rr][i].x + v[rr][i].y * v[rr][i].y + v[rr][i].z * v[rr][i].z + v[rr][i].w * v[rr][i].w;
      ss[rr] = a;
    }
#pragma unroll
    for (int off = 32; off > 0; off >>= 1) {
#pragma unroll
      for (int rr = 0; rr < 5; ++rr) ss[rr] += __shfl_xor(ss[rr], off);
    }
    float4 g[4];
#pragma unroll
    for (int i = 0; i < 4; ++i) g[i] = ((const float4*)p.norm_g)[lane + 64 * i];
#pragma unroll
    for (int rr = 0; rr < 5; ++rr) {
      const int row = gw + nw * (k0 + rr);
      if (row < NTOK) {
        const float rstd = rsqrtf(ss[rr] * (1.f / 1024.f) + 1e-6f);
#pragma unroll
        for (int i = 0; i < 4; ++i) {
          h4 o;
          o[0] = (h16)(v[rr][i].x * rstd * g[i].x); o[1] = (h16)(v[rr][i].y * rstd * g[i].y);
          o[2] = (h16)(v[rr][i].z * rstd * g[i].z); o[3] = (h16)(v[rr][i].w * rstd * g[i].w);
          *(h4*)(p.hX + (size_t)row * DM + (lane + 64 * i) * 4) = o;
        }
      }
    }
  }
  transpose_to_h(p.w_in, 1024, INW, INWP, p.Wt_in, smem);
  transpose_to_h(p.w_out, 1024, 1024, 1024, p.Wt_out, smem);
  for (int wt = gw; wt < 256; wt += nw) {
    const int hd = wt >> 5, k0 = ((wt >> 2) & 7) * 32, c0 = (wt & 3) * 32;
    const int r = lane & 31, hh = lane >> 5;
    f16v D;
#pragma unroll
    for (int i = 0; i < 16; ++i) D[i] = 0.f;
#pragma unroll
    for (int t = 0; t < 4; ++t) {
      const float* ap = p.w_uq + (size_t)(k0 + r) * 768 + hd * 96 + 16 * t + 8 * hh;
      const float* bp = p.w_uk + (size_t)(c0 + r) * 512 + hd * 64 + 16 * t + 8 * hh;
      const h8 a = cvt8(*(const float4*)ap, *(const float4*)(ap + 4));
      const h8 bq = cvt8(*(const float4*)bp, *(const float4*)(bp + 4));
      D = MFMA32(a, bq, D);
    }
#pragma unroll
    for (int g4 = 0; g4 < 4; ++g4) {
      const int k = k0 + 8 * g4 + 4 * hh;
      const float4 g = *(const float4*)(p.qn_g + k);
      h4 o;
      o[0] = (h16)(D[4 * g4 + 0] * g.x); o[1] = (h16)(D[4 * g4 + 1] * g.y);
      o[2] = (h16)(D[4 * g4 + 2] * g.z); o[3] = (h16)(D[4 * g4 + 3] * g.w);
      *(h4*)(p.Wq + (size_t)(hd * 128 + c0 + r) * 256 + k) = o;
    }
  }
  for (int idx = gt; idx < 256 * 256; idx += nt) {
    const int n = 1024 + (idx >> 8), k = idx & 255;
    const int hd = (n - 1024) >> 5, rr = (n - 1024) & 31;
    p.Wq[(size_t)n * 256 + k] = (h16)(p.w_uq[(size_t)k * 768 + hd * 96 + 64 + rr] * p.qn_g[k]);
  }
  for (int idx = gt; idx < 8 * 64 * 128; idx += nt) {
    const int j = idx & 7, ln = (idx >> 3) & 63, sq = (idx >> 9) & 1, dt = (idx >> 10) & 3, vt = (idx >> 12) & 1, hd = idx >> 13;
    const int v = 32 * vt + (ln & 31);
    const int c = 32 * dt + 16 * sq + 8 * (j >> 2) + 4 * (ln >> 5) + (j & 3);
    p.Wuv[idx] = (h16)p.w_uv[(size_t)c * 512 + hd * 64 + v];
  }
  for (int idx = gt; idx < 2080 * 16; idx += nt) {
    const int pi = idx >> 4, j = idx & 15;
    const int pos = pi < 2048 ? pi : PAST + (pi - 2048);
    const float ang = (float)pos * c_inv_freq[j];
    float s, c;
    sincos_acc(ang, &s, &c);
    p.ropeC[idx] = c; p.ropeS[idx] = s;
  }
}

template <int BM, int BN, int WGM, int WGN>
DI void gemm_tile(const h16* __restrict__ A, int lda, const h16* __restrict__ B, int ldb, int K, int m0, int n0,
                  char* smem) {
  constexpr int LS = 72, TS = 136;
  constexpr int TM = BM / WGM, TN = BN / WGN, MI = TM / 32, NI = TN / 32;
  constexpr int ACH = BM * 8 / NBLK_THREADS, BCH = BN * 8 / NBLK_THREADS;
  h16* sA = (h16*)smem;
  h16* sB = sA + 2 * BM * LS;
  const int tid = opaque_tid(), lane = tid & 63, w = tid >> 6;
  const int wm = w / WGN, wn = w % WGN;
  const int r = lane & 31, hh = lane >> 5;
  f16v acc[MI][NI];
#pragma unroll
  for (int mi = 0; mi < MI; ++mi)
#pragma unroll
    for (int ni = 0; ni < NI; ++ni)
#pragma unroll
      for (int i = 0; i < 16; ++i) acc[mi][ni][i] = 0.f;
  h8 ra[ACH], rb[BCH];
  const int KT = K / 64;
#define GLOAD(kt)                                                                                   \
  {                                                                                                 \
    _Pragma("unroll") for (int i = 0; i < ACH; ++i) {                                               \
      const int q = tid + NBLK_THREADS * i;                                                         \
      ra[i] = *(const h8*)(A + (size_t)(m0 + (q >> 3)) * lda + (kt) * 64 + (q & 7) * 8);            \
    }                                                                                               \
    _Pragma("unroll") for (int i = 0; i < BCH; ++i) {                                               \
      const int q = tid + NBLK_THREADS * i;                                                         \
      rb[i] = *(const h8*)(B + (size_t)(n0 + (q >> 3)) * ldb + (kt) * 64 + (q & 7) * 8);            \
    }                                                                                               \
  }
#define SSTORE(buf)                                                                                 \
  {                                                                                                 \
    _Pragma("unroll") for (int i = 0; i < ACH; ++i) {                                               \
      const int q = tid + NBLK_THREADS * i;                                                         \
      *(h8*)(sA + ((buf) * BM + (q >> 3)) * LS + (q & 7) * 8) = ra[i];                              \
    }                                                                                               \
    _Pragma("unroll") for (int i = 0; i < BCH; ++i) {                                               \
      const int q = tid + NBLK_THREADS * i;                                                         \
      *(h8*)(sB + ((buf) * BN + (q >> 3)) * LS + (q & 7) * 8) = rb[i];                              \
    }                                                                                               \
  }
  GLOAD(0);
  SSTORE(0);
  __syncthreads();
  int buf = 0;
  for (int kt = 0; kt < KT; ++kt) {
    if (kt + 1 < KT) GLOAD(kt + 1);
    const h16* a_base = sA + (buf * BM + wm * TM + r) * LS + 8 * hh;
    const h16* b_base = sB + (buf * BN + wn * TN + r) * LS + 8 * hh;
#pragma unroll
    for (int t = 0; t < 4; ++t) {
      h8 af[MI], bf[NI];
#pragma unroll
      for (int mi = 0; mi < MI; ++mi) af[mi] = *(const h8*)(a_base + mi * 32 * LS + t * 16);
#pragma unroll
      for (int ni = 0; ni < NI; ++ni) bf[ni] = *(const h8*)(b_base + ni * 32 * LS + t * 16);
#pragma unroll
      for (int mi = 0; mi < MI; ++mi)
#pragma unroll
        for (int ni = 0; ni < NI; ++ni) acc[mi][ni] = MFMA32(bf[ni], af[mi], acc[mi][ni]);
    }
    if (kt + 1 < KT) SSTORE(buf ^ 1);
    __syncthreads();
    buf ^= 1;
  }
#undef GLOAD
#undef SSTORE
  h16* T = (h16*)smem;
#pragma unroll
  for (int mi = 0; mi < MI; ++mi)
#pragma unroll
    for (int ni = 0; ni < NI; ++ni)
#pragma unroll
      for (int g4 = 0; g4 < 4; ++g4) {
        h4 o;
#pragma unroll
        for (int jj = 0; jj < 4; ++jj) o[jj] = (h16)acc[mi][ni][4 * g4 + jj];
        *(h4*)(T + (wm * TM + mi * 32 + r) * TS + wn * TN + ni * 32 + 8 * g4 + 4 * hh) = o;
      }
  __syncthreads();
}

template <int OP>
DI void epi_simple(const h16* T, int m0, h16* dst, int ld, int col0, int tid) {
  h8 v[8];
#pragma unroll
  for (int it = 0; it < 8; ++it) {
    const int q = tid + NBLK_THREADS * it;
    v[it] = *(const h8*)(T + (q >> 4) * 136 + (q & 15) * 8);
  }
#pragma unroll
  for (int it = 0; it < 8; ++it) {
    const int q = tid + NBLK_THREADS * it;
    h8 o;
#pragma unroll
    for (int e = 0; e < 8; ++e) {
      const float x = (float)v[it][e];
      o[e] = (OP == 1) ? (h16)silu(x) : (OP == 2) ? (h16)(x * QB_SCALE) : v[it][e];
    }
    *(h8*)(dst + (size_t)(m0 + (q >> 4)) * ld + col0 + (q & 15) * 8) = o;
  }
}
DI float4 f4_lo(h8 v) { return make_float4((float)v[0], (float)v[1], (float)v[2], (float)v[3]); }
DI float4 f4_hi(h8 v) { return make_float4((float)v[4], (float)v[5], (float)v[6], (float)v[7]); }
typedef float f32x4 __attribute__((ext_vector_type(4)));
typedef __attribute__((address_space(3))) unsigned* lds_u32p;
DI int g8_lds_byte(int r, int c) {
  const int st = (r >> 4) * 2 + (c >> 5), rr = r & 15, cc = c & 31, ob = rr * 64 + cc * 2;
  return st * 1024 + (ob ^ (((ob >> 9) & 1) << 5));
}
DI void g8_stage_rc(int b, int& R, int& C) {
  const int st = b / 1024, sb = b % 1024, swz = sb ^ (((sb >> 9) & 1) << 5);
  R = (st >> 1) * 16 + swz / 64;
  C = (st & 1) * 32 + (swz % 64) / 2;
}
#define G8_HT (128 * 64)
DI void gemm8_mainloop(const h16* __restrict__ A, const h16* __restrict__ Bt, int K, int brow, int bcol, char* smem,
                       f32x4 (&acc)[2][2][4][2]) {
  h16* shm = (h16*)smem;
  const int tid = opaque_tid();
  const int wid = tid >> 6, lane = tid & 63, wr = wid >> 2, wc = wid & 3, fr = lane & 15, fq = lane >> 4;
  int so[2];
#pragma unroll
  for (int i = 0; i < 2; ++i) { int R, C; g8_stage_rc(tid * 16 + i * 8192, R, C); so[i] = R * K + C; }
#define G8_SA(b, h) (shm + ((b) * 2 + (h)) * G8_HT)
#define G8_SB(b, h) (shm + (4 + (b) * 2 + (h)) * G8_HT)
#define G8_STAGE(Pp, BASE, br, kt)                                                                        \
  do {                                                                                                    \
    const h16* _bp = (BASE) + (size_t)(br) * K + (kt) * 64;                              \
    _Pragma("unroll") for (int _i = 0; _i < 2; ++_i) {                                                    \
      const h16* _g = _bp + so[_i];                                                                       \
      __builtin_amdgcn_global_load_lds((const unsigned*)_g,                                               \
                                       (lds_u32p)((char*)(Pp) + tid * 16 + _i * 8192), 16, 0, 0);         \
    }                                                                                                     \
  } while (0)
#define G8_LDA(dst, b, h)                                                                                 \
  _Pragma("unroll") for (int m = 0; m < 4; ++m) _Pragma("unroll") for (int k = 0; k < 2; ++k)             \
    dst[m][k] = *(const h8*)((const char*)G8_SA(b, h) + g8_lds_byte(wr * 64 + m * 16 + fr, k * 32 + fq * 8))
#define G8_LDB(dst, b, h)                                                                                 \
  _Pragma("unroll") for (int n = 0; n < 2; ++n) _Pragma("unroll") for (int k = 0; k < 2; ++k)             \
    dst[n][k] = *(const h8*)((const char*)G8_SB(b, h) + g8_lds_byte(wc * 32 + n * 16 + fr, k * 32 + fq * 8))
#define G8_MMA(ai, bj, At, Bq)                                                                            \
  do {                                                                                                    \
    __builtin_amdgcn_s_setprio(1);                                                                        \
    _Pragma("unroll") for (int m = 0; m < 4; ++m) _Pragma("unroll") for (int n = 0; n < 2; ++n)           \
      _Pragma("unroll") for (int k = 0; k < 2; ++k)                                                       \
        acc[ai][bj][m][n] = __builtin_amdgcn_mfma_f32_16x16x32_f16(Bq[n][k], At[m][k], acc[ai][bj][m][n], 0, 0, 0); \
    __builtin_amdgcn_s_setprio(0);                                                                        \
  } while (0)
#define G8_WAIT_V(n) asm volatile("s_waitcnt vmcnt(" #n ")" ::: "memory")
#define G8_WAIT_L(n) asm volatile("s_waitcnt lgkmcnt(" #n ")" ::: "memory")
#define G8_BAR __builtin_amdgcn_s_barrier()
#define G8_SCHED __builtin_amdgcn_sched_barrier(0)
#pragma unroll
  for (int a = 0; a < 2; ++a)
#pragma unroll
    for (int b = 0; b < 2; ++b)
#pragma unroll
      for (int m = 0; m < 4; ++m)
#pragma unroll
        for (int n = 0; n < 2; ++n) acc[a][b][m][n] = f32x4{0.f, 0.f, 0.f, 0.f};
  h8 At[4][2], B0[2][2], B1[2][2];
  const int nt = K / 64;
  G8_STAGE(G8_SB(0, 0), Bt, bcol, 0); G8_STAGE(G8_SA(0, 0), A, brow, 0);
  G8_STAGE(G8_SB(0, 1), Bt, bcol + 128, 0); G8_STAGE(G8_SA(0, 1), A, brow + 128, 0);
  if (wr == 1) G8_BAR;
  G8_WAIT_V(4); G8_BAR;
  G8_STAGE(G8_SB(1, 0), Bt, bcol, 1); G8_STAGE(G8_SA(1, 0), A, brow, 1); G8_STAGE(G8_SB(1, 1), Bt, bcol + 128, 1);
  G8_WAIT_V(6); G8_BAR;
  for (int t = 0; t < nt - 2; t += 2) {
    G8_LDB(B0, 0, 0); G8_SCHED; G8_LDA(At, 0, 0); G8_STAGE(G8_SA(1, 1), A, brow + 128, t + 1);
    G8_WAIT_L(8); G8_BAR; G8_WAIT_L(0); G8_MMA(0, 0, At, B0); G8_BAR; G8_SCHED;
    G8_LDB(B1, 0, 1); G8_STAGE(G8_SB(0, 0), Bt, bcol, t + 2);
    G8_BAR; G8_WAIT_L(0); G8_MMA(0, 1, At, B1); G8_BAR;
    G8_LDA(At, 0, 1); G8_STAGE(G8_SA(0, 0), A, brow, t + 2);
    G8_BAR; G8_WAIT_L(0); G8_MMA(1, 0, At, B0); G8_BAR; G8_SCHED;
    G8_STAGE(G8_SB(0, 1), Bt, bcol + 128, t + 2);
    G8_WAIT_V(6); G8_BAR; G8_MMA(1, 1, At, B1); G8_BAR;
    G8_LDB(B0, 1, 0); G8_SCHED; G8_LDA(At, 1, 0); G8_STAGE(G8_SA(0, 1), A, brow + 128, t + 2);
    G8_WAIT_L(8); G8_BAR; G8_WAIT_L(0); G8_MMA(0, 0, At, B0); G8_BAR; G8_SCHED;
    G8_LDB(B1, 1, 1); G8_STAGE(G8_SB(1, 0), Bt, bcol, t + 3);
    G8_BAR; G8_WAIT_L(0); G8_MMA(0, 1, At, B1); G8_BAR;
    G8_LDA(At, 1, 1); G8_STAGE(G8_SA(1, 0), A, brow, t + 3);
    G8_BAR; G8_WAIT_L(0); G8_MMA(1, 0, At, B0); G8_BAR; G8_SCHED;
    G8_STAGE(G8_SB(1, 1), Bt, bcol + 128, t + 3);
    G8_WAIT_V(6); G8_BAR; G8_MMA(1, 1, At, B1); G8_BAR;
  }
  { G8_LDB(B0, 0, 0); G8_LDA(At, 0, 0); G8_STAGE(G8_SA(1, 1), A, brow + 128, nt - 1);
    G8_BAR; G8_WAIT_L(0); G8_MMA(0, 0, At, B0); G8_BAR;
    G8_LDB(B1, 0, 1); G8_BAR; G8_WAIT_L(0); G8_MMA(0, 1, At, B1); G8_BAR;
    G8_LDA(At, 0, 1); G8_WAIT_V(4); G8_BAR; G8_WAIT_L(0); G8_MMA(1, 0, At, B0); G8_MMA(1, 1, At, B1); G8_BAR; }
  { G8_LDB(B0, 1, 0); G8_LDA(At, 1, 0); G8_WAIT_V(2); G8_BAR; G8_WAIT_L(0); G8_MMA(0, 0, At, B0); G8_BAR;
    G8_LDB(B1, 1, 1); G8_WAIT_V(0); G8_BAR; G8_WAIT_L(0); G8_MMA(0, 1, At, B1); G8_BAR;
    G8_LDA(At, 1, 1); G8_BAR; G8_WAIT_L(0); G8_MMA(1, 0, At, B0); G8_MMA(1, 1, At, B1); G8_BAR; }
  if (wr == 0) G8_BAR;
#undef G8_SA
#undef G8_SB
#undef G8_STAGE
#undef G8_LDA
#undef G8_LDB
#undef G8_MMA
}

DI void p1_epilogue(const P& p, const h16* T, int m0, int n0, int nt, bool isP) {
  constexpr int TS = 136;
  const int tid = opaque_tid(), lane = tid & 63, w = tid >> 6;
  if (nt == 2) {
    for (int rr = w; rr < 256; rr += 8) {
      const int m = m0 + rr;
      const h2 v2 = *(const h2*)(T + rr * TS + 2 * lane);
      const float a = (float)v2[0], b = (float)v2[1];
      const float ss = wave_sum(a * a + b * b);
      const float rstd = rsqrtf(ss * (1.f / 128.f) + 1e-6f);
      const float2 g = *(const float2*)(p.kvn_g + 2 * lane);
      const float o0 = a * rstd * g.x, o1 = b * rstd * g.y;
      float* oc = isP ? p.out + OFF_P_CKV + (size_t)m * 128 : p.out + OFF_S_CKV + (size_t)(m - NP) * 128;
      *(float2*)(oc + 2 * lane) = make_float2(o0, o1);
      h2 o; o[0] = (h16)o0; o[1] = (h16)o1;
      *(h2*)(p.KM + (size_t)m * 160 + 2 * lane) = o;
    }
  } else if (nt >= 4 && nt <= 6) {
    epi_simple<1>(T, m0, p.GA, 512, n0 - ZC_GA, tid);
  } else if (nt >= 8 && nt <= 10) {
    epi_simple<2>(T, m0, p.QB, 512, n0 - ZC_QB, tid);
  } else if (nt >= 14 && nt <= 16) {
    epi_simple<0>(T, m0, p.QI, 512, n0 - ZC_QI, tid);
  } else if (nt >= 18 && nt <= 20) {
    epi_simple<1>(T, m0, p.GB, 512, n0 - ZC_GB, tid);
  } else {
#pragma unroll 1
    for (int it = 0; it < 8; ++it) {
      const int q = tid + NBLK_THREADS * it;
      const int row = q >> 4, ch = q & 15;
      const int col = n0 + ch * 8, m = m0 + row;
      const int ms = isP ? m : m - NP;
      const h8 v = *(const h8*)(T + row * TS + ch * 8);
      if (col < ZC_CKV) {
        *(h8*)(p.CQ + (size_t)m * 256 + col) = v;
        float ss = 0.f;
#pragma unroll
        for (int e = 0; e < 8; ++e) ss += (float)v[e] * (float)v[e];
        ss += __shfl_xor(ss, 1); ss += __shfl_xor(ss, 2); ss += __shfl_xor(ss, 4); ss += __shfl_xor(ss, 8);
        if (ch == 0) p.RQP[(size_t)m * 2 + nt] = ss;
      } else if (col < ZC_GA) {
        const int j0 = col - ZC_KPE;
        const bool hiHalf = j0 >= 16;
        const h8 u = *(const h8*)(T + row * TS + (hiHalf ? ch - 2 : ch + 2) * 8);
        const int ri = rope_idx(m) * 16 + (j0 & 15);
        const float4 c0 = *(const float4*)(p.ropeC + ri), c1 = *(const float4*)(p.ropeC + ri + 4);
        const float4 s0 = *(const float4*)(p.ropeS + ri), s1 = *(const float4*)(p.ropeS + ri + 4);
        const float cs[8] = {c0.x, c0.y, c0.z, c0.w, c1.x, c1.y, c1.z, c1.w};
        const float sn[8] = {s0.x, s0.y, s0.z, s0.w, s1.x, s1.y, s1.z, s1.w};
        float o[8];
        h8 oh;
#pragma unroll
        for (int e = 0; e < 8; ++e) {
          const float mine = (float)v[e], other = (float)u[e];
          o[e] = hiHalf ? (other * sn[e] + mine * cs[e]) : (mine * cs[e] - other * sn[e]);
          oh[e] = (h16)o[e];
        }
        float* oc = (isP ? p.out + OFF_P_KPE : p.out + OFF_S_KPE) + (size_t)ms * 32 + j0;
        *(float4*)oc = make_float4(o[0], o[1], o[2], o[3]);
        *(float4*)(oc + 4) = make_float4(o[4], o[5], o[6], o[7]);
        *(h8*)(p.KM + (size_t)m * 160 + 128 + j0) = oh;
      } else if (col < ZC_QB) {
        h8 o;
#pragma unroll
        for (int e = 0; e < 8; ++e) o[e] = (h16)silu((float)v[e]);
        *(h8*)(p.GA + (size_t)m * 512 + (col - ZC_GA)) = o;
      } else if (col < ZC_KB) {
        h8 o;
#pragma unroll
        for (int e = 0; e < 8; ++e) o[e] = (h16)((float)v[e] * QB_SCALE);
        *(h8*)(p.QB + (size_t)m * 512 + (col - ZC_QB)) = o;
      } else if (col < ZC_QI) {
        const bool isK = col < ZC_VB;
        const int c0 = col - (isK ? ZC_KB : ZC_VB);
        float* oc = (isK ? (isP ? p.out + OFF_P_K : p.out + OFF_S_K) : (isP ? p.out + OFF_P_V : p.out + OFF_S_V)) +
                    (size_t)ms * 128 + c0;
        *(float4*)oc = f4_lo(v);
        *(float4*)(oc + 4) = f4_hi(v);
        *(h8*)((isK ? p.KB : p.VB) + (size_t)m * 128 + c0) = v;
      } else if (col < ZC_KI) {
        *(h8*)(p.QI + (size_t)m * 512 + (col - ZC_QI)) = v;
      } else if (col < ZC_WI) {
        float* oc = (isP ? p.out + OFF_P_KIDX : p.out + OFF_S_KIDX) + (size_t)ms * 64 + (col - ZC_KI);
        *(float4*)oc = f4_lo(v);
        *(float4*)(oc + 4) = f4_hi(v);
        *(h8*)(p.KI + (size_t)m * 64 + (col - ZC_KI)) = v;
      } else if (col < ZC_GB) {
        float* oc = p.WI + (size_t)m * 8;
        const float4 a = f4_lo(v), b = f4_hi(v);
        *(float4*)oc = make_float4(a.x * WI_SCALE, a.y * WI_SCALE, a.z * WI_SCALE, a.w * WI_SCALE);
        *(float4*)(oc + 4) = make_float4(b.x * WI_SCALE, b.y * WI_SCALE, b.z * WI_SCALE, b.w * WI_SCALE);
      } else if (col < INW) {
        h8 o;
#pragma unroll
        for (int e = 0; e < 8; ++e) o[e] = (h16)silu((float)v[e]);
        *(h8*)(p.GB + (size_t)m * 512 + (col - ZC_GB)) = o;
      }
    }
  }
}

DI void phase1(const P& p, char* smem) {
  constexpr int TS = 136;
  h16* T = (h16*)smem;
  const int ntiles = 68 * 11;
  const int xcd = blockIdx.x & 7, lb = blockIdx.x >> 3, nlb = gridDim.x >> 3;
  const int per = (ntiles + 7) >> 3;
  const int tend = (xcd * per + per) < ntiles ? (xcd * per + per) : ntiles;
  for (int L = xcd * per + lb; L < tend; L += nlb) {
    const int pg = L / 44, rem = L - pg * 44;
    const int pn = rem >> 2, mt = pg * 4 + (rem & 3);
    const int m0 = mt * 256;
    const bool isP = mt < 64;
    f32x4 acc[2][2][4][2];
    gemm8_mainloop(p.hX, p.Wt_in, DM, m0, pn * 256, smem, acc);
    __syncthreads();
    const int tid = opaque_tid();
    const int wid = tid >> 6, lane = tid & 63, wr = wid >> 2, wc = wid & 3, fr = lane & 15, fq = lane >> 4;
#pragma unroll
    for (int bj = 0; bj < 2; ++bj) {
#pragma unroll
      for (int ai = 0; ai < 2; ++ai)
#pragma unroll
        for (int m = 0; m < 4; ++m)
#pragma unroll
          for (int n = 0; n < 2; ++n)
          {
            h4 o;
#pragma unroll
            for (int jj = 0; jj < 4; ++jj) o[jj] = (h16)acc[ai][bj][m][n][jj];
            *(h4*)(T + (ai * 128 + wr * 64 + m * 16 + fr) * TS + wc * 32 + n * 16 + fq * 4) = o;
          }
      __syncthreads();
      p1_epilogue(p, T, m0, pn * 256 + bj * 128, pn * 2 + bj, isP);
      __syncthreads();
    }
  }
}

DI size_t qm_index(int m, int hd, int d) {
  return ((((size_t)(m >> 5) * 8 + hd) * 10 + (d >> 4)) * 64 + (((d >> 3) & 1) * 32 + (m & 31))) * 8 + (d & 7);
}
DI void phase1b(const P& p, char* smem) {
  constexpr int TS = 136;
  h16* T = (h16*)smem;
  float* rq = (float*)(smem + 128 * 1024 - 2048);
  const int ntiles = 68 * 5;
  for (int tile = blockIdx.x; tile < ntiles; tile += gridDim.x) {
    const int mt = tile / 5, pn = tile % 5;
    const int m0 = mt * 256;
    f32x4 acc[2][2][4][2];
    gemm8_mainloop(p.CQ, p.Wq, 256, m0, pn * 256, smem, acc);
    __syncthreads();
    const int tid = opaque_tid();
    if (tid < 256) {
      const float2 pp = *(const float2*)(p.RQP + (size_t)(m0 + tid) * 2);
      rq[tid] = rsqrtf((pp.x + pp.y) * (1.f / 256.f) + 1e-6f) * QM_SCALE;
    }
    const int wid = tid >> 6, lane = tid & 63, wr = wid >> 2, wc = wid & 3, fr = lane & 15, fq = lane >> 4;
#pragma unroll
    for (int bj = 0; bj < 2; ++bj) {
      const int nt = pn * 2 + bj;
#pragma unroll
      for (int ai = 0; ai < 2; ++ai)
#pragma unroll
        for (int m = 0; m < 4; ++m)
#pragma unroll
          for (int n = 0; n < 2; ++n)
          {
            h4 o;
#pragma unroll
            for (int jj = 0; jj < 4; ++jj) o[jj] = (h16)acc[ai][bj][m][n][jj];
            *(h4*)(T + (ai * 128 + wr * 64 + m * 16 + fr) * TS + wc * 32 + n * 16 + fq * 4) = o;
          }
      __syncthreads();
#pragma unroll 2
      for (int it = 0; it < 8; ++it) {
        const int q = tid + NBLK_THREADS * it;
        const int row = q >> 4, ch = q & 15;
        const int m = m0 + row;
        const float sc = rq[row];
        const h8 v = *(const h8*)(T + row * TS + ch * 8);
        h8 o;
        int hd, d0;
        if (nt < 8) {
          hd = nt; d0 = ch * 8;
#pragma unroll
          for (int e = 0; e < 8; ++e) o[e] = (h16)((float)v[e] * sc);
        } else {
          hd = (nt - 8) * 4 + (ch >> 2);
          const int j0 = (ch & 3) * 8;
          d0 = 128 + j0;
          const bool hiHalf = j0 >= 16;
          const h8 u = *(const h8*)(T + row * TS + (hiHalf ? ch - 2 : ch + 2) * 8);
          const int ri = rope_idx(m) * 16 + (j0 & 15);
          const float4 c0 = *(const float4*)(p.ropeC + ri), c1 = *(const float4*)(p.ropeC + ri + 4);
          const float4 s0 = *(const float4*)(p.ropeS + ri), s1 = *(const float4*)(p.ropeS + ri + 4);
          const float cs[8] = {c0.x, c0.y, c0.z, c0.w, c1.x, c1.y, c1.z, c1.w};
          const float sn[8] = {s0.x, s0.y, s0.z, s0.w, s1.x, s1.y, s1.z, s1.w};
#pragma unroll
          for (int e = 0; e < 8; ++e) {
            const float mine = (float)v[e] * sc, other = (float)u[e] * sc;
            o[e] = (h16)(hiHalf ? (other * sn[e] + mine * cs[e]) : (mine * cs[e] - other * sn[e]));
          }
        }
        *(h8*)(p.QM + qm_index(m, hd, d0)) = o;
      }
      __syncthreads();
    }
  }
}

template <bool SAMPLE>
DI void mla_item(const P& p, int b, int tok0, int nkeys, char* smem, const int tid, unsigned* ctr, int& nxt) {
  constexpr int KS = 168;
  h16* sK = (h16*)smem;
  const int lane = tid & 63, w = tid >> 6;
  const int r = lane & 31, hh = lane >> 5;
  const int i16 = lane & 15, q4 = i16 >> 2, p4 = i16 & 3, blk = (lane >> 4) & 1;

  h8 qf[10];
  {
    const h16* qp = p.QM + ((size_t)((tok0 >> 5) * 8 + w) * 10 * 64 + lane) * 8;
#pragma unroll
    for (int t = 0; t < 10; ++t) qf[t] = *(const h8*)(qp + t * 512);
  }
  f16v O[4];
#pragma unroll
  for (int dt = 0; dt < 4; ++dt)
#pragma unroll
    for (int i = 0; i < 16; ++i) O[dt][i] = 0.f;
  float m = NEGBIG, l = 0.f;

  h8 sh[3];
  float4 sf[3][2];
  const int NT = (nkeys + 63) >> 6;

#define MLA_GLOAD(kt)                                                                                          \
  {                                                                                                            \
    _Pragma("unroll") for (int i = 0; i < 3; ++i) {                                                            \
      const int q = tid + NBLK_THREADS * i;                                                                    \
      const int row = q / 20, cc = q % 20;                                                                     \
      const int s = (kt) * 64 + row;                                                                           \
      if (q < 1280) {                                                                                          \
        if (!SAMPLE) {                                                                                         \
          sh[i] = *(const h8*)(p.KM + (size_t)(b * 2048 + s) * 160 + cc * 8);                                  \
        } else {                                                                                               \
          if (s < PAST) {                                                                                      \
            const float* src = (cc < 16) ? p.c_ckv + ((size_t)(b * PAST + s) * 128 + cc * 8)                   \
                                         : p.c_kpe + ((size_t)(b * PAST + s) * 32 + (cc - 16) * 8);            \
            sf[i][0] = *(const float4*)src; sf[i][1] = *(const float4*)(src + 4);                              \
          } else if (s < SKEYS) {                                                                              \
            sf[i][0] = __builtin_bit_cast(float4, *(const h8*)(p.KM + (size_t)(NP + b * 32 + (s - PAST)) * 160 + cc * 8)); \
          } else {                                                                                             \
            sf[i][0] = make_float4(0.f, 0.f, 0.f, 0.f);                                                        \
          }                                                                                                    \
        }                                                                                                      \
      }                                                                                                        \
    }                                                                                                          \
  }
#define MLA_SSTORE(kt, buf)                                                                                    \
  {                                                                                                            \
    _Pragma("unroll") for (int i = 0; i < 3; ++i) {                                                            \
      const int q = tid + NBLK_THREADS * i;                                                                    \
      const int row = q / 20, cc = q % 20;                                                                     \
      const int s = (kt) * 64 + row;                                                                           \
      if (q < 1280) {                                                                                          \
        h8 v;                                                                                                  \
        if (SAMPLE) v = (s < PAST) ? cvt8(sf[i][0], sf[i][1]) : __builtin_bit_cast(h8, sf[i][0]);              \
        else v = sh[i];                                                                                        \
        *(h8*)(sK + ((buf) * 64 + row) * KS + cc * 8) = v;                                                     \
      }                                                                                                        \
    }                                                                                                          \
  }

  MLA_GLOAD(0);
#pragma unroll
  for (int t = 0; t < 10; ++t) pin8(qf[t]);
  MLA_SSTORE(0, 0);
  __syncthreads();
  int buf = 0;
  for (int kt = 0; kt < NT; ++kt) {
    if (kt + 1 < NT) MLA_GLOAD(kt + 1);
    const bool two = (nkeys - kt * 64) > 32;
    const h16* kbase = sK + buf * 64 * KS;
    const h16* ka_ptr = kbase + r * KS + 8 * hh;
    const h16* vb_ptr = kbase + (4 * hh + q4) * KS + 16 * blk + 4 * p4;
    f16v S0, S1;
#pragma unroll
    for (int i = 0; i < 16; ++i) { S0[i] = 0.f; S1[i] = 0.f; }
    {
      h8 ka0[3], ka1[3];
#pragma unroll
      for (int t = 0; t < 3; ++t) {
        ka0[t] = *(const h8*)(ka_ptr + 16 * t);
        ka1[t] = *(const h8*)(ka_ptr + 32 * KS + 16 * t);
      }
#pragma unroll
      for (int t = 0; t < 10; ++t) {
        S0 = MFMA32(ka0[t % 3], qf[t], S0);
        S1 = MFMA32(ka1[t % 3], qf[t], S1);
        if (t + 3 < 10) {
          ka0[t % 3] = *(const h8*)(ka_ptr + 16 * (t + 3));
          ka1[t % 3] = *(const h8*)(ka_ptr + 32 * KS + 16 * (t + 3));
        }
      }
    }
    h8 vf[4];
#define MLA_VLOAD(f)                                                                   \
  {                                                                                    \
    const h16* vp = vb_ptr + ((((f) >> 3) * 32) + ((((f) >> 2) & 1) * 16)) * KS + 32 * ((f) & 3); \
    vf[(f) & 3] = cat8(trread(vp), trread(vp + 8 * KS));                               \
  }
#pragma unroll
    for (int f = 0; f < 4; ++f) MLA_VLOAD(f);
    if (!two) {
      asm volatile("" ::: "memory");
#pragma unroll
      for (int i = 0; i < 16; ++i) S1[i] = NEGBIG;
    }
    mfma_settle();
    float mx = max3f(S0[0], S0[1], S1[0]);
    mx = max3f(mx, S1[1], S0[2]);
#pragma unroll
    for (int i = 2; i < 15; ++i) mx = max3f(mx, S1[i], S0[i + 1]);
    mx = fmaxf(mx, S1[15]);
    mx = fmaxf(mx, __shfl_xor(mx, 32));
    if (__any(mx > m)) {
      const float mn = fmaxf(m, mx);
      const float alpha = fast_exp2(m - mn);
      m = mn;
      l *= alpha;
#pragma unroll
      for (int dt = 0; dt < 4; ++dt)
#pragma unroll
        for (int i = 0; i < 16; ++i) O[dt][i] *= alpha;
    }
    {
      const f2v m2 = {m, m};
      f2v rs2 = {0.f, 0.f};
#pragma unroll
      for (int i = 0; i < 16; i += 2) {
        f2v a = {S0[i], S0[i + 1]};
        f2v b = {S1[i], S1[i + 1]};
        a -= m2; b -= m2;
        a[0] = fast_exp2(a[0]); a[1] = fast_exp2(a[1]);
        b[0] = fast_exp2(b[0]); b[1] = fast_exp2(b[1]);
        rs2 += a; rs2 += b;
        S0[i] = a[0]; S0[i + 1] = a[1]; S1[i] = b[0]; S1[i + 1] = b[1];
      }
      l += rs2[0] + rs2[1];
    }
    h8 pb[4];
#pragma unroll
    for (int g = 0; g < 4; ++g)
#pragma unroll
      for (int jj = 0; jj < 8; ++jj) pb[g][jj] = (h16)((g < 2) ? S0[8 * (g & 1) + jj] : S1[8 * (g & 1) + jj]);
#pragma unroll
    for (int f = 0; f < 16; ++f) {
      O[f & 3] = MFMA32(vf[f & 3], pb[f >> 2], O[f & 3]);
      if (f + 4 < 16) MLA_VLOAD(f + 4);
    }
#undef MLA_VLOAD
    if (kt + 1 < NT) MLA_SSTORE(kt + 1, buf ^ 1);
    __syncthreads();
    buf ^= 1;
  }
#undef MLA_GLOAD
#undef MLA_SSTORE
  if (threadIdx.x == 0) nxt = (int)atomicAdd(ctr, 1u);
  const float inv = 1.f / (l + __shfl_xor(l, 32));
  f16v Y[2];
#pragma unroll
  for (int vt = 0; vt < 2; ++vt)
#pragma unroll
    for (int i = 0; i < 16; ++i) Y[vt][i] = 0.f;
#pragma unroll
  for (int dt = 0; dt < 4; ++dt) {
#pragma unroll
    for (int s = 0; s < 2; ++s) {
      h8 ob;
#pragma unroll
      for (int j = 0; j < 8; ++j) ob[j] = (h16)(O[dt][8 * s + j] * inv);
#pragma unroll
      for (int vt = 0; vt < 2; ++vt) {
        const h8 a = *(const h8*)(p.Wuv + ((size_t)((((w * 2 + vt) * 4 + dt) * 2 + s) * 64 + lane)) * 8);
        Y[vt] = MFMA32(a, ob, Y[vt]);
      }
    }
  }
  h16* Yt = (h16*)smem + w * (32 * 72);
#pragma unroll
  for (int vt = 0; vt < 2; ++vt) {
#pragma unroll
    for (int g4 = 0; g4 < 4; ++g4) {
      h4 o;
#pragma unroll
      for (int j = 0; j < 4; ++j) o[j] = (h16)Y[vt][4 * g4 + j];
      *(h4*)(Yt + r * 72 + 32 * vt + 8 * g4 + 4 * hh) = o;
    }
  }
  wavebar();
#pragma unroll
  for (int i = 0; i < 4; ++i) {
    const int q = lane + 64 * i;
    const int row = q >> 3, ch = q & 7;
    const h8 y = *(const h8*)(Yt + row * 72 + ch * 8);
    const h8 ga = *(const h8*)(p.GA + (size_t)(tok0 + row) * 512 + w * 64 + ch * 8);
    h8 o;
#pragma unroll
    for (int j = 0; j < 8; ++j) o[j] = (h16)((float)y[j] * (float)ga[j]);
    *(h8*)(p.mix + (size_t)(tok0 + row) * 1024 + w * 64 + ch * 8) = o;
  }
  __syncthreads();
}

#define SEL_CAP 256
DI int sel_bin(float v, float lo, float scale, bool degen) {
  if (degen) return v > lo ? 1023 : 0;
  int b = (int)((v - lo) * scale);
  return b > 1023 ? 1023 : b;
}
template <int NR, int NH>
DI void wave_select(const float* sc, int N, unsigned* maskrow, unsigned* hist, float* candv, int* candi, int lane,
                 float (&vpre)[NR], const float* scnext) {
  const int nwords = N >> 5;
  if (lane == 0) maskrow[nwords] = 0u;
  if (N <= 256) {
    for (int wd = lane; wd < nwords; wd += 64) maskrow[wd] = 0xffffffffu;
    return;
  }
  float v[NR];
#define SEL_LOAD(hf)                                                     \
  {                                                                      \
    _Pragma("unroll") for (int i = 0; i < NR; ++i) {                     \
      const int e = 64 * ((hf) * NR + i) + lane;                         \
      v[i] = (e < N) ? sc[e] : -INFINITY;                                \
    }                                                                    \
  }
  if (NH == 1) {
#pragma unroll
    for (int i = 0; i < NR; ++i) v[i] = vpre[i];
    if (scnext) {
#pragma unroll
      for (int i = 0; i < NR; ++i) {
        const int e = 64 * i + lane;
        vpre[i] = (e < N) ? scnext[e] : -INFINITY;
      }
    }
  }
  float lo = INFINITY, hi = -INFINITY;
#pragma unroll 1
  for (int hf = 0; hf < NH; ++hf) {
    if (NH > 1) SEL_LOAD(hf);
#pragma unroll
    for (int i = 0; i < NR; ++i) {
      hi = fmaxf(hi, v[i]);
      lo = fminf(lo, (v[i] == -INFINITY) ? INFINITY : v[i]);
    }
  }
  lo = wave_min(lo); hi = wave_max(hi);
  int need = 256;
  int T = 0, above = 0;
  float scale = 0.f;
  bool degen = false;
  bool rankmode = false;
  bool first = true;
  for (int iter = 0; iter < 64; ++iter) {
    if (!(lo < hi)) break;
    scale = 1024.f / (hi - lo);
    degen = !(scale < 1.0e37f);
    for (int i = lane; i < 1024; i += 64) hist[i] = 0u;
    wavebar();
    if (first && !degen) {
#pragma unroll 1
      for (int hf = 0; hf < NH; ++hf) {
        if (NH > 1) SEL_LOAD(hf);
#pragma unroll
        for (int i = 0; i < NR; ++i) {
          const int eb = 64 * (hf * NR + i);
          if (eb < N) {
            int bn = (int)((v[i] - lo) * scale);
            bn = bn > 1023 ? 1023 : bn;
            if (eb + 64 <= N) atomicAdd(&hist[bn], 1u);
            else if (eb + lane < N) atomicAdd(&hist[bn], 1u);
          }
        }
      }
    } else {
#pragma unroll 1
      for (int hf = 0; hf < NH; ++hf) {
        if (NH > 1) SEL_LOAD(hf);
#pragma unroll
        for (int i = 0; i < NR; ++i) {
          if (v[i] >= lo && v[i] <= hi) atomicAdd(&hist[sel_bin(v[i], lo, scale, degen)], 1u);
          if ((i & 7) == 7) __builtin_amdgcn_sched_barrier(0);
        }
      }
    }
    wavebar();
    unsigned ssum = 0;
#pragma unroll
    for (int i = 0; i < 16; ++i) ssum += hist[16 * lane + i];
    unsigned x = ssum;
#pragma unroll
    for (int off = 1; off < 64; off <<= 1) {
      const unsigned y = __shfl_down(x, off);
      if (lane + off < 64) x += y;
    }
    const unsigned sufx = x - ssum;
    const bool cross = (sufx < (unsigned)need) && (x >= (unsigned)need);
    int myT = 0, myAbove = 0, myC = 0;
    if (cross) {
      unsigned run = sufx;
      for (int i = 15; i >= 0; --i) {
        const unsigned c = hist[16 * lane + i];
        if (run + c >= (unsigned)need) { myT = 16 * lane + i; myAbove = (int)run; myC = (int)c; break; }
        run += c;
      }
    }
    const unsigned long long bal = __ballot(cross);
    const int src = bal ? (int)__builtin_ctzll(bal) : 0;
    T = __shfl(myT, src); above = __shfl(myAbove, src);
    const int cT = __shfl(myC, src);
    if (cT <= SEL_CAP) { rankmode = true; break; }
    first = false;
    need -= above;
    float nlo = INFINITY, nhi = -INFINITY;
#pragma unroll 1
    for (int hf = 0; hf < NH; ++hf) {
      if (NH > 1) SEL_LOAD(hf);
#pragma unroll
      for (int i = 0; i < NR; ++i) {
        if (v[i] >= lo && v[i] <= hi && sel_bin(v[i], lo, scale, degen) == T) { nlo = fminf(nlo, v[i]); nhi = fmaxf(nhi, v[i]); }
      }
    }
    lo = wave_min(nlo); hi = wave_max(nhi);
  }
  const int pick = rankmode ? need - above : need;
  int running = 0;
  const unsigned long long ltmask = (lane == 0) ? 0ull : (~0ull >> (64 - lane));
  const bool fastfinal = rankmode && first && !degen;
#pragma unroll 1
  for (int hf = 0; hf < NH; ++hf) {
    if (NH > 1) SEL_LOAD(hf);
    int mlo = 0, mhi = 0;
#pragma unroll
    for (int i = 0; i < NR; ++i) {
      const int eb = 64 * (hf * NR + i);
      if (eb < N) {
        const float vv = v[i];
        unsigned long long bs, bc;
        if (fastfinal) {
          int bn = (int)((vv - lo) * scale);
          bn = bn > 1023 ? 1023 : bn;
          bs = __ballot(bn > T);
          bc = __ballot(bn == T);
        } else {
          bool s = vv > hi;
          bool c;
          if (rankmode) {
            const bool inr = (vv >= lo && vv <= hi);
            const int bn = inr ? sel_bin(vv, lo, scale, degen) : -1;
            s = s || (bn > T);
            c = (bn == T);
          } else {
            c = (vv == hi);
          }
          bc = __ballot(c);
          if (!rankmode) {
            const int pos = running + __popcll(bc & ltmask);
            s = s || (c && pos < pick);
          }
          bs = __ballot(s);
        }
        if (bc != 0ull) {
          if (rankmode) {
            const bool c = (bc >> lane) & 1ull;
            const int pos = running + __popcll(bc & ltmask);
            if (c) { candv[pos] = vv; candi[pos] = eb + lane; }
          }
          running += __popcll(bc);
        }
        if (lane == i) { mlo = (int)(unsigned)bs; mhi = (int)(unsigned)(bs >> 32); }
      }
      if ((i & 7) == 7) __builtin_amdgcn_sched_barrier(0);
    }
    {
      const int wd = 2 * (hf * NR + lane);
      if (lane < NR && wd < nwords) {
        maskrow[wd] = (unsigned)mlo;
        if (wd + 1 < nwords) maskrow[wd + 1] = (unsigned)mhi;
      }
    }
  }
#undef SEL_LOAD
  if (rankmode) {
    wavebar();
    const int ncand = running;
    for (int i = lane; i < ncand; i += 64) {
      const float vi = candv[i];
      const int ii = candi[i];
      int rank = 0;
      for (int j = 0; j < ncand; ++j) {
        const float vj = candv[j];
        const int ij = candi[j];
        rank += ((vj > vi) || (vj == vi && ij < ii)) ? 1 : 0;
      }
      if (rank < pick) atomicOr(&maskrow[ii >> 5], 1u << (ii & 31));
    }
  }
  wavebar();
}

template <bool SAMPLE>
DI void dsa_item(const P& p, int b, int tok0, int qpos0, int nkeys, float* sc, int scs,
                         char* smem, const int tid, unsigned* ctr, int& nxt) {
  const int lane = tid & 63, w = tid >> 6;
  const int r = lane & 31, hh = lane >> 5;
  const int NT = (nkeys + 63) >> 6;
  unsigned* sMask = (unsigned*)(smem + 73728);
  float* sBias = (float*)(smem + 73728 + 32 * MASK_W * 4);
  if (tid < 256) sBias[tid] = p.rel_bias[tid] * LOG2E;
  float* sBT = sBias + 256;
  for (int e = tid; e < 249 * 8; e += NBLK_THREADS) {
    const int rel = (e >> 3) - 185;
    const int n = rel < 0 ? -rel : rel;
    int bk = n;
    if (n >= 8) bk = 8 + (n >= 12) + (n >= 16) + (n >= 23) + (n >= 32) + (n >= 46) + (n >= 64) + (n >= 91);
    if (rel > 0) bk += 16;
    sBT[e] = p.rel_bias[bk * 8 + (e & 7)] * LOG2E;
  }
  {
    constexpr int LS = 72;
    h16* sKI = (h16*)smem;
    const int NTA = (nkeys + 127) >> 7;
    h8 ai[4];
    {
      const int aq = ((r >> 2) & 1) * 2 + (r >> 4), ah = (r & 3) + 4 * ((r >> 3) & 1);
      const h16* qp = p.QI + ((size_t)(tok0 + 4 * w + aq) * 8 + ah) * 64 + 8 * hh;
#pragma unroll
      for (int t = 0; t < 4; ++t) ai[t] = *(const h8*)(qp + 16 * t);
    }
    float w16[16];
#pragma unroll
    for (int i = 0; i < 16; ++i)
      w16[i] = p.WI[(size_t)(tok0 + 4 * w + 2 * hh + (i >> 3)) * 8 + (i & 3) + 4 * ((i >> 2) & 1)];
    h8 sh[2];
    float4 sf[2][2];
#define KI_GLOAD(kt)                                                                                  \
  {                                                                                                   \
    _Pragma("unroll") for (int i = 0; i < 2; ++i) {                                                   \
      const int q = tid + NBLK_THREADS * i;                                                           \
      const int s = (kt) * 128 + (q >> 3), lcc = q & 7;                                               \
      if (!SAMPLE) {                                                                                  \
        sh[i] = (s < nkeys) ? *(const h8*)(p.KI + (size_t)(b * 2048 + s) * 64 + lcc * 8) : zero8();   \
      } else if (s < PAST) {                                                                          \
        const float* src = p.c_kidx + ((size_t)(b * PAST + s) * 64 + lcc * 8);                        \
        sf[i][0] = *(const float4*)src; sf[i][1] = *(const float4*)(src + 4);                         \
      } else if (s < SKEYS) {                                                                         \
        sf[i][0] = __builtin_bit_cast(float4, *(const h8*)(p.KI + (size_t)(NP + b * 32 + (s - PAST)) * 64 + lcc * 8)); \
      } else {                                                                                        \
        sf[i][0] = make_float4(0.f, 0.f, 0.f, 0.f);                                                   \
      }                                                                                               \
    }                                                                                                 \
  }
#define KI_SSTORE(kt, buf)                                                                            \
  {                                                                                                   \
    _Pragma("unroll") for (int i = 0; i < 2; ++i) {                                                   \
      const int q = tid + NBLK_THREADS * i;                                                           \
      const int s = (kt) * 128 + (q >> 3), lcc = q & 7;                                               \
      h8 v;                                                                                           \
      if (SAMPLE) v = (s < PAST) ? cvt8(sf[i][0], sf[i][1]) : __builtin_bit_cast(h8, sf[i][0]);       \
      else v = sh[i];                                                                                 \
      *(h8*)(sKI + ((buf) * 128 + (q >> 3)) * LS + lcc * 8) = v;                                      \
    }                                                                                                 \
  }
    KI_GLOAD(0);
#pragma unroll
    for (int t = 0; t < 4; ++t) pin8(ai[t]);
#pragma unroll
    for (int i = 0; i < 16; ++i) pinf(w16[i]);
    KI_SSTORE(0, 0);
    __syncthreads();
    int buf = 0;
    for (int kt = 0; kt < NTA; ++kt) {
      if (kt + 1 < NTA) KI_GLOAD(kt + 1);
      const h16* kbase = sKI + buf * 128 * LS + r * LS + 8 * hh;
#pragma unroll
      for (int sub = 0; sub < 4; ++sub) {
        const int key0 = kt * 128 + 32 * sub;
        if (key0 < nkeys) {
          f16v D;
#pragma unroll
          for (int i = 0; i < 16; ++i) D[i] = 0.f;
#pragma unroll
          for (int t = 0; t < 4; ++t) {
            const h8 bf = *(const h8*)(kbase + 32 * sub * LS + 16 * t);
            D = MFMA32(ai[t], bf, D);
          }
          mfma_settle();
          float ps0 = 0.f, ps1 = 0.f;
#pragma unroll
          for (int i = 0; i < 8; ++i) {
            ps0 = fmaf(relu1(D[i]), w16[i], ps0);
            ps1 = fmaf(relu1(D[8 + i]), w16[8 + i], ps1);
          }
          float* so = sc + (size_t)(4 * w + 2 * hh) * scs + key0 + r;
          so[0] = ps0;
          so[scs] = ps1;
        }
      }
      if (kt + 1 < NTA) KI_SSTORE(kt + 1, buf ^ 1);
      __syncthreads();
      buf ^= 1;
    }
#undef KI_GLOAD
#undef KI_SSTORE
  }
    constexpr int LS = 136;
    h16* sKb = (h16*)smem;
    h16* sVb = sKb + 2 * 64 * LS;
    const int kv = w >> 2, ql = 8 * (w & 3) + (r >> 2), g = r & 3, head = 4 * kv + g;
    const int i16 = lane & 15, q4 = i16 >> 2, p4 = i16 & 3, blk = (lane >> 4) & 1;
    const int tq = tok0 + ql;
    const int pq = qpos0 + ql;
    h8 qf[4];
#define DSA_QLOAD                                                                  \
    {                                                                              \
      const h16* qp = p.QB + (size_t)tq * 512 + head * 64 + 8 * hh;                \
      _Pragma("unroll") for (int t = 0; t < 4; ++t) qf[t] = *(const h8*)(qp + 16 * t); \
    }
    if (!SAMPLE) DSA_QLOAD;
    h8 sh[4];
    float4 sf[4][2];
#define KV_GLOAD(kt)                                                                                   \
  {                                                                                                    \
    _Pragma("unroll") for (int i = 0; i < 4; ++i) {                                                    \
      const int q = tid + NBLK_THREADS * i;                                                            \
      const int row = q >> 5, cc = q & 31, c16 = cc & 15;                                              \
      const int s = (kt) * 64 + row;                                                                   \
      if (!SAMPLE) {                                                                                   \
        sh[i] = *(const h8*)(((cc < 16) ? p.KB : p.VB) + (size_t)(b * 2048 + s) * 128 + c16 * 8);      \
      } else if (s < PAST) {                                                                           \
        const float* src = ((cc < 16) ? p.c_k : p.c_v) + ((size_t)(b * PAST + s) * 128 + c16 * 8);     \
        sf[i][0] = *(const float4*)src; sf[i][1] = *(const float4*)(src + 4);                          \
      } else if (s < SKEYS) {                                                                          \
        sf[i][0] = __builtin_bit_cast(float4, *(const h8*)(((cc < 16) ? p.KB : p.VB) + (size_t)(NP + b * 32 + (s - PAST)) * 128 + c16 * 8)); \
      } else {                                                                                         \
        sf[i][0] = make_float4(0.f, 0.f, 0.f, 0.f);                                                    \
      }                                                                                                \
    }                                                                                                  \
  }
#define KV_SSTORE(kt, buf)                                                                             \
  {                                                                                                    \
    _Pragma("unroll") for (int i = 0; i < 4; ++i) {                                                    \
      const int q = tid + NBLK_THREADS * i;                                                            \
      const int row = q >> 5, cc = q & 31, c16 = cc & 15;                                              \
      const int s = (kt) * 64 + row;                                                                   \
      h8 v;                                                                                            \
      if (SAMPLE) v = (s < PAST) ? cvt8(sf[i][0], sf[i][1]) : __builtin_bit_cast(h8, sf[i][0]);        \
      else v = sh[i];                                                                                  \
      *(h8*)(((cc < 16) ? sKb : sVb) + ((buf) * 64 + row) * LS + c16 * 8) = v;                         \
    }                                                                                                  \
  }
    if (!SAMPLE) KV_GLOAD(0);
  __syncthreads();
  {
    unsigned* hist = (unsigned*)(smem + w * 8192);
    float* candv = (float*)(smem + w * 8192 + 4096);
    int* candi = (int*)(smem + w * 8192 + 4096 + 1024);
    constexpr int SNR = SAMPLE ? 33 : 32;
    float vpre[SNR];
    if (!SAMPLE && nkeys > 256) {
#pragma unroll
      for (int i = 0; i < SNR; ++i) {
        const int e = 64 * i + lane;
        vpre[i] = (e < nkeys) ? sc[(size_t)(4 * w) * scs + e] : -INFINITY;
      }
    } else {
#pragma unroll
      for (int i = 0; i < SNR; ++i) vpre[i] = 0.f;
    }
#pragma unroll 1
    for (int qw = 0; qw < 4; ++qw) {
      const int ql = 4 * w + qw;
      wave_select<SNR, SAMPLE ? 2 : 1>(sc + (size_t)ql * scs, nkeys, sMask + ql * MASK_W, hist, candv, candi, lane, vpre,
                                      (qw < 3) ? sc + (size_t)(ql + 1) * scs : (const float*)nullptr);
    }
  }
  __syncthreads();
  {
    const float bias_far = sBias[15 * 8 + head];
    f16v O[2];
#pragma unroll
    for (int dt = 0; dt < 2; ++dt)
#pragma unroll
      for (int i = 0; i < 16; ++i) O[dt][i] = 0.f;
    float m = -1.0e29f, l = 0.f;
    if (SAMPLE) { DSA_QLOAD; KV_GLOAD(0); }
#undef DSA_QLOAD
#pragma unroll
    for (int t = 0; t < 4; ++t) pin8(qf[t]);
    KV_SSTORE(0, 0);
    __syncthreads();
    int buf = 0;
    for (int kt = 0; kt < NT; ++kt) {
      if (kt + 1 < NT) KV_GLOAD(kt + 1);
      const h16* ka_ptr = sKb + buf * 64 * LS + 64 * kv + r * LS + 8 * hh;
      const h16* vb_ptr = sVb + buf * 64 * LS + 64 * kv + (4 * hh + q4) * LS + 16 * blk + 4 * p4;
      const bool nearb = (qpos0 - (kt * 64 + 63)) < 91;
      const unsigned mw0 = sMask[ql * MASK_W + kt * 2] >> (4 * hh);
      const unsigned mw1 = sMask[ql * MASK_W + kt * 2 + 1] >> (4 * hh);
      f16v S0, S1;
      const int nb = __float_as_int(NEGBIG);
      const int im0 = (int)~mw0, im1 = (int)~mw1;
      const float boff = nearb ? 0.f : bias_far;
      MASKINIT16(S0, im0, nb);
      MASKINIT16(S1, im1, nb);
      asm volatile("s_nop 1");
      if (nearb) {
        const float* bt = sBT + (kt * 64 + 4 * hh - pq + 185) * 8 + head;
#pragma unroll
        for (int i = 0; i < 16; ++i) {
          S0[i] += bt[((i & 3) + 8 * (i >> 2)) * 8];
          S1[i] += bt[(32 + (i & 3) + 8 * (i >> 2)) * 8];
        }
      }
      {
        h8 ka0[2], ka1[2];
#pragma unroll
        for (int t = 0; t < 2; ++t) {
          ka0[t] = *(const h8*)(ka_ptr + 16 * t);
          ka1[t] = *(const h8*)(ka_ptr + 32 * LS + 16 * t);
        }
#pragma unroll
        for (int t = 0; t < 4; ++t) {
          S0 = MFMA32(ka0[t & 1], qf[t], S0);
          S1 = MFMA32(ka1[t & 1], qf[t], S1);
          if (t + 2 < 4) {
            ka0[t & 1] = *(const h8*)(ka_ptr + 16 * (t + 2));
            ka1[t & 1] = *(const h8*)(ka_ptr + 32 * LS + 16 * (t + 2));
          }
        }
      }
      h8 vf[4];
#define DSA_VLOAD(f)                                                                              \
  {                                                                                               \
    const h16* vp = vb_ptr + ((((f) >> 2) * 32) + ((((f) >> 1) & 1) * 16)) * LS + 32 * ((f) & 1); \
    vf[(f) & 3] = cat8(trread(vp), trread(vp + 8 * LS));                                          \
  }
#pragma unroll
      for (int f = 0; f < 4; ++f) DSA_VLOAD(f);
      mfma_settle();
      float mx = max3f(S0[0], S0[1], S1[0]);
      mx = max3f(mx, S1[1], S0[2]);
#pragma unroll
      for (int i = 2; i < 15; ++i) mx = max3f(mx, S1[i], S0[i + 1]);
      mx = fmaxf(mx, S1[15]);
      mx = fmaxf(mx, __shfl_xor(mx, 32)) + boff;
      if (__any(mx > m)) {
        const float mn = fmaxf(m, mx);
        const float alpha = fast_exp2(m - mn);
        m = mn;
        l *= alpha;
#pragma unroll
        for (int dt = 0; dt < 2; ++dt)
#pragma unroll
          for (int i = 0; i < 16; ++i) O[dt][i] *= alpha;
      }
      {
        const float msub = m - boff;
        const f2v m2 = {msub, msub};
        f2v rs2 = {0.f, 0.f};
#pragma unroll
        for (int i = 0; i < 16; i += 2) {
          f2v a = {S0[i], S0[i + 1]};
          f2v c = {S1[i], S1[i + 1]};
          a -= m2; c -= m2;
          a[0] = fast_exp2(a[0]); a[1] = fast_exp2(a[1]);
          c[0] = fast_exp2(c[0]); c[1] = fast_exp2(c[1]);
          rs2 += a; rs2 += c;
          S0[i] = a[0]; S0[i + 1] = a[1]; S1[i] = c[0]; S1[i + 1] = c[1];
        }
        l += rs2[0] + rs2[1];
      }
      h8 pb[4];
#pragma unroll
      for (int gg = 0; gg < 4; ++gg)
#pragma unroll
        for (int jj = 0; jj < 8; ++jj) pb[gg][jj] = (h16)((gg < 2) ? S0[8 * (gg & 1) + jj] : S1[8 * (gg & 1) + jj]);
#pragma unroll
      for (int f = 0; f < 8; ++f) {
        O[f & 1] = MFMA32(vf[f & 3], pb[f >> 1], O[f & 1]);
        if (f + 4 < 8) DSA_VLOAD(f + 4);
      }
#undef DSA_VLOAD
      if (kt + 1 < NT) KV_SSTORE(kt + 1, buf ^ 1);
      __syncthreads();
      buf ^= 1;
    }
#undef KV_GLOAD
#undef KV_SSTORE
    if (threadIdx.x == 0) nxt = (int)atomicAdd(ctr, 1u);
    const float inv = 1.f / (l + __shfl_xor(l, 32));
    h16* Ot = (h16*)smem + w * (8 * 264);
    {
      const int q8 = r >> 2;
#pragma unroll
      for (int dt = 0; dt < 2; ++dt) {
#pragma unroll
        for (int g4 = 0; g4 < 4; ++g4) {
          h4 o;
#pragma unroll
          for (int j = 0; j < 4; ++j) o[j] = (h16)(O[dt][4 * g4 + j] * inv);
          *(h4*)(Ot + q8 * 264 + g * 64 + 32 * dt + 8 * g4 + 4 * hh) = o;
        }
      }
    }
    wavebar();
#pragma unroll
    for (int i = 0; i < 4; ++i) {
      const int q = lane + 64 * i;
      const int row = q >> 5, ch = q & 31;
      const int tk = tok0 + 8 * (w & 3) + row;
      const h8 y = *(const h8*)(Ot + row * 264 + ch * 8);
      const h8 gb = *(const h8*)(p.GB + (size_t)tk * 512 + kv * 256 + ch * 8);
      h8 o;
#pragma unroll
      for (int j = 0; j < 8; ++j) o[j] = (h16)((float)y[j] * (float)gb[j]);
      *(h8*)(p.mix + (size_t)tk * 1024 + 512 + kv * 256 + ch * 8) = o;
    }
  }
  __syncthreads();
}

#define ITEMS_PER_Q 136
DI void phase2(const P& p, char* smem, int cidx = 0) {
  volatile int& s_item = *(volatile int*)(smem + SMEM_BYTES - 16);
  const int xq = blockIdx.x & 7;
  unsigned* ctr = &p.counters[cidx * 8 + xq];
  if (threadIdx.x == 0) s_item = (int)atomicAdd(ctr, 1u);
  __syncthreads();
  int item = s_item;
  while (item < ITEMS_PER_Q) {
    int nxt = 0;
    const int tid = opaque_tid();
    if (item < 4) {
      const int b = xq + 8 * item;
      mla_item<true>(p, b, NP + b * 32, SKEYS, smem, tid, ctr, nxt);
    } else if (item < 8) {
      const int b = xq + 8 * (item - 4);
      dsa_item<true>(p, b, NP + b * 32, PAST, SKEYS, p.scS + (size_t)b * 32 * SC_STRIDE_S, SC_STRIDE_S, smem, tid, ctr, nxt);
    } else {
      const int k = item - 8;
      const int kind = k & 1, sub = (k >> 1) & 1, b = xq, c = 31 - (k >> 2);
      const int tok0 = b * 2048 + c * 64 + sub * 32;
      const int nkeys = 64 * (c + 1);
      if (kind == 0) mla_item<false>(p, b, tok0, nkeys, smem, tid, ctr, nxt);
      else dsa_item<false>(p, b, tok0, c * 64 + sub * 32, nkeys, p.scP + (size_t)blockIdx.x * 32 * SC_STRIDE_P,
                           SC_STRIDE_P, smem, tid, ctr, nxt);
    }
    if (threadIdx.x == 0) s_item = nxt;
    __syncthreads();
    item = s_item;
    __syncthreads();
  }
}

template <int BM>
DI void p3_epilogue(const P& p, const h16* T, int m0, int n0) {
  constexpr int TS = 136;
  const int tid = opaque_tid();
  constexpr int NIT = BM / 32;
  float4 x0[NIT], x1[NIT];
#pragma unroll
  for (int it = 0; it < NIT; ++it) {
    const int q = tid + NBLK_THREADS * it;
    const int m = m0 + (q >> 4), n = n0 + (q & 15) * 8;
    const float* xr = (m < NP ? p.x_p + (size_t)m * DM : p.x_s + (size_t)(m - NP) * DM) + n;
    x0[it] = *(const float4*)xr; x1[it] = *(const float4*)(xr + 4);
  }
#pragma unroll
  for (int it = 0; it < NIT; ++it) {
    const int q = tid + NBLK_THREADS * it;
    const int row = q >> 4, ch = q & 15;
    const int m = m0 + row, n = n0 + ch * 8;
    const h8 v = *(const h8*)(T + row * TS + ch * 8);
    h8 o;
    o[0] = (h16)(x0[it].x + (float)v[0]); o[1] = (h16)(x0[it].y + (float)v[1]);
    o[2] = (h16)(x0[it].z + (float)v[2]); o[3] = (h16)(x0[it].w + (float)v[3]);
    o[4] = (h16)(x1[it].x + (float)v[4]); o[5] = (h16)(x1[it].y + (float)v[5]);
    o[6] = (h16)(x1[it].z + (float)v[6]); o[7] = (h16)(x1[it].w + (float)v[7]);
    *(h8*)(p.XN + (size_t)m * DM + n) = o;
  }
}
DI void phase3(const P& p, char* smem) {
  constexpr int TS = 136;
  h16* T = (h16*)smem;
  for (int tile = blockIdx.x; tile < 256; tile += gridDim.x) {
    const int xcd = tile & 7, idx = tile >> 3;
    const int mt = xcd * 8 + (idx >> 2), pn = idx & 3;
    const int m0 = mt * 256;
    f32x4 acc[2][2][4][2];
    gemm8_mainloop(p.mix, p.Wt_out, DM, m0, pn * 256, smem, acc);
    __syncthreads();
    const int tid = opaque_tid();
    const int wid = tid >> 6, lane = tid & 63, wr = wid >> 2, wc = wid & 3, fr = lane & 15, fq = lane >> 4;
#pragma unroll
    for (int bj = 0; bj < 2; ++bj) {
#pragma unroll
      for (int ai = 0; ai < 2; ++ai)
#pragma unroll
        for (int m = 0; m < 4; ++m)
#pragma unroll
          for (int n = 0; n < 2; ++n)
          {
            h4 o;
#pragma unroll
            for (int jj = 0; jj < 4; ++jj) o[jj] = (h16)acc[ai][bj][m][n][jj];
            *(h4*)(T + (ai * 128 + wr * 64 + m * 16 + fr) * TS + wc * 32 + n * 16 + fq * 4) = o;
          }
      __syncthreads();
      p3_epilogue<256>(p, T, m0, pn * 256 + bj * 128);
      __syncthreads();
    }
  }
  for (int tile = blockIdx.x; tile < 128; tile += gridDim.x) {
    const int m0 = NP + (tile >> 3) * 64, n0 = (tile & 7) * 128;
    gemm_tile<64, 128, 2, 4>(p.mix, 1024, p.Wt_out, 1024, 1024, m0, n0, smem);
    p3_epilogue<64>(p, T, m0, n0);
    __syncthreads();
  }
}

DI void phase4(const P& p) {
  const int tid = opaque_tid(), lane = tid & 63, w = tid >> 6;
  const int gw = blockIdx.x * 8 + w, nw = gridDim.x * 8;
  for (int k0 = 0; gw + nw * k0 < NTOK; k0 += 5) {
    h4 v[5][4];
    float ss[5];
#pragma unroll
    for (int rr = 0; rr < 5; ++rr) {
      const int row = gw + nw * (k0 + rr);
#pragma unroll
      for (int k = 0; k < 4; ++k) {
        if (row < NTOK) v[rr][k] = *(const h4*)(p.XN + (size_t)row * DM + 4 * lane + 256 * k);
        else { v[rr][k][0] = (h16)0.f; v[rr][k][1] = (h16)0.f; v[rr][k][2] = (h16)0.f; v[rr][k][3] = (h16)0.f; }
      }
    }
#pragma unroll
    for (int rr = 0; rr < 5; ++rr) {
      float a = 0.f;
#pragma unroll
      for (int k = 0; k < 4; ++k)
#pragma unroll
        for (int e = 0; e < 4; ++e) a += (float)v[rr][k][e] * (float)v[rr][k][e];
      ss[rr] = a;
    }
#pragma unroll
    for (int off = 32; off > 0; off >>= 1) {
#pragma unroll
      for (int rr = 0; rr < 5; ++rr) ss[rr] += __shfl_xor(ss[rr], off);
    }
    float4 g[4];
#pragma unroll
    for (int k = 0; k < 4; ++k) g[k] = *(const float4*)(p.fn_g + 4 * lane + 256 * k);
#pragma unroll
    for (int rr = 0; rr < 5; ++rr) {
      const int row = gw + nw * (k0 + rr);
      if (row < NTOK) {
        const float rstd = rsqrtf(ss[rr] * (1.f / 1024.f) + 1e-6f);
        float* o = p.out + (size_t)row * DM;
#pragma unroll
        for (int k = 0; k < 4; ++k)
          *(float4*)(o + 4 * lane + 256 * k) = make_float4((float)v[rr][k][0] * rstd * g[k].x, (float)v[rr][k][1] * rstd * g[k].y,
                                                           (float)v[rr][k][2] * rstd * g[k].z, (float)v[rr][k][3] * rstd * g[k].w);
      }
    }
  }
}

__global__ void __launch_bounds__(NBLK_THREADS) mega_kernel(P p) {
  __shared__ __attribute__((aligned(16))) char smem[SMEM_BYTES];
  XBar xb;
  xb.w = p.counters;
  xb.x = (unsigned)__builtin_amdgcn_s_getreg((3 << 11) | 20) & 0xFu;
  xb.nloc = 0u; xb.nx = 0u;
  if (threadIdx.x == 0) __hip_atomic_fetch_add(&xb.w[XB_CNT(xb.x)], 1u, __ATOMIC_RELAXED, __HIP_MEMORY_SCOPE_AGENT);
  phase0(p, smem);
  xcd_barrier(xb, 1u, smem);
  phase1(p, smem);
  xcd_barrier(xb, 2u, smem);
  phase1b(p, smem);
  xcd_barrier(xb, 3u, smem);
  phase2(p, smem);
  xcd_barrier(xb, 4u, smem);
  phase3(p, smem);
  xcd_barrier(xb, 5u, smem);
  phase4(p);
}

extern "C" void kernel_launch(void* const* d_in, const int* in_sizes, int n_in, void* d_out, int out_size, void* d_ws,
                              size_t ws_size, hipStream_t stream) {
  P p{};
  p.x_p = (const float*)d_in[0];
  p.x_s = (const float*)d_in[1];
  p.c_ckv = (const float*)d_in[2];
  p.c_kpe = (const float*)d_in[3];
  p.c_k = (const float*)d_in[4];
  p.c_v = (const float*)d_in[5];
  p.c_kidx = (const float*)d_in[6];
  p.norm_g = (const float*)d_in[7];
  p.w_in = (const float*)d_in[8];
  p.qn_g = (const float*)d_in[9];
  p.kvn_g = (const float*)d_in[10];
  p.w_uq = (const float*)d_in[11];
  p.w_uk = (const float*)d_in[12];
  p.w_uv = (const float*)d_in[13];
  p.rel_bias = (const float*)d_in[14];
  p.w_out = (const float*)d_in[15];
  p.fn_g = (const float*)d_in[16];
  p.out = (float*)d_out;

  char* ws = (char*)d_ws;
  size_t off = 0;
  auto carve = [&](size_t bytes) {
    char* r = ws + off;
    off += (bytes + 255) & ~(size_t)255;
    return r;
  };
  p.counters = (unsigned*)carve(XB_WORDS * 4);
  p.hX = (h16*)carve((size_t)NTOK * DM * 2);
  p.mix = p.hX;
  p.scP = (float*)carve((size_t)256 * 32 * SC_STRIDE_P * 4);
  p.CQ = (h16*)carve((size_t)NTOK * 256 * 2);
  p.Wt_in = (h16*)carve((size_t)INWP * DM * 2);
  p.Wt_out = (h16*)carve((size_t)DM * DM * 2);
  p.Wq = (h16*)carve((size_t)1280 * 256 * 2);
  p.Wuv = (h16*)carve((size_t)8 * 64 * 128 * 2);
  p.QM = (h16*)carve((size_t)NTOK * 1280 * 2);
  p.XN = (h16*)carve((size_t)NTOK * DM * 2);
  p.KM = (h16*)carve((size_t)NTOK * 160 * 2);
  p.GA = (h16*)carve((size_t)NTOK * 512 * 2);
  p.GB = (h16*)carve((size_t)NTOK * 512 * 2);
  p.QB = (h16*)carve((size_t)NTOK * 512 * 2);
  p.KB = (h16*)carve((size_t)NTOK * 128 * 2);
  p.VB = (h16*)carve((size_t)NTOK * 128 * 2);
  p.QI = (h16*)carve((size_t)NTOK * 512 * 2);
  p.KI = (h16*)carve((size_t)NTOK * 64 * 2);
  p.WI = (float*)carve((size_t)NTOK * 8 * 4);
  p.RQP = (float*)carve((size_t)NTOK * 2 * 4);
  p.ropeC = (float*)carve((size_t)2080 * 16 * 4);
  p.ropeS = (float*)carve((size_t)2080 * 16 * 4);
  p.scS = (float*)carve((size_t)32 * 32 * SC_STRIDE_S * 4);
  if (off > ws_size) {
    fprintf(stderr, "workspace too small: need %zu have %zu\n", off, ws_size);
    return;
  }
  static int grid_blocks = 0;
  if (!grid_blocks) {
    int dev = 0, cus = 0, per_cu = 0;
    hipGetDevice(&dev);
    hipDeviceGetAttribute(&cus, hipDeviceAttributeMultiprocessorCount, dev);
    hipOccupancyMaxActiveBlocksPerMultiprocessor(&per_cu, mega_kernel, NBLK_THREADS, 0);
    if (per_cu > 1) per_cu = 1;
    grid_blocks = cus * per_cu;
    if (grid_blocks > 256) grid_blocks = 256;
  }
  hipMemsetAsync(p.counters, 0, XB_WORDS * 4, stream);
  hipLaunchKernelGGL(mega_kernel, dim3(grid_blocks), dim3(NBLK_THREADS), 0, stream, p);
}
```

```cpp
#include <hip/hip_runtime.h>
#include <stdint.h>
#include <stdio.h>

typedef _Float16 h16;
typedef h16 h8 __attribute__((ext_vector_type(8)));
typedef h16 h4 __attribute__((ext_vector_type(4)));
typedef h16 h2 __attribute__((ext_vector_type(2)));
typedef float f16v __attribute__((ext_vector_type(16)));
typedef short s4v __attribute__((vector_size(8)));
typedef __attribute__((address_space(3))) s4v* lds_s4p;

#define DI __device__ __forceinline__
#define MFMA32(a, b, c) __builtin_amdgcn_mfma_f32_32x32x16_f16((a), (b), (c), 0, 0, 0)

#define NTOK 17408
#define NP 16384
#define DM 1024
#define INW 2792
#define INWP 2816
#define PAST 4096
#define SKEYS 4128
#define NBLK_THREADS 512

#define OFF_Y 0
#define OFF_P_CKV 17825792
#define OFF_P_KPE 19922944
#define OFF_P_K 20447232
#define OFF_P_V 22544384
#define OFF_P_KIDX 24641536
#define OFF_S_CKV 25690112
#define OFF_S_KPE 25821184
#define OFF_S_K 25853952
#define OFF_S_V 25985024
#define OFF_S_KIDX 26116096

#define ZC_CQ 0
#define ZC_CKV 256
#define ZC_KPE 384
#define ZC_GA 416
#define ZC_QB 928
#define ZC_KB 1440
#define ZC_VB 1568
#define ZC_QI 1696
#define ZC_KI 2208
#define ZC_WI 2272
#define ZC_GB 2280

#define LOG2E 1.4426950408889634f
#define QM_SCALE 0.14724444602590306f
#define QB_SCALE 0.18033688011112042f
#define WI_SCALE 0.04419417382415922f
#define NEGBIG (-1.0e30f)
#define RESC_T 8.0f

#define SMEM_BYTES 131072
#define SC_STRIDE_P 2048
#define SC_STRIDE_S 4160
#define MASK_W 132
#define N_ITEMS 1088

struct P {
  const float *x_p, *x_s, *c_ckv, *c_kpe, *c_k, *c_v, *c_kidx, *norm_g, *w_in, *qn_g, *kvn_g, *w_uq, *w_uk, *w_uv,
      *rel_bias, *w_out, *fn_g;
  float* out;
  h16 *hX, *CQ, *Wt_in, *Wt_out, *Wq, *Wuv, *QM, *KM, *GA, *GB, *QB, *KB, *VB, *QI, *KI, *mix, *XN;
  float *WI, *ropeC, *ropeS, *scP, *scS, *RQP;
  unsigned* counters;
};

DI int crow(int i, int hh) { return (i & 3) + 8 * (i >> 2) + 4 * hh; }
DI float wave_sum(float v) {
#pragma unroll
  for (int off = 32; off > 0; off >>= 1) v += __shfl_xor(v, off);
  return v;
}
DI float wave_max(float v) {
#pragma unroll
  for (int off = 32; off > 0; off >>= 1) v = fmaxf(v, __shfl_xor(v, off));
  return v;
}
DI float wave_min(float v) {
#pragma unroll
  for (int off = 32; off > 0; off >>= 1) v = fminf(v, __shfl_xor(v, off));
  return v;
}
DI h4 trread(const h16* p) {
  s4v r = __builtin_amdgcn_ds_read_tr16_b64_v4i16((lds_s4p)(p));
  return __builtin_bit_cast(h4, r);
}
DI h8 cat8(h4 a, h4 b) { return __builtin_shufflevector(a, b, 0, 1, 2, 3, 4, 5, 6, 7); }
DI h8 cvt8(float4 a, float4 b) {
  h8 r;
  r[0] = (h16)a.x; r[1] = (h16)a.y; r[2] = (h16)a.z; r[3] = (h16)a.w;
  r[4] = (h16)b.x; r[5] = (h16)b.y; r[6] = (h16)b.z; r[7] = (h16)b.w;
  return r;
}
DI h8 zero8() { h8 r; for (int i = 0; i < 8; ++i) r[i] = (h16)0.f; return r; }
DI float fast_exp2(float x) { return __builtin_amdgcn_exp2f(x); }
DI float silu(float x) { return x * __builtin_amdgcn_rcpf(1.f + __expf(-x)); }
DI int rope_idx(int t) { return t < NP ? (t & 2047) : 2048 + ((t - NP) & 31); }
DI int opaque_tid() { int t = threadIdx.x; asm volatile("" : "+v"(t)); return t; }
#define XB_CNT(x) (256 + 64 * (x))
#define XB_ARR(x) (256 + 64 * (16 + (x)))
#define XB_GEN(x) (256 + 64 * (32 + (x)))
#define XB_TOP (256 + 64 * 48)
#define XB_WORDS (256 + 64 * 49)
DI unsigned xb_ld(unsigned* q) { return __hip_atomic_load(q, __ATOMIC_RELAXED, __HIP_MEMORY_SCOPE_AGENT); }
struct XBar { unsigned* w; unsigned x, nloc, nx; };
DI void xcd_barrier(XBar& xb, unsigned k, char* smem) {
  asm volatile("s_waitcnt vmcnt(0)" ::: "memory");
  __syncthreads();
  volatile unsigned* bc = (volatile unsigned*)(smem + SMEM_BYTES - 64);
  if (threadIdx.x == 0) {
    if (k == 1u) {
      const unsigned G = gridDim.x;
      unsigned sum, nxx;
      do {
        sum = 0u; nxx = 0u;
        for (int j = 0; j < 16; ++j) { const unsigned c = xb_ld(&xb.w[XB_CNT(j)]); sum += c; nxx += (c != 0u); }
        if (sum != G) __builtin_amdgcn_s_sleep(2);
      } while (sum != G);
      bc[0] = xb_ld(&xb.w[XB_CNT(xb.x)]);
      bc[1] = nxx;
    }
  }
  if (k == 1u) {
    __syncthreads();
    xb.nloc = (unsigned)__builtin_amdgcn_readfirstlane((int)bc[0]);
    xb.nx = (unsigned)__builtin_amdgcn_readfirstlane((int)bc[1]);
  }
  if (threadIdx.x == 0) {
    const unsigned old = __hip_atomic_fetch_add(&xb.w[XB_ARR(xb.x)], 1u, __ATOMIC_RELAXED, __HIP_MEMORY_SCOPE_AGENT);
    if (old + 1u == k * xb.nloc) {
      __builtin_amdgcn_fence(__ATOMIC_RELEASE, "agent");
      asm volatile("s_waitcnt vmcnt(0)" ::: "memory");
      __hip_atomic_fetch_add(&xb.w[XB_TOP], 1u, __ATOMIC_RELAXED, __HIP_MEMORY_SCOPE_AGENT);
      while (xb_ld(&xb.w[XB_TOP]) < k * xb.nx) __builtin_amdgcn_s_sleep(1);
      __hip_atomic_store(&xb.w[XB_GEN(xb.x)], k, __ATOMIC_RELAXED, __HIP_MEMORY_SCOPE_AGENT);
    } else {
      while (xb_ld(&xb.w[XB_GEN(xb.x)]) < k) __builtin_amdgcn_s_sleep(1);
    }
    __builtin_amdgcn_fence(__ATOMIC_ACQUIRE, "agent");
    asm volatile("s_waitcnt vmcnt(0)" ::: "memory");
  }
  __syncthreads();
}
DI void grid_barrier(unsigned* bar, unsigned target) {
  asm volatile("s_waitcnt vmcnt(0)" ::: "memory");
  __syncthreads();
  if (threadIdx.x == 0) {
    __builtin_amdgcn_fence(__ATOMIC_RELEASE, "agent");
    asm volatile("s_waitcnt vmcnt(0)" ::: "memory");
    __hip_atomic_fetch_add(bar, 1u, __ATOMIC_RELAXED, __HIP_MEMORY_SCOPE_AGENT);
    while (__hip_atomic_load(bar, __ATOMIC_RELAXED, __HIP_MEMORY_SCOPE_AGENT) < target) __builtin_amdgcn_s_sleep(2);
    __builtin_amdgcn_fence(__ATOMIC_ACQUIRE, "agent");
    asm volatile("s_waitcnt vmcnt(0)" ::: "memory");
  }
  __syncthreads();
}
typedef float f2v __attribute__((ext_vector_type(2)));
DI float max3f(float a, float b, float c) {
  float d;
  asm("v_max3_f32 %0, %1, %2, %3" : "=v"(d) : "v"(a), "v"(b), "v"(c));
  return d;
}
DI float xhalf_max(float x) {
  const auto r = __builtin_amdgcn_permlane32_swap(__float_as_uint(x), __float_as_uint(x), false, false);
  float d;
  asm("v_max_f32 %0, %1, %2" : "=v"(d) : "v"(__uint_as_float(r[0])), "v"(__uint_as_float(r[1])));
  return d;
}
DI void mfma_settle() {
  __builtin_amdgcn_sched_barrier(0);
  asm volatile("s_nop 7\n\ts_nop 7");
  __builtin_amdgcn_sched_barrier(0);
}
DI float relu1(float x) { float d; asm("v_max_f32 %0, 0, %1" : "=v"(d) : "v"(x)); return d; }
#define MASKINIT(dst, im, BIT, nbv) asm volatile("v_bfe_i32 %0, %1, " #BIT ", 1\n\tv_and_b32 %0, %0, %2" : "=&v"(dst) : "v"(im), "v"(nbv))
#define MASKINIT16(S, im, nbv)                                                                                  \
  { float _t;                                                                                                   \
    MASKINIT(_t, im, 0, nbv); S[0] = _t; MASKINIT(_t, im, 1, nbv); S[1] = _t; MASKINIT(_t, im, 2, nbv); S[2] = _t;     \
    MASKINIT(_t, im, 3, nbv); S[3] = _t; MASKINIT(_t, im, 8, nbv); S[4] = _t; MASKINIT(_t, im, 9, nbv); S[5] = _t;     \
    MASKINIT(_t, im, 10, nbv); S[6] = _t; MASKINIT(_t, im, 11, nbv); S[7] = _t; MASKINIT(_t, im, 16, nbv); S[8] = _t;  \
    MASKINIT(_t, im, 17, nbv); S[9] = _t; MASKINIT(_t, im, 18, nbv); S[10] = _t; MASKINIT(_t, im, 19, nbv); S[11] = _t; \
    MASKINIT(_t, im, 24, nbv); S[12] = _t; MASKINIT(_t, im, 25, nbv); S[13] = _t; MASKINIT(_t, im, 26, nbv); S[14] = _t; \
    MASKINIT(_t, im, 27, nbv); S[15] = _t; }
DI void pin8(const h8& v) { asm volatile("" ::"v"(v)); }
DI void pinf(const float& v) { asm volatile("" ::"v"(v)); }
DI void wavebar() { asm volatile("s_waitcnt lgkmcnt(0)" ::: "memory"); }

__constant__ float c_inv_freq[16] = {1.000000000e+00f, 5.623413324e-01f, 3.162277639e-01f, 1.778279394e-01f,
                                     1.000000015e-01f, 5.623413250e-02f, 3.162277490e-02f, 1.778279431e-02f,
                                     9.999999776e-03f, 5.623413250e-03f, 3.162277630e-03f, 1.778279431e-03f,
                                     1.000000047e-03f, 5.623413017e-04f, 3.162277571e-04f, 1.778279402e-04f};

DI void sincos_acc(float angf, float* so, float* co) {
  const double a = (double)angf;
  const double q = rint(a * 0.6366197723675814);
  double t = fma(-q, 1.5707963267948966, a);
  t = fma(-q, 6.123233995736766e-17, t);
  const int qi = ((int)q) & 3;
  const double t2 = t * t;
  double sn = -1.0 / 1307674368000.0;
  sn = fma(sn, t2, 1.0 / 6227020800.0);
  sn = fma(sn, t2, -1.0 / 39916800.0);
  sn = fma(sn, t2, 1.0 / 362880.0);
  sn = fma(sn, t2, -1.0 / 5040.0);
  sn = fma(sn, t2, 1.0 / 120.0);
  sn = fma(sn, t2, -1.0 / 6.0);
  sn = fma(sn * t2, t, t);
  double cs = 1.0 / 20922789888000.0;
  cs = fma(cs, t2, -1.0 / 87178291200.0);
  cs = fma(cs, t2, 1.0 / 479001600.0);
  cs = fma(cs, t2, -1.0 / 3628800.0);
  cs = fma(cs, t2, 1.0 / 40320.0);
  cs = fma(cs, t2, -1.0 / 720.0);
  cs = fma(cs, t2, 1.0 / 24.0);
  cs = fma(cs, t2, -0.5);
  cs = fma(cs, t2, 1.0);
  double s, c;
  if (qi == 0) { s = sn; c = cs; }
  else if (qi == 1) { s = cs; c = -sn; }
  else if (qi == 2) { s = -sn; c = -cs; }
  else { s = -cs; c = sn; }
  *so = (float)s; *co = (float)c;
}

DI void transpose_to_h(const float* __restrict__ src, int K, int N, int Npad, h16* __restrict__ dst, char* smem) {
  float* tile = (float*)smem;
  const int tid = opaque_tid();
  const int ktn = K / 64, ntn = Npad / 64;
  for (int tix = blockIdx.x; tix < ktn * ntn; tix += gridDim.x) {
    const int k0 = (tix / ntn) * 64, n0 = (tix % ntn) * 64;
    {
      const int nn = tid & 63;
#pragma unroll
      for (int i = 0; i < 8; ++i) {
        const int kk = (tid >> 6) + 8 * i;
        const int n = n0 + nn;
        tile[kk * 65 + nn] = (n < N) ? src[(size_t)(k0 + kk) * N + n] : 0.f;
      }
    }
    __syncthreads();
    {
      const int kk = tid & 63;
#pragma unroll
      for (int i = 0; i < 8; ++i) {
        const int nn = (tid >> 6) + 8 * i;
        dst[(size_t)(n0 + nn) * K + k0 + kk] = (h16)tile[kk * 65 + nn];
      }
    }
    __syncthreads();
  }
}

DI void phase0(const P& p, char* smem) {
  const int tid = opaque_tid(), lane = tid & 63, w = tid >> 6;
  const int gw = blockIdx.x * 8 + w, nw = gridDim.x * 8;
  const int gt = blockIdx.x * NBLK_THREADS + tid, nt = gridDim.x * NBLK_THREADS;
  for (int k0 = 0; gw + nw * k0 < NTOK; k0 += 5) {
    float4 v[5][4];
    float ss[5];
#pragma unroll
    for (int rr = 0; rr < 5; ++rr) {
      const int row = gw + nw * (k0 + rr);
      if (row < NTOK) {
        const float* x = row < NP ? p.x_p + (size_t)row * DM : p.x_s + (size_t)(row - NP) * DM;
#pragma unroll
        for (int i = 0; i < 4; ++i) v[rr][i] = ((const float4*)x)[lane + 64 * i];
      } else {
#pragma unroll
        for (int i = 0; i < 4; ++i) v[rr][i] = make_float4(0.f, 0.f, 0.f, 0.f);
      }
    }
#pragma unroll
    for (int rr = 0; rr < 5; ++rr) {
      float a = 0.f;
#pragma unroll
      for (int i = 0; i < 4; ++i)
        a += v[rr][i].x * v[rr][i].x + v[rr][i].y * v[rr][i].y + v[rr][i].z * v[rr][i].z + v[rr][i].w * v[rr][i].w;
      ss[rr] = a;
    }
#pragma unroll
    for (int off = 32; off > 0; off >>= 1) {
#pragma unroll
      for (int rr = 0; rr < 5; ++rr) ss[rr] += __shfl_xor(ss[rr], off);
    }
    float4 g[4];
#pragma unroll
    for (int i = 0; i < 4; ++i) g[i] = ((const float4*)p.norm_g)[lane + 64 * i];
#pragma unroll
    for (int rr = 0; rr < 5; ++rr) {
      const int row = gw + nw * (k0 + rr);
      if (row < NTOK) {
        const float rstd = rsqrtf(ss[rr] * (1.f / 1024.f) + 1e-6f);
#pragma unroll
        for (int i = 0; i < 4; ++i) {
          h4 o;
          o[0] = (h16)(v[rr][i].x * rstd * g[i].x); o[1] = (h16)(v[rr][i].y * rstd * g[i].y);
          o[2] = (h16)(v[rr][i].z * rstd * g[i].z); o[3] = (h16)(v[rr][i].w * rstd * g[i].w);
          *(h4*)(p.hX + (size_t)row * DM + (lane + 64 * i) * 4) = o;
        }
      }
    }
  }
  transpose_to_h(p.w_in, 1024, INW, INWP, p.Wt_in, smem);
  transpose_to_h(p.w_out, 1024, 1024, 1024, p.Wt_out, smem);
  for (int wt = gw; wt < 256; wt += nw) {
    const int hd = wt >> 5, k0 = ((wt >> 2) & 7) * 32, c0 = (wt & 3) * 32;
    const int r = lane & 31, hh = lane >> 5;
    f16v D;
#pragma unroll
    for (int i = 0; i < 16; ++i) D[i] = 0.f;
#pragma unroll
    for (int t = 0; t < 4; ++t) {
      const float* ap = p.w_uq + (size_t)(k0 + r) * 768 + hd * 96 + 16 * t + 8 * hh;
      const float* bp = p.w_uk + (size_t)(c0 + r) * 512 + hd * 64 + 16 * t + 8 * hh;
      const h8 a = cvt8(*(const float4*)ap, *(const float4*)(ap + 4));
      const h8 bq = cvt8(*(const float4*)bp, *(const float4*)(bp + 4));
      D = MFMA32(a, bq, D);
    }
#pragma unroll
    for (int g4 = 0; g4 < 4; ++g4) {
      const int k = k0 + 8 * g4 + 4 * hh;
      const float4 g = *(const float4*)(p.qn_g + k);
      h4 o;
      o[0] = (h16)(D[4 * g4 + 0] * g.x); o[1] = (h16)(D[4 * g4 + 1] * g.y);
      o[2] = (h16)(D[4 * g4 + 2] * g.z); o[3] = (h16)(D[4 * g4 + 3] * g.w);
      *(h4*)(p.Wq + (size_t)(hd * 128 + c0 + r) * 256 + k) = o;
    }
  }
  for (int idx = gt; idx < 256 * 256; idx += nt) {
    const int n = 1024 + (idx >> 8), k = idx & 255;
    const int hd = (n - 1024) >> 5, rr = (n - 1024) & 31;
    p.Wq[(size_t)n * 256 + k] = (h16)(p.w_uq[(size_t)k * 768 + hd * 96 + 64 + rr] * p.qn_g[k]);
  }
  for (int idx = gt; idx < 8 * 64 * 128; idx += nt) {
    const int j = idx & 7, ln = (idx >> 3) & 63, sq = (idx >> 9) & 1, dt = (idx >> 10) & 3, vt = (idx >> 12) & 1, hd = idx >> 13;
    const int v = 32 * vt + (ln & 31);
    const int c = 32 * dt + 16 * sq + 8 * (j >> 2) + 4 * (ln >> 5) + (j & 3);
    p.Wuv[idx] = (h16)p.w_uv[(size_t)c * 512 + hd * 64 + v];
  }
  for (int idx = gt; idx < 2080 * 16; idx += nt) {
    const int pi = idx >> 4, j = idx & 15;
    const int pos = pi < 2048 ? pi : PAST + (pi - 2048);
    const float ang = (float)pos * c_inv_freq[j];
    float s, c;
    sincos_acc(ang, &s, &c);
    p.ropeC[idx] = c; p.ropeS[idx] = s;
  }
}

template <int BM, int BN, int WGM, int WGN>
DI void gemm_tile(const h16* __restrict__ A, int lda, const h16* __restrict__ B, int ldb, int K, int m0, int n0,
                  char* smem) {
  constexpr int LS = 72, TS = 136;
  constexpr int TM = BM / WGM, TN = BN / WGN, MI = TM / 32, NI = TN / 32;
  constexpr int ACH = BM * 8 / NBLK_THREADS, BCH = BN * 8 / NBLK_THREADS;
  h16* sA = (h16*)smem;
  h16* sB = sA + 2 * BM * LS;
  const int tid = opaque_tid(), lane = tid & 63, w = tid >> 6;
  const int wm = w / WGN, wn = w % WGN;
  const int r = lane & 31, hh = lane >> 5;
  f16v acc[MI][NI];
#pragma unroll
  for (int mi = 0; mi < MI; ++mi)
#pragma unroll
    for (int ni = 0; ni < NI; ++ni)
#pragma unroll
      for (int i = 0; i < 16; ++i) acc[mi][ni][i] = 0.f;
  h8 ra[ACH], rb[BCH];
  const int KT = K / 64;
#define GLOAD(kt)                                                                                   \
  {                                                                                                 \
    _Pragma("unroll") for (int i = 0; i < ACH; ++i) {                                               \
      const int q = tid + NBLK_THREADS * i;                                                         \
      ra[i] = *(const h8*)(A + (size_t)(m0 + (q >> 3)) * lda + (kt) * 64 + (q & 7) * 8);            \
    }                                                                                               \
    _Pragma("unroll") for (int i = 0; i < BCH; ++i) {                                               \
      const int q = tid + NBLK_THREADS * i;                                                         \
      rb[i] = *(const h8*)(B + (size_t)(n0 + (q >> 3)) * ldb + (kt) * 64 + (q & 7) * 8);            \
    }                                                                                               \
  }
#define SSTORE(buf)                                                                                 \
  {                                                                                                 \
    _Pragma("unroll") for (int i = 0; i < ACH; ++i) {                                               \
      const int q = tid + NBLK_THREADS * i;                                                         \
      *(h8*)(sA + ((buf) * BM + (q >> 3)) * LS + (q & 7) * 8) = ra[i];                              \
    }                                                                                               \
    _Pragma("unroll") for (int i = 0; i < BCH; ++i) {                                               \
      const int q = tid + NBLK_THREADS * i;                                                         \
      *(h8*)(sB + ((buf) * BN + (q >> 3)) * LS + (q & 7) * 8) = rb[i];                              \
    }                                                                                               \
  }
  GLOAD(0);
  SSTORE(0);
  __syncthreads();
  int buf = 0;
  for (int kt = 0; kt < KT; ++kt) {
    if (kt + 1 < KT) GLOAD(kt + 1);
    const h16* a_base = sA + (buf * BM + wm * TM + r) * LS + 8 * hh;
    const h16* b_base = sB + (buf * BN + wn * TN + r) * LS + 8 * hh;
#pragma unroll
    for (int t = 0; t < 4; ++t) {
      h8 af[MI], bf[NI];
#pragma unroll
      for (int mi = 0; mi < MI; ++mi) af[mi] = *(const h8*)(a_base + mi * 32 * LS + t * 16);
#pragma unroll
      for (int ni = 0; ni < NI; ++ni) bf[ni] = *(const h8*)(b_base + ni * 32 * LS + t * 16);
#pragma unroll
      for (int mi = 0; mi < MI; ++mi)
#pragma unroll
        for (int ni = 0; ni < NI; ++ni) acc[mi][ni] = MFMA32(bf[ni], af[mi], acc[mi][ni]);
    }
    if (kt + 1 < KT) SSTORE(buf ^ 1);
    __syncthreads();
    buf ^= 1;
  }
#undef GLOAD
#undef SSTORE
  h16* T = (h16*)smem;
#pragma unroll
  for (int mi = 0; mi < MI; ++mi)
#pragma unroll
    for (int ni = 0; ni < NI; ++ni)
#pragma unroll
      for (int g4 = 0; g4 < 4; ++g4) {
        h4 o;
#pragma unroll
        for (int jj = 0; jj < 4; ++jj) o[jj] = (h16)acc[mi][ni][4 * g4 + jj];
        *(h4*)(T + (wm * TM + mi * 32 + r) * TS + wn * TN + ni * 32 + 8 * g4 + 4 * hh) = o;
      }
  __syncthreads();
}

template <int OP>
DI void epi_simple(const h16* T, int m0, h16* dst, int ld, int col0, int tid) {
  h8 v[8];
#pragma unroll
  for (int it = 0; it < 8; ++it) {
    const int q = tid + NBLK_THREADS * it;
    v[it] = *(const h8*)(T + (q >> 4) * 136 + (q & 15) * 8);
  }
#pragma unroll
  for (int it = 0; it < 8; ++it) {
    const int q = tid + NBLK_THREADS * it;
    h8 o;
#pragma unroll
    for (int e = 0; e < 8; ++e) {
      const float x = (float)v[it][e];
      o[e] = (OP == 1) ? (h16)silu(x) : (OP == 2) ? (h16)(x * QB_SCALE) : v[it][e];
    }
    *(h8*)(dst + (size_t)(m0 + (q >> 4)) * ld + col0 + (q & 15) * 8) = o;
  }
}
DI float4 f4_lo(h8 v) { return make_float4((float)v[0], (float)v[1], (float)v[2], (float)v[3]); }
DI float4 f4_hi(h8 v) { return make_float4((float)v[4], (float)v[5], (float)v[6], (float)v[7]); }
typedef float f32x4 __attribute__((ext_vector_type(4)));
typedef __attribute__((address_space(3))) unsigned* lds_u32p;
DI int g8_lds_byte(int r, int c) {
  const int st = (r >> 4) * 2 + (c >> 5), rr = r & 15, cc = c & 31, ob = rr * 64 + cc * 2;
  return st * 1024 + (ob ^ (((ob >> 9) & 1) << 5));
}
DI void g8_stage_rc(int b, int& R, int& C) {
  const int st = b / 1024, sb = b % 1024, swz = sb ^ (((sb >> 9) & 1) << 5);
  R = (st >> 1) * 16 + swz / 64;
  C = (st & 1) * 32 + (swz % 64) / 2;
}
#define G8_HT (128 * 64)
DI void gemm8_mainloop(const h16* __restrict__ A, const h16* __restrict__ Bt, int K, int brow, int bcol, char* smem,
                       f32x4 (&acc)[2][2][4][2]) {
  h16* shm = (h16*)smem;
  const int tid = opaque_tid();
  const int wid = tid >> 6, lane = tid & 63, wr = wid >> 2, wc = wid & 3, fr = lane & 15, fq = lane >> 4;
  int so[2];
#pragma unroll
  for (int i = 0; i < 2; ++i) { int R, C; g8_stage_rc(tid * 16 + i * 8192, R, C); so[i] = R * K + C; }
#define G8_SA(b, h) (shm + ((b) * 2 + (h)) * G8_HT)
#define G8_SB(b, h) (shm + (4 + (b) * 2 + (h)) * G8_HT)
#define G8_STAGE(Pp, BASE, br, kt)                                                                        \
  do {                                                                                                    \
    const h16* _bp = (BASE) + (size_t)(br) * K + (kt) * 64;                              \
    _Pragma("unroll") for (int _i = 0; _i < 2; ++_i) {                                                    \
      const h16* _g = _bp + so[_i];                                                                       \
      __builtin_amdgcn_global_load_lds((const unsigned*)_g,                                               \
                                       (lds_u32p)((char*)(Pp) + tid * 16 + _i * 8192), 16, 0, 0);         \
    }                                                                                                     \
  } while (0)
#define G8_LDA(dst, b, h)                                                                                 \
  _Pragma("unroll") for (int m = 0; m < 4; ++m) _Pragma("unroll") for (int k = 0; k < 2; ++k)             \
    dst[m][k] = *(const h8*)((const char*)G8_SA(b, h) + g8_lds_byte(wr * 64 + m * 16 + fr, k * 32 + fq * 8))
#define G8_LDB(dst, b, h)                                                                                 \
  _Pragma("unroll") for (int n = 0; n < 2; ++n) _Pragma("unroll") for (int k = 0; k < 2; ++k)             \
    dst[n][k] = *(const h8*)((const char*)G8_SB(b, h) + g8_lds_byte(wc * 32 + n * 16 + fr, k * 32 + fq * 8))
#define G8_MMA(ai, bj, At, Bq)                                                                            \
  do {                                                                                                    \
    __builtin_amdgcn_s_setprio(1);                                                                        \
    _Pragma("unroll") for (int m = 0; m < 4; ++m) _Pragma("unroll") for (int n = 0; n < 2; ++n)           \
      _Pragma("unroll") for (int k = 0; k < 2; ++k)                                                       \
        acc[ai][bj][m][n] = __builtin_amdgcn_mfma_f32_16x16x32_f16(Bq[n][k], At[m][k], acc[ai][bj][m][n], 0, 0, 0); \
    __builtin_amdgcn_s_setprio(0);                                                                        \
  } while (0)
#define G8_WAIT_V(n) asm volatile("s_waitcnt vmcnt(" #n ")" ::: "memory")
#define G8_WAIT_L(n) asm volatile("s_waitcnt lgkmcnt(" #n ")" ::: "memory")
#define G8_BAR __builtin_amdgcn_s_barrier()
#define G8_SCHED __builtin_amdgcn_sched_barrier(0)
#pragma unroll
  for (int a = 0; a < 2; ++a)
#pragma unroll
    for (int b = 0; b < 2; ++b)
#pragma unroll
      for (int m = 0; m < 4; ++m)
#pragma unroll
        for (int n = 0; n < 2; ++n) acc[a][b][m][n] = f32x4{0.f, 0.f, 0.f, 0.f};
  h8 At[4][2], B0[2][2], B1[2][2];
  const int nt = K / 64;
  G8_STAGE(G8_SB(0, 0), Bt, bcol, 0); G8_STAGE(G8_SA(0, 0), A, brow, 0);
  G8_STAGE(G8_SB(0, 1), Bt, bcol + 128, 0); G8_STAGE(G8_SA(0, 1), A, brow + 128, 0);
  if (wr == 1) G8_BAR;
  G8_WAIT_V(4); G8_BAR;
  G8_STAGE(G8_SB(1, 0), Bt, bcol, 1); G8_STAGE(G8_SA(1, 0), A, brow, 1); G8_STAGE(G8_SB(1, 1), Bt, bcol + 128, 1);
  G8_WAIT_V(6); G8_BAR;
  for (int t = 0; t < nt - 2; t += 2) {
    G8_LDB(B0, 0, 0); G8_SCHED; G8_LDA(At, 0, 0); G8_STAGE(G8_SA(1, 1), A, brow + 128, t + 1);
    G8_WAIT_L(8); G8_BAR; G8_WAIT_L(0); G8_MMA(0, 0, At, B0); G8_BAR; G8_SCHED;
    G8_LDB(B1, 0, 1); G8_STAGE(G8_SB(0, 0), Bt, bcol, t + 2);
    G8_BAR; G8_WAIT_L(0); G8_MMA(0, 1, At, B1); G8_BAR;
    G8_LDA(At, 0, 1); G8_STAGE(G8_SA(0, 0), A, brow, t + 2);
    G8_BAR; G8_WAIT_L(0); G8_MMA(1, 0, At, B0); G8_BAR; G8_SCHED;
    G8_STAGE(G8_SB(0, 1), Bt, bcol + 128, t + 2);
    G8_WAIT_V(6); G8_BAR; G8_MMA(1, 1, At, B1); G8_BAR;
    G8_LDB(B0, 1, 0); G8_SCHED; G8_LDA(At, 1, 0); G8_STAGE(G8_SA(0, 1), A, brow + 128, t + 2);
    G8_WAIT_L(8); G8_BAR; G8_WAIT_L(0); G8_MMA(0, 0, At, B0); G8_BAR; G8_SCHED;
    G8_LDB(B1, 1, 1); G8_STAGE(G8_SB(1, 0), Bt, bcol, t + 3);
    G8_BAR; G8_WAIT_L(0); G8_MMA(0, 1, At, B1); G8_BAR;
    G8_LDA(At, 1, 1); G8_STAGE(G8_SA(1, 0), A, brow, t + 3);
    G8_BAR; G8_WAIT_L(0); G8_MMA(1, 0, At, B0); G8_BAR; G8_SCHED;
    G8_STAGE(G8_SB(1, 1), Bt, bcol + 128, t + 3);
    G8_WAIT_V(6); G8_BAR; G8_MMA(1, 1, At, B1); G8_BAR;
  }
  { G8_LDB(B0, 0, 0); G8_LDA(At, 0, 0); G8_STAGE(G8_SA(1, 1), A, brow + 128, nt - 1);
    G8_BAR; G8_WAIT_L(0); G8_MMA(0, 0, At, B0); G8_BAR;
    G8_LDB(B1, 0, 1); G8_BAR; G8_WAIT_L(0); G8_MMA(0, 1, At, B1); G8_BAR;
    G8_LDA(At, 0, 1); G8_WAIT_V(4); G8_BAR; G8_WAIT_L(0); G8_MMA(1, 0, At, B0); G8_MMA(1, 1, At, B1); G8_BAR; }
  { G8_LDB(B0, 1, 0); G8_LDA(At, 1, 0); G8_WAIT_V(2); G8_BAR; G8_WAIT_L(0); G8_MMA(0, 0, At, B0); G8_BAR;
    G8_LDB(B1, 1, 1); G8_WAIT_V(0); G8_BAR; G8_WAIT_L(0); G8_MMA(0, 1, At, B1); G8_BAR;
    G8_LDA(At, 1, 1); G8_BAR; G8_WAIT_L(0); G8_MMA(1, 0, At, B0); G8_MMA(1, 1, At, B1); G8_BAR; }
  if (wr == 0) G8_BAR;
#undef G8_SA
#undef G8_SB
#undef G8_STAGE
#undef G8_LDA
#undef G8_LDB
#undef G8_MMA
}

DI void p1_epilogue(const P& p, const h16* T, int m0, int n0, int nt, bool isP) {
  constexpr int TS = 136;
  const int tid = opaque_tid(), lane = tid & 63, w = tid >> 6;
  if (nt == 2) {
    for (int rr = w; rr < 256; rr += 8) {
      const int m = m0 + rr;
      const h2 v2 = *(const h2*)(T + rr * TS + 2 * lane);
      const float a = (float)v2[0], b = (float)v2[1];
      const float ss = wave_sum(a * a + b * b);
      const float rstd = rsqrtf(ss * (1.f / 128.f) + 1e-6f);
      const float2 g = *(const float2*)(p.kvn_g + 2 * lane);
      const float o0 = a * rstd * g.x, o1 = b * rstd * g.y;
      float* oc = isP ? p.out + OFF_P_CKV + (size_t)m * 128 : p.out + OFF_S_CKV + (size_t)(m - NP) * 128;
      *(float2*)(oc + 2 * lane) = make_float2(o0, o1);
      h2 o; o[0] = (h16)o0; o[1] = (h16)o1;
      *(h2*)(p.KM + (size_t)m * 160 + 2 * lane) = o;
    }
  } else if (nt >= 4 && nt <= 6) {
    epi_simple<1>(T, m0, p.GA, 512, n0 - ZC_GA, tid);
  } else if (nt >= 8 && nt <= 10) {
    epi_simple<2>(T, m0, p.QB, 512, n0 - ZC_QB, tid);
  } else if (nt >= 14 && nt <= 16) {
    epi_simple<0>(T, m0, p.QI, 512, n0 - ZC_QI, tid);
  } else if (nt >= 18 && nt <= 20) {
    epi_simple<1>(T, m0, p.GB, 512, n0 - ZC_GB, tid);
  } else {
#pragma unroll 1
    for (int it = 0; it < 8; ++it) {
      const int q = tid + NBLK_THREADS * it;
      const int row = q >> 4, ch = q & 15;
      const int col = n0 + ch * 8, m = m0 + row;
      const int ms = isP ? m : m - NP;
      const h8 v = *(const h8*)(T + row * TS + ch * 8);
      if (col < ZC_CKV) {
        *(h8*)(p.CQ + (size_t)m * 256 + col) = v;
        float ss = 0.f;
#pragma unroll
        for (int e = 0; e < 8; ++e) ss += (float)v[e] * (float)v[e];
        ss += __shfl_xor(ss, 1); ss += __shfl_xor(ss, 2); ss += __shfl_xor(ss, 4); ss += __shfl_xor(ss, 8);
        if (ch == 0) p.RQP[(size_t)m * 2 + nt] = ss;
      } else if (col < ZC_GA) {
        const int j0 = col - ZC_KPE;
        const bool hiHalf = j0 >= 16;
        const h8 u = *(const h8*)(T + row * TS + (hiHalf ? ch - 2 : ch + 2) * 8);
        const int ri = rope_idx(m) * 16 + (j0 & 15);
        const float4 c0 = *(const float4*)(p.ropeC + ri), c1 = *(const float4*)(p.ropeC + ri + 4);
        const float4 s0 = *(const float4*)(p.ropeS + ri), s1 = *(const float4*)(p.ropeS + ri + 4);
        const float cs[8] = {c0.x, c0.y, c0.z, c0.w, c1.x, c1.y, c1.z, c1.w};
        const float sn[8] = {s0.x, s0.y, s0.z, s0.w, s1.x, s1.y, s1.z, s1.w};
        float o[8];
        h8 oh;
#pragma unroll
        for (int e = 0; e < 8; ++e) {
          const float mine = (float)v[e], other = (float)u[e];
          o[e] = hiHalf ? (other * sn[e] + mine * cs[e]) : (mine * cs[e] - other * sn[e]);
          oh[e] = (h16)o[e];
        }
        float* oc = (isP ? p.out + OFF_P_KPE : p.out + OFF_S_KPE) + (size_t)ms * 32 + j0;
        *(float4*)oc = make_float4(o[0], o[1], o[2], o[3]);
        *(float4*)(oc + 4) = make_float4(o[4], o[5], o[6], o[7]);
        *(h8*)(p.KM + (size_t)m * 160 + 128 + j0) = oh;
      } else if (col < ZC_QB) {
        h8 o;
#pragma unroll
        for (int e = 0; e < 8; ++e) o[e] = (h16)silu((float)v[e]);
        *(h8*)(p.GA + (size_t)m * 512 + (col - ZC_GA)) = o;
      } else if (col < ZC_KB) {
        h8 o;
#pragma unroll
        for (int e = 0; e < 8; ++e) o[e] = (h16)((float)v[e] * QB_SCALE);
        *(h8*)(p.QB + (size_t)m * 512 + (col - ZC_QB)) = o;
      } else if (col < ZC_QI) {
        const bool isK = col < ZC_VB;
        const int c0 = col - (isK ? ZC_KB : ZC_VB);
        float* oc = (isK ? (isP ? p.out + OFF_P_K : p.out + OFF_S_K) : (isP ? p.out + OFF_P_V : p.out + OFF_S_V)) +
                    (size_t)ms * 128 + c0;
        *(float4*)oc = f4_lo(v);
        *(float4*)(oc + 4) = f4_hi(v);
        *(h8*)((isK ? p.KB : p.VB) + (size_t)m * 128 + c0) = v;
      } else if (col < ZC_KI) {
        *(h8*)(p.QI + (size_t)m * 512 + (col - ZC_QI)) = v;
      } else if (col < ZC_WI) {
        float* oc = (isP ? p.out + OFF_P_KIDX : p.out + OFF_S_KIDX) + (size_t)ms * 64 + (col - ZC_KI);
        *(float4*)oc = f4_lo(v);
        *(float4*)(oc + 4) = f4_hi(v);
        *(h8*)(p.KI + (size_t)m * 64 + (col - ZC_KI)) = v;
      } else if (col < ZC_GB) {
        float* oc = p.WI + (size_t)m * 8;
        const float4 a = f4_lo(v), b = f4_hi(v);
        *(float4*)oc = make_float4(a.x * WI_SCALE, a.y * WI_SCALE, a.z * WI_SCALE, a.w * WI_SCALE);
        *(float4*)(oc + 4) = make_float4(b.x * WI_SCALE, b.y * WI_SCALE, b.z * WI_SCALE, b.w * WI_SCALE);
      } else if (col < INW) {
        h8 o;
#pragma unroll
        for (int e = 0; e < 8; ++e) o[e] = (h16)silu((float)v[e]);
        *(h8*)(p.GB + (size_t)m * 512 + (col - ZC_GB)) = o;
      }
    }
  }
}

DI void phase1(const P& p, char* smem) {
  constexpr int TS = 136;
  h16* T = (h16*)smem;
  const int ntiles = 68 * 11;
  const int xcd = blockIdx.x & 7, lb = blockIdx.x >> 3, nlb = gridDim.x >> 3;
  const int per = (ntiles + 7) >> 3;
  const int tend = (xcd * per + per) < ntiles ? (xcd * per + per) : ntiles;
  for (int L = xcd * per + lb; L < tend; L += nlb) {
    const int pg = L / 44, rem = L - pg * 44;
    const int pn = rem >> 2, mt = pg * 4 + (rem & 3);
    const int m0 = mt * 256;
    const bool isP = mt < 64;
    f32x4 acc[2][2][4][2];
    gemm8_mainloop(p.hX, p.Wt_in, DM, m0, pn * 256, smem, acc);
    __syncthreads();
    const int tid = opaque_tid();
    const int wid = tid >> 6, lane = tid & 63, wr = wid >> 2, wc = wid & 3, fr = lane & 15, fq = lane >> 4;
#pragma unroll
    for (int bj = 0; bj < 2; ++bj) {
#pragma unroll
      for (int ai = 0; ai < 2; ++ai)
#pragma unroll
        for (int m = 0; m < 4; ++m)
#pragma unroll
          for (int n = 0; n < 2; ++n)
          {
            h4 o;
#pragma unroll
            for (int jj = 0; jj < 4; ++jj) o[jj] = (h16)acc[ai][bj][m][n][jj];
            *(h4*)(T + (ai * 128 + wr * 64 + m * 16 + fr) * TS + wc * 32 + n * 16 + fq * 4) = o;
          }
      __syncthreads();
      p1_epilogue(p, T, m0, pn * 256 + bj * 128, pn * 2 + bj, isP);
      __syncthreads();
    }
  }
}

DI size_t qm_index(int m, int hd, int d) {
  return ((((size_t)(m >> 5) * 8 + hd) * 10 + (d >> 4)) * 64 + (((d >> 3) & 1) * 32 + (m & 31))) * 8 + (d & 7);
}
DI void phase1b(const P& p, char* smem) {
  constexpr int TS = 136;
  h16* T = (h16*)smem;
  float* rq = (float*)(smem + 128 * 1024 - 2048);
  const int ntiles = 68 * 5;
  for (int tile = blockIdx.x; tile < ntiles; tile += gridDim.x) {
    const int mt = tile / 5, pn = tile % 5;
    const int m0 = mt * 256;
    f32x4 acc[2][2][4][2];
    gemm8_mainloop(p.CQ, p.Wq, 256, m0, pn * 256, smem, acc);
    __syncthreads();
    const int tid = opaque_tid();
    if (tid < 256) {
      const float2 pp = *(const float2*)(p.RQP + (size_t)(m0 + tid) * 2);
      rq[tid] = rsqrtf((pp.x + pp.y) * (1.f / 256.f) + 1e-6f) * QM_SCALE;
    }
    const int wid = tid >> 6, lane = tid & 63, wr = wid >> 2, wc = wid & 3, fr = lane & 15, fq = lane >> 4;
#pragma unroll
    for (int bj = 0; bj < 2; ++bj) {
      const int nt = pn * 2 + bj;
#pragma unroll
      for (int ai = 0; ai < 2; ++ai)
#pragma unroll
        for (int m = 0; m < 4; ++m)
#pragma unroll
          for (int n = 0; n < 2; ++n)
          {
            h4 o;
#pragma unroll
            for (int jj = 0; jj < 4; ++jj) o[jj] = (h16)acc[ai][bj][m][n][jj];
            *(h4*)(T + (ai * 128 + wr * 64 + m * 16 + fr) * TS + wc * 32 + n * 16 + fq * 4) = o;
          }
      __syncthreads();
#pragma unroll 2
      for (int it = 0; it < 8; ++it) {
        const int q = tid + NBLK_THREADS * it;
        const int row = q >> 4, ch = q & 15;
        const int m = m0 + row;
        const float sc = rq[row];
        const h8 v = *(const h8*)(T + row * TS + ch * 8);
        h8 o;
        int hd, d0;
        if (nt < 8) {
          hd = nt; d0 = ch * 8;
#pragma unroll
          for (int e = 0; e < 8; ++e) o[e] = (h16)((float)v[e] * sc);
        } else {
          hd = (nt - 8) * 4 + (ch >> 2);
          const int j0 = (ch & 3) * 8;
          d0 = 128 + j0;
          const bool hiHalf = j0 >= 16;
          const h8 u = *(const h8*)(T + row * TS + (hiHalf ? ch - 2 : ch + 2) * 8);
          const int ri = rope_idx(m) * 16 + (j0 & 15);
          const float4 c0 = *(const float4*)(p.ropeC + ri), c1 = *(const float4*)(p.ropeC + ri + 4);
          const float4 s0 = *(const float4*)(p.ropeS + ri), s1 = *(const float4*)(p.ropeS + ri + 4);
          const float cs[8] = {c0.x, c0.y, c0.z, c0.w, c1.x, c1.y, c1.z, c1.w};
          const float sn[8] = {s0.x, s0.y, s0.z, s0.w, s1.x, s1.y, s1.z, s1.w};
#pragma unroll
          for (int e = 0; e < 8; ++e) {
            const float mine = (float)v[e] * sc, other = (float)u[e] * sc;
            o[e] = (h16)(hiHalf ? (other * sn[e] + mine * cs[e]) : (mine * cs[e] - other * sn[e]));
          }
        }
        *(h8*)(p.QM + qm_index(m, hd, d0)) = o;
      }
      __syncthreads();
    }
  }
}

template <bool SAMPLE>
DI void mla_item(const P& p, int b, int tok0, int nkeys, char* smem, const int tid, unsigned* ctr, int& nxt) {
  constexpr int KS = 168;
  h16* sK = (h16*)smem;
  const int lane = tid & 63, w = tid >> 6;
  const int r = lane & 31, hh = lane >> 5;
  const int i16 = lane & 15, q4 = i16 >> 2, p4 = i16 & 3, blk = (lane >> 4) & 1;

  h8 qf[10];
  {
    const h16* qp = p.QM + ((size_t)((tok0 >> 5) * 8 + w) * 10 * 64 + lane) * 8;
#pragma unroll
    for (int t = 0; t < 10; ++t) qf[t] = *(const h8*)(qp + t * 512);
  }
  f16v O[4];
#pragma unroll
  for (int dt = 0; dt < 4; ++dt)
#pragma unroll
    for (int i = 0; i < 16; ++i) O[dt][i] = 0.f;
  float m = NEGBIG, l = 0.f;

  h8 sh[3];
  float4 sf[3][2];
  const int NT = (nkeys + 63) >> 6;

#define MLA_GLOAD(kt)                                                                                          \
  {                                                                                                            \
    _Pragma("unroll") for (int i = 0; i < 3; ++i) {                                                            \
      const int q = tid + NBLK_THREADS * i;                                                                    \
      const int row = q / 20, cc = q % 20;                                                                     \
      const int s = (kt) * 64 + row;                                                                           \
      if (q < 1280) {                                                                                          \
        if (!SAMPLE) {                                                                                         \
          sh[i] = *(const h8*)(p.KM + (size_t)(b * 2048 + s) * 160 + cc * 8);                                  \
        } else {                                                                                               \
          if (s < PAST) {                                                                                      \
            const float* src = (cc < 16) ? p.c_ckv + ((size_t)(b * PAST + s) * 128 + cc * 8)                   \
                                         : p.c_kpe + ((size_t)(b * PAST + s) * 32 + (cc - 16) * 8);            \
            sf[i][0] = *(const float4*)src; sf[i][1] = *(const float4*)(src + 4);                              \
          } else if (s < SKEYS) {                                                                              \
            sf[i][0] = __builtin_bit_cast(float4, *(const h8*)(p.KM + (size_t)(NP + b * 32 + (s - PAST)) * 160 + cc * 8)); \
          } else {                                                                                             \
            sf[i][0] = make_float4(0.f, 0.f, 0.f, 0.f);                                                        \
          }                                                                                                    \
        }                                                                                                      \
      }                                                                                                        \
    }                                                                                                          \
  }
#define MLA_SSTORE(kt, buf)                                                                                    \
  {                                                                                                            \
    _Pragma("unroll") for (int i = 0; i < 3; ++i) {                                                            \
      const int q = tid + NBLK_THREADS * i;                                                                    \
      const int row = q / 20, cc = q % 20;                                                                     \
      const int s = (kt) * 64 + row;                                                                           \
      if (q < 1280) {                                                                                          \
        h8 v;                                                                                                  \
        if (SAMPLE) v = (s < PAST) ? cvt8(sf[i][0], sf[i][1]) : __builtin_bit_cast(h8, sf[i][0]);              \
        else v = sh[i];                                                                                        \
        *(h8*)(sK + ((buf) * 64 + row) * KS + cc * 8) = v;                                                     \
      }                                                                                                        \
    }                                                                                                          \
  }

  MLA_GLOAD(0);
#pragma unroll
  for (int t = 0; t < 10; ++t) pin8(qf[t]);
  MLA_SSTORE(0, 0);
  __syncthreads();
  int buf = 0;
  for (int kt = 0; kt < NT; ++kt) {
    if (kt + 1 < NT) MLA_GLOAD(kt + 1);
    const bool two = (nkeys - kt * 64) > 32;
    const h16* kbase = sK + buf * 64 * KS;
    const h16* ka_ptr = kbase + r * KS + 8 * hh;
    const h16* vb_ptr = kbase + (4 * hh + q4) * KS + 16 * blk + 4 * p4;
    f16v S0, S1;
#pragma unroll
    for (int i = 0; i < 16; ++i) { S0[i] = 0.f; S1[i] = 0.f; }
    {
      h8 ka0[3], ka1[3];
#pragma unroll
      for (int t = 0; t < 3; ++t) {
        ka0[t] = *(const h8*)(ka_ptr + 16 * t);
        ka1[t] = *(const h8*)(ka_ptr + 32 * KS + 16 * t);
      }
#pragma unroll
      for (int t = 0; t < 10; ++t) {
        S0 = MFMA32(ka0[t % 3], qf[t], S0);
        S1 = MFMA32(ka1[t % 3], qf[t], S1);
        if (t + 3 < 10) {
          ka0[t % 3] = *(const h8*)(ka_ptr + 16 * (t + 3));
          ka1[t % 3] = *(const h8*)(ka_ptr + 32 * KS + 16 * (t + 3));
        }
      }
    }
    h8 vf[4];
#define MLA_VLOAD(f)                                                                   \
  {                                                                                    \
    const h16* vp = vb_ptr + ((((f) >> 3) * 32) + ((((f) >> 2) & 1) * 16)) * KS + 32 * ((f) & 3); \
    vf[(f) & 3] = cat8(trread(vp), trread(vp + 8 * KS));                               \
  }
#pragma unroll
    for (int f = 0; f < 4; ++f) MLA_VLOAD(f);
    if (!two) {
      asm volatile("" ::: "memory");
#pragma unroll
      for (int i = 0; i < 16; ++i) S1[i] = NEGBIG;
    }
    mfma_settle();
    float mx = max3f(S0[0], S0[1], S1[0]);
    mx = max3f(mx, S1[1], S0[2]);
#pragma unroll
    for (int i = 2; i < 15; ++i) mx = max3f(mx, S1[i], S0[i + 1]);
    mx = fmaxf(mx, S1[15]);
    mx = xhalf_max(mx);
    if (__any(mx > m + RESC_T)) {
      const float mn = fmaxf(m, mx);
      const float alpha = fast_exp2(m - mn);
      m = mn;
      l *= alpha;
#pragma unroll
      for (int dt = 0; dt < 4; ++dt)
#pragma unroll
        for (int i = 0; i < 16; ++i) O[dt][i] *= alpha;
    }
    {
      const f2v m2 = {m, m};
      f2v rs2 = {0.f, 0.f};
#pragma unroll
      for (int i = 0; i < 16; i += 2) {
        f2v a = {S0[i], S0[i + 1]};
        f2v b = {S1[i], S1[i + 1]};
        a -= m2; b -= m2;
        a[0] = fast_exp2(a[0]); a[1] = fast_exp2(a[1]);
        b[0] = fast_exp2(b[0]); b[1] = fast_exp2(b[1]);
        rs2 += a; rs2 += b;
        S0[i] = a[0]; S0[i + 1] = a[1]; S1[i] = b[0]; S1[i + 1] = b[1];
      }
      l += rs2[0] + rs2[1];
    }
    h8 pb[4];
#pragma unroll
    for (int g = 0; g < 4; ++g)
#pragma unroll
      for (int jj = 0; jj < 8; ++jj) pb[g][jj] = (h16)((g < 2) ? S0[8 * (g & 1) + jj] : S1[8 * (g & 1) + jj]);
#pragma unroll
    for (int f = 0; f < 16; ++f) {
      O[f & 3] = MFMA32(vf[f & 3], pb[f >> 2], O[f & 3]);
      if (f + 4 < 16) MLA_VLOAD(f + 4);
    }
#undef MLA_VLOAD
    if (kt + 1 < NT) MLA_SSTORE(kt + 1, buf ^ 1);
    __syncthreads();
    buf ^= 1;
  }
#undef MLA_GLOAD
#undef MLA_SSTORE
  if (threadIdx.x == 0) nxt = (int)atomicAdd(ctr, 1u);
  const float inv = 1.f / (l + __shfl_xor(l, 32));
  f16v Y[2];
#pragma unroll
  for (int vt = 0; vt < 2; ++vt)
#pragma unroll
    for (int i = 0; i < 16; ++i) Y[vt][i] = 0.f;
#pragma unroll
  for (int dt = 0; dt < 4; ++dt) {
#pragma unroll
    for (int s = 0; s < 2; ++s) {
      h8 ob;
#pragma unroll
      for (int j = 0; j < 8; ++j) ob[j] = (h16)(O[dt][8 * s + j] * inv);
#pragma unroll
      for (int vt = 0; vt < 2; ++vt) {
        const h8 a = *(const h8*)(p.Wuv + ((size_t)((((w * 2 + vt) * 4 + dt) * 2 + s) * 64 + lane)) * 8);
        Y[vt] = MFMA32(a, ob, Y[vt]);
      }
    }
  }
  h16* Yt = (h16*)smem + w * (32 * 72);
#pragma unroll
  for (int vt = 0; vt < 2; ++vt) {
#pragma unroll
    for (int g4 = 0; g4 < 4; ++g4) {
      h4 o;
#pragma unroll
      for (int j = 0; j < 4; ++j) o[j] = (h16)Y[vt][4 * g4 + j];
      *(h4*)(Yt + r * 72 + 32 * vt + 8 * g4 + 4 * hh) = o;
    }
  }
  wavebar();
#pragma unroll
  for (int i = 0; i < 4; ++i) {
    const int q = lane + 64 * i;
    const int row = q >> 3, ch = q & 7;
    const h8 y = *(const h8*)(Yt + row * 72 + ch * 8);
    const h8 ga = *(const h8*)(p.GA + (size_t)(tok0 + row) * 512 + w * 64 + ch * 8);
    h8 o;
#pragma unroll
    for (int j = 0; j < 8; ++j) o[j] = (h16)((float)y[j] * (float)ga[j]);
    *(h8*)(p.mix + (size_t)(tok0 + row) * 1024 + w * 64 + ch * 8) = o;
  }
  __syncthreads();
}

#define SEL_CAP 256
DI int sel_bin(float v, float lo, float scale, bool degen) {
  if (degen) return v > lo ? 1023 : 0;
  int b = (int)((v - lo) * scale);
  return b > 1023 ? 1023 : b;
}
template <int NR, int NH>
DI void wave_select(const float* sc, int N, unsigned* maskrow, unsigned* hist, float* candv, int* candi, int lane,
                 float (&vpre)[NR], const float* scnext) {
  const int nwords = N >> 5;
  if (lane == 0) maskrow[nwords] = 0u;
  if (N <= 256) {
    for (int wd = lane; wd < nwords; wd += 64) maskrow[wd] = 0xffffffffu;
    return;
  }
  float v[NR];
#define SEL_LOAD(hf)                                                     \
  {                                                                      \
    _Pragma("unroll") for (int i = 0; i < NR; ++i) {                     \
      const int e = 64 * ((hf) * NR + i) + lane;                         \
      v[i] = (e < N) ? sc[e] : -INFINITY;                                \
    }                                                                    \
  }
  if (NH == 1) {
#pragma unroll
    for (int i = 0; i < NR; ++i) v[i] = vpre[i];
    if (scnext) {
#pragma unroll
      for (int i = 0; i < NR; ++i) {
        const int e = 64 * i + lane;
        vpre[i] = (e < N) ? scnext[e] : -INFINITY;
      }
    }
  }
  float lo = INFINITY, hi = -INFINITY;
#pragma unroll 1
  for (int hf = 0; hf < NH; ++hf) {
    if (NH > 1) SEL_LOAD(hf);
#pragma unroll
    for (int i = 0; i < NR; ++i) {
      hi = fmaxf(hi, v[i]);
      lo = fminf(lo, (v[i] == -INFINITY) ? INFINITY : v[i]);
    }
  }
  lo = wave_min(lo); hi = wave_max(hi);
  int need = 256;
  int T = 0, above = 0;
  float scale = 0.f;
  bool degen = false;
  bool rankmode = false;
  bool first = true;
  for (int iter = 0; iter < 64; ++iter) {
    if (!(lo < hi)) break;
    scale = 1024.f / (hi - lo);
    degen = !(scale < 1.0e37f);
    for (int i = lane; i < 1024; i += 64) hist[i] = 0u;
    wavebar();
    if (first && !degen) {
#pragma unroll 1
      for (int hf = 0; hf < NH; ++hf) {
        if (NH > 1) SEL_LOAD(hf);
#pragma unroll
        for (int i = 0; i < NR; ++i) {
          const int eb = 64 * (hf * NR + i);
          if (eb < N) {
            int bn = (int)((v[i] - lo) * scale);
            bn = bn > 1023 ? 1023 : bn;
            if (eb + 64 <= N) atomicAdd(&hist[bn], 1u);
            else if (eb + lane < N) atomicAdd(&hist[bn], 1u);
          }
        }
      }
    } else {
#pragma unroll 1
      for (int hf = 0; hf < NH; ++hf) {
        if (NH > 1) SEL_LOAD(hf);
#pragma unroll
        for (int i = 0; i < NR; ++i) {
          if (v[i] >= lo && v[i] <= hi) atomicAdd(&hist[sel_bin(v[i], lo, scale, degen)], 1u);
          if ((i & 7) == 7) __builtin_amdgcn_sched_barrier(0);
        }
      }
    }
    wavebar();
    unsigned ssum = 0;
#pragma unroll
    for (int i = 0; i < 16; ++i) ssum += hist[16 * lane + i];
    unsigned x = ssum;
#pragma unroll
    for (int off = 1; off < 64; off <<= 1) {
      const unsigned y = __shfl_down(x, off);
      if (lane + off < 64) x += y;
    }
    const unsigned sufx = x - ssum;
    const bool cross = (sufx < (unsigned)need) && (x >= (unsigned)need);
    int myT = 0, myAbove = 0, myC = 0;
    if (cross) {
      unsigned run = sufx;
      for (int i = 15; i >= 0; --i) {
        const unsigned c = hist[16 * lane + i];
        if (run + c >= (unsigned)need) { myT = 16 * lane + i; myAbove = (int)run; myC = (int)c; break; }
        run += c;
      }
    }
    const unsigned long long bal = __ballot(cross);
    const int src = bal ? (int)__builtin_ctzll(bal) : 0;
    T = __shfl(myT, src); above = __shfl(myAbove, src);
    const int cT = __shfl(myC, src);
    if (cT <= SEL_CAP) { rankmode = true; break; }
    first = false;
    need -= above;
    float nlo = INFINITY, nhi = -INFINITY;
#pragma unroll 1
    for (int hf = 0; hf < NH; ++hf) {
      if (NH > 1) SEL_LOAD(hf);
#pragma unroll
      for (int i = 0; i < NR; ++i) {
        if (v[i] >= lo && v[i] <= hi && sel_bin(v[i], lo, scale, degen) == T) { nlo = fminf(nlo, v[i]); nhi = fmaxf(nhi, v[i]); }
      }
    }
    lo = wave_min(nlo); hi = wave_max(nhi);
  }
  const int pick = rankmode ? need - above : need;
  int running = 0;
  const unsigned long long ltmask = (lane == 0) ? 0ull : (~0ull >> (64 - lane));
  const bool fastfinal = rankmode && first && !degen;
#pragma unroll 1
  for (int hf = 0; hf < NH; ++hf) {
    if (NH > 1) SEL_LOAD(hf);
    int mlo = 0, mhi = 0;
#pragma unroll
    for (int i = 0; i < NR; ++i) {
      const int eb = 64 * (hf * NR + i);
      if (eb < N) {
        const float vv = v[i];
        unsigned long long bs, bc;
        if (fastfinal) {
          int bn = (int)((vv - lo) * scale);
          bn = bn > 1023 ? 1023 : bn;
          bs = __ballot(bn > T);
          bc = __ballot(bn == T);
        } else {
          bool s = vv > hi;
          bool c;
          if (rankmode) {
            const bool inr = (vv >= lo && vv <= hi);
            const int bn = inr ? sel_bin(vv, lo, scale, degen) : -1;
            s = s || (bn > T);
            c = (bn == T);
          } else {
            c = (vv == hi);
          }
          bc = __ballot(c);
          if (!rankmode) {
            const int pos = running + __popcll(bc & ltmask);
            s = s || (c && pos < pick);
          }
          bs = __ballot(s);
        }
        if (bc != 0ull) {
          if (rankmode) {
            const bool c = (bc >> lane) & 1ull;
            const int pos = running + __popcll(bc & ltmask);
            if (c) { candv[pos] = vv; candi[pos] = eb + lane; }
          }
          running += __popcll(bc);
        }
        if (lane == i) { mlo = (int)(unsigned)bs; mhi = (int)(unsigned)(bs >> 32); }
      }
      if ((i & 7) == 7) __builtin_amdgcn_sched_barrier(0);
    }
    {
      const int wd = 2 * (hf * NR + lane);
      if (lane < NR && wd < nwords) {
        maskrow[wd] = (unsigned)mlo;
        if (wd + 1 < nwords) maskrow[wd + 1] = (unsigned)mhi;
      }
    }
  }
#undef SEL_LOAD
  if (rankmode) {
    wavebar();
    const int ncand = running;
    for (int i = lane; i < ncand; i += 64) {
      const float vi = candv[i];
      const int ii = candi[i];
      int rank = 0;
      for (int j = 0; j < ncand; ++j) {
        const float vj = candv[j];
        const int ij = candi[j];
        rank += ((vj > vi) || (vj == vi && ij < ii)) ? 1 : 0;
      }
      if (rank < pick) atomicOr(&maskrow[ii >> 5], 1u << (ii & 31));
    }
  }
  wavebar();
}

template <bool SAMPLE>
DI void dsa_item(const P& p, int b, int tok0, int qpos0, int nkeys, float* sc, int scs,
                         char* smem, const int tid, unsigned* ctr, int& nxt) {
  const int lane = tid & 63, w = tid >> 6;
  const int r = lane & 31, hh = lane >> 5;
  const int NT = (nkeys + 63) >> 6;
  unsigned* sMask = (unsigned*)(smem + 73728);
  float* sBias = (float*)(smem + 73728 + 32 * MASK_W * 4);
  if (tid < 256) sBias[tid] = p.rel_bias[tid] * LOG2E;
  float* sBT = sBias + 256;
  for (int e = tid; e < 249 * 8; e += NBLK_THREADS) {
    const int rel = (e >> 3) - 185;
    const int n = rel < 0 ? -rel : rel;
    int bk = n;
    if (n >= 8) bk = 8 + (n >= 12) + (n >= 16) + (n >= 23) + (n >= 32) + (n >= 46) + (n >= 64) + (n >= 91);
    if (rel > 0) bk += 16;
    sBT[e] = p.rel_bias[bk * 8 + (e & 7)] * LOG2E;
  }
  {
    constexpr int LS = 72;
    h16* sKI = (h16*)smem;
    const int NTA = (nkeys + 127) >> 7;
    h8 ai[4];
    {
      const int aq = ((r >> 2) & 1) * 2 + (r >> 4), ah = (r & 3) + 4 * ((r >> 3) & 1);
      const h16* qp = p.QI + ((size_t)(tok0 + 4 * w + aq) * 8 + ah) * 64 + 8 * hh;
#pragma unroll
      for (int t = 0; t < 4; ++t) ai[t] = *(const h8*)(qp + 16 * t);
    }
    float w16[16];
#pragma unroll
    for (int i = 0; i < 16; ++i)
      w16[i] = p.WI[(size_t)(tok0 + 4 * w + 2 * hh + (i >> 3)) * 8 + (i & 3) + 4 * ((i >> 2) & 1)];
    h8 sh[2];
    float4 sf[2][2];
#define KI_GLOAD(kt)                                                                                  \
  {                                                                                                   \
    _Pragma("unroll") for (int i = 0; i < 2; ++i) {                                                   \
      const int q = tid + NBLK_THREADS * i;                                                           \
      const int s = (kt) * 128 + (q >> 3), lcc = q & 7;                                               \
      if (!SAMPLE) {                                                                                  \
        sh[i] = (s < nkeys) ? *(const h8*)(p.KI + (size_t)(b * 2048 + s) * 64 + lcc * 8) : zero8();   \
      } else if (s < PAST) {                                                                          \
        const float* src = p.c_kidx + ((size_t)(b * PAST + s) * 64 + lcc * 8);                        \
        sf[i][0] = *(const float4*)src; sf[i][1] = *(const float4*)(src + 4);                         \
      } else if (s < SKEYS) {                                                                         \
        sf[i][0] = __builtin_bit_cast(float4, *(const h8*)(p.KI + (size_t)(NP + b * 32 + (s - PAST)) * 64 + lcc * 8)); \
      } else {                                                                                        \
        sf[i][0] = make_float4(0.f, 0.f, 0.f, 0.f);                                                   \
      }                                                                                               \
    }                                                                                                 \
  }
#define KI_SSTORE(kt, buf)                                                                            \
  {                                                                                                   \
    _Pragma("unroll") for (int i = 0; i < 2; ++i) {                                                   \
      const int q = tid + NBLK_THREADS * i;                                                           \
      const int s = (kt) * 128 + (q >> 3), lcc = q & 7;                                               \
      h8 v;                                                                                           \
      if (SAMPLE) v = (s < PAST) ? cvt8(sf[i][0], sf[i][1]) : __builtin_bit_cast(h8, sf[i][0]);       \
      else v = sh[i];                                                                                 \
      *(h8*)(sKI + ((buf) * 128 + (q >> 3)) * LS + lcc * 8) = v;                                      \
    }                                                                                                 \
  }
    KI_GLOAD(0);
#pragma unroll
    for (int t = 0; t < 4; ++t) pin8(ai[t]);
#pragma unroll
    for (int i = 0; i < 16; ++i) pinf(w16[i]);
    KI_SSTORE(0, 0);
    __syncthreads();
    int buf = 0;
    for (int kt = 0; kt < NTA; ++kt) {
      if (kt + 1 < NTA) KI_GLOAD(kt + 1);
      const h16* kbase = sKI + buf * 128 * LS + r * LS + 8 * hh;
#pragma unroll
      for (int sub = 0; sub < 4; ++sub) {
        const int key0 = kt * 128 + 32 * sub;
        if (key0 < nkeys) {
          f16v D;
#pragma unroll
          for (int i = 0; i < 16; ++i) D[i] = 0.f;
#pragma unroll
          for (int t = 0; t < 4; ++t) {
            const h8 bf = *(const h8*)(kbase + 32 * sub * LS + 16 * t);
            D = MFMA32(ai[t], bf, D);
          }
          mfma_settle();
          float ps0 = 0.f, ps1 = 0.f;
#pragma unroll
          for (int i = 0; i < 8; ++i) {
            ps0 = fmaf(relu1(D[i]), w16[i], ps0);
            ps1 = fmaf(relu1(D[8 + i]), w16[8 + i], ps1);
          }
          float* so = sc + (size_t)(4 * w + 2 * hh) * scs + key0 + r;
          so[0] = ps0;
          so[scs] = ps1;
        }
      }
      if (kt + 1 < NTA) KI_SSTORE(kt + 1, buf ^ 1);
      __syncthreads();
      buf ^= 1;
    }
#undef KI_GLOAD
#undef KI_SSTORE
  }
    constexpr int LS = 136;
    h16* sKb = (h16*)smem;
    h16* sVb = sKb + 2 * 64 * LS;
    const int kv = w >> 2, ql = 8 * (w & 3) + (r >> 2), g = r & 3, head = 4 * kv + g;
    const int i16 = lane & 15, q4 = i16 >> 2, p4 = i16 & 3, blk = (lane >> 4) & 1;
    const int tq = tok0 + ql;
    const int pq = qpos0 + ql;
    h8 qf[4];
#define DSA_QLOAD                                                                  \
    {                                                                              \
      const h16* qp = p.QB + (size_t)tq * 512 + head * 64 + 8 * hh;                \
      _Pragma("unroll") for (int t = 0; t < 4; ++t) qf[t] = *(const h8*)(qp + 16 * t); \
    }
    if (!SAMPLE) DSA_QLOAD;
    h8 sh[4];
    float4 sf[4][2];
#define KV_GLOAD(kt)                                                                                   \
  {                                                                                                    \
    _Pragma("unroll") for (int i = 0; i < 4; ++i) {                                                    \
      const int q = tid + NBLK_THREADS * i;                                                            \
      const int row = q >> 5, cc = q & 31, c16 = cc & 15;                                              \
      const int s = (kt) * 64 + row;                                                                   \
      if (!SAMPLE) {                                                                                   \
        sh[i] = *(const h8*)(((cc < 16) ? p.KB : p.VB) + (size_t)(b * 2048 + s) * 128 + c16 * 8);      \
      } else if (s < PAST) {                                                                           \
        const float* src = ((cc < 16) ? p.c_k : p.c_v) + ((size_t)(b * PAST + s) * 128 + c16 * 8);     \
        sf[i][0] = *(const float4*)src; sf[i][1] = *(const float4*)(src + 4);                          \
      } else if (s < SKEYS) {                                                                          \
        sf[i][0] = __builtin_bit_cast(float4, *(const h8*)(((cc < 16) ? p.KB : p.VB) + (size_t)(NP + b * 32 + (s - PAST)) * 128 + c16 * 8)); \
      } else {                                                                                         \
        sf[i][0] = make_float4(0.f, 0.f, 0.f, 0.f);                                                    \
      }                                                                                                \
    }                                                                                                  \
  }
#define KV_SSTORE(kt, buf)                                                                             \
  {                                                                                                    \
    _Pragma("unroll") for (int i = 0; i < 4; ++i) {                                                    \
      const int q = tid + NBLK_THREADS * i;                                                            \
      const int row = q >> 5, cc = q & 31, c16 = cc & 15;                                              \
      const int s = (kt) * 64 + row;                                                                   \
      h8 v;                                                                                            \
      if (SAMPLE) v = (s < PAST) ? cvt8(sf[i][0], sf[i][1]) : __builtin_bit_cast(h8, sf[i][0]);        \
      else v = sh[i];                                                                                  \
      *(h8*)(((cc < 16) ? sKb : sVb) + ((buf) * 64 + row) * LS + c16 * 8) = v;                         \
    }                                                                                                  \
  }
    if (!SAMPLE) KV_GLOAD(0);
  __syncthreads();
  {
    unsigned* hist = (unsigned*)(smem + w * 8192);
    float* candv = (float*)(smem + w * 8192 + 4096);
    int* candi = (int*)(smem + w * 8192 + 4096 + 1024);
    constexpr int SNR = SAMPLE ? 33 : 32;
    float vpre[SNR];
    if (!SAMPLE && nkeys > 256) {
#pragma unroll
      for (int i = 0; i < SNR; ++i) {
        const int e = 64 * i + lane;
        vpre[i] = (e < nkeys) ? sc[(size_t)(4 * w) * scs + e] : -INFINITY;
      }
    } else {
#pragma unroll
      for (int i = 0; i < SNR; ++i) vpre[i] = 0.f;
    }
#pragma unroll 1
    for (int qw = 0; qw < 4; ++qw) {
      const int ql = 4 * w + qw;
      wave_select<SNR, SAMPLE ? 2 : 1>(sc + (size_t)ql * scs, nkeys, sMask + ql * MASK_W, hist, candv, candi, lane, vpre,
                                      (qw < 3) ? sc + (size_t)(ql + 1) * scs : (const float*)nullptr);
    }
  }
  __syncthreads();
  {
    const float bias_far = sBias[15 * 8 + head];
    f16v O[2];
#pragma unroll
    for (int dt = 0; dt < 2; ++dt)
#pragma unroll
      for (int i = 0; i < 16; ++i) O[dt][i] = 0.f;
    float m = -1.0e29f, l = 0.f;
    if (SAMPLE) { DSA_QLOAD; KV_GLOAD(0); }
#undef DSA_QLOAD
#pragma unroll
    for (int t = 0; t < 4; ++t) pin8(qf[t]);
    KV_SSTORE(0, 0);
    __syncthreads();
    int buf = 0;
    for (int kt = 0; kt < NT; ++kt) {
      if (kt + 1 < NT) KV_GLOAD(kt + 1);
      const h16* ka_ptr = sKb + buf * 64 * LS + 64 * kv + r * LS + 8 * hh;
      const h16* vb_ptr = sVb + buf * 64 * LS + 64 * kv + (4 * hh + q4) * LS + 16 * blk + 4 * p4;
      const bool nearb = (qpos0 - (kt * 64 + 63)) < 91;
      const unsigned mw0 = sMask[ql * MASK_W + kt * 2] >> (4 * hh);
      const unsigned mw1 = sMask[ql * MASK_W + kt * 2 + 1] >> (4 * hh);
      f16v S0, S1;
      const int nb = __float_as_int(NEGBIG);
      const int im0 = (int)~mw0, im1 = (int)~mw1;
      const float boff = nearb ? 0.f : bias_far;
      MASKINIT16(S0, im0, nb);
      MASKINIT16(S1, im1, nb);
      asm volatile("s_nop 1");
      if (nearb) {
        const float* bt = sBT + (kt * 64 + 4 * hh - pq + 185) * 8 + head;
#pragma unroll
        for (int i = 0; i < 16; ++i) {
          S0[i] += bt[((i & 3) + 8 * (i >> 2)) * 8];
          S1[i] += bt[(32 + (i & 3) + 8 * (i >> 2)) * 8];
        }
      }
      {
        h8 ka0[2], ka1[2];
#pragma unroll
        for (int t = 0; t < 2; ++t) {
          ka0[t] = *(const h8*)(ka_ptr + 16 * t);
          ka1[t] = *(const h8*)(ka_ptr + 32 * LS + 16 * t);
        }
#pragma unroll
        for (int t = 0; t < 4; ++t) {
          S0 = MFMA32(ka0[t & 1], qf[t], S0);
          S1 = MFMA32(ka1[t & 1], qf[t], S1);
          if (t + 2 < 4) {
            ka0[t & 1] = *(const h8*)(ka_ptr + 16 * (t + 2));
            ka1[t & 1] = *(const h8*)(ka_ptr + 32 * LS + 16 * (t + 2));
          }
        }
      }
      h8 vf[4];
#define DSA_VLOAD(f)                                                                              \
  {                                                                                               \
    const h16* vp = vb_ptr + ((((f) >> 2) * 32) + ((((f) >> 1) & 1) * 16)) * LS + 32 * ((f) & 1); \
    vf[(f) & 3] = cat8(trread(vp), trread(vp + 8 * LS));                                          \
  }
#pragma unroll
      for (int f = 0; f < 4; ++f) DSA_VLOAD(f);
      mfma_settle();
      float mx = max3f(S0[0], S0[1], S1[0]);
      mx = max3f(mx, S1[1], S0[2]);
#pragma unroll
      for (int i = 2; i < 15; ++i) mx = max3f(mx, S1[i], S0[i + 1]);
      mx = fmaxf(mx, S1[15]);
      mx = xhalf_max(mx) + boff;
      if (__any(mx > m + RESC_T)) {
        const float mn = fmaxf(m, mx);
        const float alpha = fast_exp2(m - mn);
        m = mn;
        l *= alpha;
#pragma unroll
        for (int dt = 0; dt < 2; ++dt)
#pragma unroll
          for (int i = 0; i < 16; ++i) O[dt][i] *= alpha;
      }
      {
        const float msub = m - boff;
        const f2v m2 = {msub, msub};
        f2v rs2 = {0.f, 0.f};
#pragma unroll
        for (int i = 0; i < 16; i += 2) {
          f2v a = {S0[i], S0[i + 1]};
          f2v c = {S1[i], S1[i + 1]};
          a -= m2; c -= m2;
          a[0] = fast_exp2(a[0]); a[1] = fast_exp2(a[1]);
          c[0] = fast_exp2(c[0]); c[1] = fast_exp2(c[1]);
          rs2 += a; rs2 += c;
          S0[i] = a[0]; S0[i + 1] = a[1]; S1[i] = c[0]; S1[i + 1] = c[1];
        }
        l += rs2[0] + rs2[1];
      }
      h8 pb[4];
#pragma unroll
      for (int gg = 0; gg < 4; ++gg)
#pragma unroll
        for (int jj = 0; jj < 8; ++jj) pb[gg][jj] = (h16)((gg < 2) ? S0[8 * (gg & 1) + jj] : S1[8 * (gg & 1) + jj]);
#pragma unroll
      for (int f = 0; f < 8; ++f) {
        O[f & 1] = MFMA32(vf[f & 3], pb[f >> 1], O[f & 1]);
        if (f + 4 < 8) DSA_VLOAD(f + 4);
      }
#undef DSA_VLOAD
      if (kt + 1 < NT) KV_SSTORE(kt + 1, buf ^ 1);
      __syncthreads();
      buf ^= 1;
    }
#undef KV_GLOAD
#undef KV_SSTORE
    if (threadIdx.x == 0) nxt = (int)atomicAdd(ctr, 1u);
    const float inv = 1.f / (l + __shfl_xor(l, 32));
    h16* Ot = (h16*)smem + w * (8 * 264);
    {
      const int q8 = r >> 2;
#pragma unroll
      for (int dt = 0; dt < 2; ++dt) {
#pragma unroll
        for (int g4 = 0; g4 < 4; ++g4) {
          h4 o;
#pragma unroll
          for (int j = 0; j < 4; ++j) o[j] = (h16)(O[dt][4 * g4 + j] * inv);
          *(h4*)(Ot + q8 * 264 + g * 64 + 32 * dt + 8 * g4 + 4 * hh) = o;
        }
      }
    }
    wavebar();
#pragma unroll
    for (int i = 0; i < 4; ++i) {
      const int q = lane + 64 * i;
      const int row = q >> 5, ch = q & 31;
      const int tk = tok0 + 8 * (w & 3) + row;
      const h8 y = *(const h8*)(Ot + row * 264 + ch * 8);
      const h8 gb = *(const h8*)(p.GB + (size_t)tk * 512 + kv * 256 + ch * 8);
      h8 o;
#pragma unroll
      for (int j = 0; j < 8; ++j) o[j] = (h16)((float)y[j] * (float)gb[j]);
      *(h8*)(p.mix + (size_t)tk * 1024 + 512 + kv * 256 + ch * 8) = o;
    }
  }
  __syncthreads();
}

#define ITEMS_PER_Q 136
DI void phase2(const P& p, char* smem, int cidx = 0) {
  volatile int& s_item = *(volatile int*)(smem + SMEM_BYTES - 16);
  const int xq = blockIdx.x & 7;
  unsigned* ctr = &p.counters[cidx * 8 + xq];
  if (threadIdx.x == 0) s_item = (int)atomicAdd(ctr, 1u);
  __syncthreads();
  int item = s_item;
  while (item < ITEMS_PER_Q) {
    int nxt = 0;
    const int tid = opaque_tid();
    if (item < 4) {
      const int b = xq + 8 * item;
      mla_item<true>(p, b, NP + b * 32, SKEYS, smem, tid, ctr, nxt);
    } else if (item < 8) {
      const int b = xq + 8 * (item - 4);
      dsa_item<true>(p, b, NP + b * 32, PAST, SKEYS, p.scS + (size_t)b * 32 * SC_STRIDE_S, SC_STRIDE_S, smem, tid, ctr, nxt);
    } else {
      const int k = item - 8;
      const int kind = k & 1, sub = (k >> 1) & 1, b = xq, c = 31 - (k >> 2);
      const int tok0 = b * 2048 + c * 64 + sub * 32;
      const int nkeys = 64 * (c + 1);
      if (kind == 0) mla_item<false>(p, b, tok0, nkeys, smem, tid, ctr, nxt);
      else dsa_item<false>(p, b, tok0, c * 64 + sub * 32, nkeys, p.scP + (size_t)blockIdx.x * 32 * SC_STRIDE_P,
                           SC_STRIDE_P, smem, tid, ctr, nxt);
    }
    if (threadIdx.x == 0) s_item = nxt;
    __syncthreads();
    item = s_item;
    __syncthreads();
  }
}

template <int BM>
DI void p3_epilogue(const P& p, const h16* T, int m0, int n0) {
  constexpr int TS = 136;
  const int tid = opaque_tid();
  constexpr int NIT = BM / 32;
  float4 x0[NIT], x1[NIT];
#pragma unroll
  for (int it = 0; it < NIT; ++it) {
    const int q = tid + NBLK_THREADS * it;
    const int m = m0 + (q >> 4), n = n0 + (q & 15) * 8;
    const float* xr = (m < NP ? p.x_p + (size_t)m * DM : p.x_s + (size_t)(m - NP) * DM) + n;
    x0[it] = *(const float4*)xr; x1[it] = *(const float4*)(xr + 4);
  }
#pragma unroll
  for (int it = 0; it < NIT; ++it) {
    const int q = tid + NBLK_THREADS * it;
    const int row = q >> 4, ch = q & 15;
    const int m = m0 + row, n = n0 + ch * 8;
    const h8 v = *(const h8*)(T + row * TS + ch * 8);
    h8 o;
    o[0] = (h16)(x0[it].x + (float)v[0]); o[1] = (h16)(x0[it].y + (float)v[1]);
    o[2] = (h16)(x0[it].z + (float)v[2]); o[3] = (h16)(x0[it].w + (float)v[3]);
    o[4] = (h16)(x1[it].x + (float)v[4]); o[5] = (h16)(x1[it].y + (float)v[5]);
    o[6] = (h16)(x1[it].z + (float)v[6]); o[7] = (h16)(x1[it].w + (float)v[7]);
    *(h8*)(p.XN + (size_t)m * DM + n) = o;
  }
}
DI void phase3(const P& p, char* smem) {
  constexpr int TS = 136;
  h16* T = (h16*)smem;
  for (int tile = blockIdx.x; tile < 256; tile += gridDim.x) {
    const int xcd = tile & 7, idx = tile >> 3;
    const int mt = xcd * 8 + (idx >> 2), pn = idx & 3;
    const int m0 = mt * 256;
    f32x4 acc[2][2][4][2];
    gemm8_mainloop(p.mix, p.Wt_out, DM, m0, pn * 256, smem, acc);
    __syncthreads();
    const int tid = opaque_tid();
    const int wid = tid >> 6, lane = tid & 63, wr = wid >> 2, wc = wid & 3, fr = lane & 15, fq = lane >> 4;
#pragma unroll
    for (int bj = 0; bj < 2; ++bj) {
#pragma unroll
      for (int ai = 0; ai < 2; ++ai)
#pragma unroll
        for (int m = 0; m < 4; ++m)
#pragma unroll
          for (int n = 0; n < 2; ++n)
          {
            h4 o;
#pragma unroll
            for (int jj = 0; jj < 4; ++jj) o[jj] = (h16)acc[ai][bj][m][n][jj];
            *(h4*)(T + (ai * 128 + wr * 64 + m * 16 + fr) * TS + wc * 32 + n * 16 + fq * 4) = o;
          }
      __syncthreads();
      p3_epilogue<256>(p, T, m0, pn * 256 + bj * 128);
      __syncthreads();
    }
  }
  for (int tile = blockIdx.x; tile < 128; tile += gridDim.x) {
    const int m0 = NP + (tile >> 3) * 64, n0 = (tile & 7) * 128;
    gemm_tile<64, 128, 2, 4>(p.mix, 1024, p.Wt_out, 1024, 1024, m0, n0, smem);
    p3_epilogue<64>(p, T, m0, n0);
    __syncthreads();
  }
}

DI void phase4(const P& p) {
  const int tid = opaque_tid(), lane = tid & 63, w = tid >> 6;
  const int gw = blockIdx.x * 8 + w, nw = gridDim.x * 8;
  for (int k0 = 0; gw + nw * k0 < NTOK; k0 += 5) {
    h4 v[5][4];
    float ss[5];
#pragma unroll
    for (int rr = 0; rr < 5; ++rr) {
      const int row = gw + nw * (k0 + rr);
#pragma unroll
      for (int k = 0; k < 4; ++k) {
        if (row < NTOK) v[rr][k] = *(const h4*)(p.XN + (size_t)row * DM + 4 * lane + 256 * k);
        else { v[rr][k][0] = (h16)0.f; v[rr][k][1] = (h16)0.f; v[rr][k][2] = (h16)0.f; v[rr][k][3] = (h16)0.f; }
      }
    }
#pragma unroll
    for (int rr = 0; rr < 5; ++rr) {
      float a = 0.f;
#pragma unroll
      for (int k = 0; k < 4; ++k)
#pragma unroll
        for (int e = 0; e < 4; ++e) a += (float)v[rr][k][e] * (float)v[rr][k][e];
      ss[rr] = a;
    }
#pragma unroll
    for (int off = 32; off > 0; off >>= 1) {
#pragma unroll
      for (int rr = 0; rr < 5; ++rr) ss[rr] += __shfl_xor(ss[rr], off);
    }
    float4 g[4];
#pragma unroll
    for (int k = 0; k < 4; ++k) g[k] = *(const float4*)(p.fn_g + 4 * lane + 256 * k);
#pragma unroll
    for (int rr = 0; rr < 5; ++rr) {
      const int row = gw + nw * (k0 + rr);
      if (row < NTOK) {
        const float rstd = rsqrtf(ss[rr] * (1.f / 1024.f) + 1e-6f);
        float* o = p.out + (size_t)row * DM;
#pragma unroll
        for (int k = 0; k < 4; ++k)
          *(float4*)(o + 4 * lane + 256 * k) = make_float4((float)v[rr][k][0] * rstd * g[k].x, (float)v[rr][k][1] * rstd * g[k].y,
                                                           (float)v[rr][k][2] * rstd * g[k].z, (float)v[rr][k][3] * rstd * g[k].w);
      }
    }
  }
}

__global__ void __launch_bounds__(NBLK_THREADS) mega_kernel(P p) {
  __shared__ __attribute__((aligned(16))) char smem[SMEM_BYTES];
  XBar xb;
  xb.w = p.counters;
  xb.x = (unsigned)__builtin_amdgcn_s_getreg((3 << 11) | 20) & 0xFu;
  xb.nloc = 0u; xb.nx = 0u;
  if (threadIdx.x == 0) __hip_atomic_fetch_add(&xb.w[XB_CNT(xb.x)], 1u, __ATOMIC_RELAXED, __HIP_MEMORY_SCOPE_AGENT);
  phase0(p, smem);
  xcd_barrier(xb, 1u, smem);
  phase1(p, smem);
  xcd_barrier(xb, 2u, smem);
  phase1b(p, smem);
  xcd_barrier(xb, 3u, smem);
  phase2(p, smem);
  xcd_barrier(xb, 4u, smem);
  phase3(p, smem);
  xcd_barrier(xb, 5u, smem);
  phase4(p);
}

extern "C" void kernel_launch(void* const* d_in, const int* in_sizes, int n_in, void* d_out, int out_size, void* d_ws,
                              size_t ws_size, hipStream_t stream) {
  P p{};
  p.x_p = (const float*)d_in[0];
  p.x_s = (const float*)d_in[1];
  p.c_ckv = (const float*)d_in[2];
  p.c_kpe = (const float*)d_in[3];
  p.c_k = (const float*)d_in[4];
  p.c_v = (const float*)d_in[5];
  p.c_kidx = (const float*)d_in[6];
  p.norm_g = (const float*)d_in[7];
  p.w_in = (const float*)d_in[8];
  p.qn_g = (const float*)d_in[9];
  p.kvn_g = (const float*)d_in[10];
  p.w_uq = (const float*)d_in[11];
  p.w_uk = (const float*)d_in[12];
  p.w_uv = (const float*)d_in[13];
  p.rel_bias = (const float*)d_in[14];
  p.w_out = (const float*)d_in[15];
  p.fn_g = (const float*)d_in[16];
  p.out = (float*)d_out;

  char* ws = (char*)d_ws;
  size_t off = 0;
  auto carve = [&](size_t bytes) {
    char* r = ws + off;
    off += (bytes + 255) & ~(size_t)255;
    return r;
  };
  p.counters = (unsigned*)carve(XB_WORDS * 4);
  p.hX = (h16*)carve((size_t)NTOK * DM * 2);
  p.mix = p.hX;
  p.scP = (float*)carve((size_t)256 * 32 * SC_STRIDE_P * 4);
  p.CQ = (h16*)carve((size_t)NTOK * 256 * 2);
  p.Wt_in = (h16*)carve((size_t)INWP * DM * 2);
  p.Wt_out = (h16*)carve((size_t)DM * DM * 2);
  p.Wq = (h16*)carve((size_t)1280 * 256 * 2);
  p.Wuv = (h16*)carve((size_t)8 * 64 * 128 * 2);
  p.QM = (h16*)carve((size_t)NTOK * 1280 * 2);
  p.XN = (h16*)carve((size_t)NTOK * DM * 2);
  p.KM = (h16*)carve((size_t)NTOK * 160 * 2);
  p.GA = (h16*)carve((size_t)NTOK * 512 * 2);
  p.GB = (h16*)carve((size_t)NTOK * 512 * 2);
  p.QB = (h16*)carve((size_t)NTOK * 512 * 2);
  p.KB = (h16*)carve((size_t)NTOK * 128 * 2);
  p.VB = (h16*)carve((size_t)NTOK * 128 * 2);
  p.QI = (h16*)carve((size_t)NTOK * 512 * 2);
  p.KI = (h16*)carve((size_t)NTOK * 64 * 2);
  p.WI = (float*)carve((size_t)NTOK * 8 * 4);
  p.RQP = (float*)carve((size_t)NTOK * 2 * 4);
  p.ropeC = (float*)carve((size_t)2080 * 16 * 4);
  p.ropeS = (float*)carve((size_t)2080 * 16 * 4);
  p.scS = (float*)carve((size_t)32 * 32 * SC_STRIDE_S * 4);
  if (off > ws_size) {
    fprintf(stderr, "workspace too small: need %zu have %zu\n", off, ws_size);
    return;
  }
  static int grid_blocks = 0;
  if (!grid_blocks) {
    int dev = 0, cus = 0, per_cu = 0;
    hipGetDevice(&dev);
    hipDeviceGetAttribute(&cus, hipDeviceAttributeMultiprocessorCount, dev);
    hipOccupancyMaxActiveBlocksPerMultiprocessor(&per_cu, mega_kernel, NBLK_THREADS, 0);
    if (per_cu > 1) per_cu = 1;
    grid_blocks = cus * per_cu;
    if (grid_blocks > 256) grid_blocks = 256;
  }
  hipMemsetAsync(p.counters, 0, XB_WORDS * 4, stream);
  hipLaunchKernelGGL(mega_kernel, dim3(grid_blocks), dim3(NBLK_THREADS), 0, stream, p);
}
```

```cpp
#include <hip/hip_runtime.h>
#include <stdint.h>
#include <stdio.h>

typedef _Float16 h16;
typedef h16 h8 __attribute__((ext_vector_type(8)));
typedef h16 h4 __attribute__((ext_vector_type(4)));
typedef h16 h2 __attribute__((ext_vector_type(2)));
typedef float f16v __attribute__((ext_vector_type(16)));
typedef short s4v __attribute__((vector_size(8)));
typedef __attribute__((address_space(3))) s4v* lds_s4p;

#define DI __device__ __forceinline__
#define MFMA32(a, b, c) __builtin_amdgcn_mfma_f32_32x32x16_f16((a), (b), (c), 0, 0, 0)

#define NTOK 17408
#define NP 16384
#define DM 1024
#define INW 2792
#define INWP 2816
#define PAST 4096
#define SKEYS 4128
#define NBLK_THREADS 512

#define OFF_Y 0
#define OFF_P_CKV 17825792
#define OFF_P_KPE 19922944
#define OFF_P_K 20447232
#define OFF_P_V 22544384
#define OFF_P_KIDX 24641536
#define OFF_S_CKV 25690112
#define OFF_S_KPE 25821184
#define OFF_S_K 25853952
#define OFF_S_V 25985024
#define OFF_S_KIDX 26116096

#define ZC_CQ 0
#define ZC_CKV 256
#define ZC_KPE 384
#define ZC_GA 416
#define ZC_QB 928
#define ZC_KB 1440
#define ZC_VB 1568
#define ZC_QI 1696
#define ZC_KI 2208
#define ZC_WI 2272
#define ZC_GB 2280

#define LOG2E 1.4426950408889634f
#define QM_SCALE 0.14724444602590306f
#define QB_SCALE 0.18033688011112042f
#define WI_SCALE 0.04419417382415922f
#define NEGBIG (-1.0e30f)
#define RESC_T 8.0f

#define SMEM_BYTES 131072
#define SC_STRIDE_P 2048
#define SC_STRIDE_S 4160
#define MASK_W 132
#define N_ITEMS 1088

struct P {
  const float *x_p, *x_s, *c_ckv, *c_kpe, *c_k, *c_v, *c_kidx, *norm_g, *w_in, *qn_g, *kvn_g, *w_uq, *w_uk, *w_uv,
      *rel_bias, *w_out, *fn_g;
  float* out;
  h16 *hX, *CQ, *Wt_in, *Wt_out, *Wq, *Wuv, *QM, *KM, *GA, *GB, *QB, *KB, *VB, *QI, *KI, *mix, *XN;
  float *WI, *ropeC, *ropeS, *scP, *scS, *RQP;
  unsigned* counters;
};

DI int crow(int i, int hh) { return (i & 3) + 8 * (i >> 2) + 4 * hh; }
DI float wave_sum(float v) {
#pragma unroll
  for (int off = 32; off > 0; off >>= 1) v += __shfl_xor(v, off);
  return v;
}
DI float wave_max(float v) {
#pragma unroll
  for (int off = 32; off > 0; off >>= 1) v = fmaxf(v, __shfl_xor(v, off));
  return v;
}
DI float wave_min(float v) {
#pragma unroll
  for (int off = 32; off > 0; off >>= 1) v = fminf(v, __shfl_xor(v, off));
  return v;
}
DI h4 trread(const h16* p) {
  s4v r = __builtin_amdgcn_ds_read_tr16_b64_v4i16((lds_s4p)(p));
  return __builtin_bit_cast(h4, r);
}
DI h8 cat8(h4 a, h4 b) { return __builtin_shufflevector(a, b, 0, 1, 2, 3, 4, 5, 6, 7); }
typedef __attribute__((address_space(3))) h8* lds_h8p;
typedef __attribute__((address_space(3))) const char* lds_ccp;
DI unsigned lds_off(const void* p) { return (unsigned)(uintptr_t)(lds_ccp)p; }
DI h8 lds_ld8(unsigned a) { return *(lds_h8p)(uintptr_t)a; }
DI h4 lds_tr(unsigned a) { return __builtin_bit_cast(h4, __builtin_amdgcn_ds_read_tr16_b64_v4i16((lds_s4p)(uintptr_t)a)); }
DI unsigned opaque_u(unsigned x) { asm volatile("" : "+v"(x)); return x; }
DI h8 cvt8(float4 a, float4 b) {
  h8 r;
  r[0] = (h16)a.x; r[1] = (h16)a.y; r[2] = (h16)a.z; r[3] = (h16)a.w;
  r[4] = (h16)b.x; r[5] = (h16)b.y; r[6] = (h16)b.z; r[7] = (h16)b.w;
  return r;
}
DI h8 zero8() { h8 r; for (int i = 0; i < 8; ++i) r[i] = (h16)0.f; return r; }
DI float fast_exp2(float x) { return __builtin_amdgcn_exp2f(x); }
DI float silu(float x) { return x * __builtin_amdgcn_rcpf(1.f + __expf(-x)); }
DI int rope_idx(int t) { return t < NP ? (t & 2047) : 2048 + ((t - NP) & 31); }
DI int opaque_tid() { int t = threadIdx.x; asm volatile("" : "+v"(t)); return t; }
#define XB_CNT(x) (256 + 64 * (x))
#define XB_ARR(x) (256 + 64 * (16 + (x)))
#define XB_GEN(x) (256 + 64 * (32 + (x)))
#define XB_TOP (256 + 64 * 48)
#define XB_WORDS (256 + 64 * 49)
DI unsigned xb_ld(unsigned* q) { return __hip_atomic_load(q, __ATOMIC_RELAXED, __HIP_MEMORY_SCOPE_AGENT); }
struct XBar { unsigned* w; unsigned x, nloc, nx; };
DI void xcd_barrier(XBar& xb, unsigned k, char* smem) {
  asm volatile("s_waitcnt vmcnt(0)" ::: "memory");
  __syncthreads();
  volatile unsigned* bc = (volatile unsigned*)(smem + SMEM_BYTES - 64);
  if (threadIdx.x == 0) {
    if (k == 1u) {
      const unsigned G = gridDim.x;
      unsigned sum, nxx;
      do {
        sum = 0u; nxx = 0u;
        for (int j = 0; j < 16; ++j) { const unsigned c = xb_ld(&xb.w[XB_CNT(j)]); sum += c; nxx += (c != 0u); }
        if (sum != G) __builtin_amdgcn_s_sleep(2);
      } while (sum != G);
      bc[0] = xb_ld(&xb.w[XB_CNT(xb.x)]);
      bc[1] = nxx;
    }
  }
  if (k == 1u) {
    __syncthreads();
    xb.nloc = (unsigned)__builtin_amdgcn_readfirstlane((int)bc[0]);
    xb.nx = (unsigned)__builtin_amdgcn_readfirstlane((int)bc[1]);
  }
  if (threadIdx.x == 0) {
    const unsigned old = __hip_atomic_fetch_add(&xb.w[XB_ARR(xb.x)], 1u, __ATOMIC_RELAXED, __HIP_MEMORY_SCOPE_AGENT);
    if (old + 1u == k * xb.nloc) {
      __builtin_amdgcn_fence(__ATOMIC_RELEASE, "agent");
      asm volatile("s_waitcnt vmcnt(0)" ::: "memory");
      __hip_atomic_fetch_add(&xb.w[XB_TOP], 1u, __ATOMIC_RELAXED, __HIP_MEMORY_SCOPE_AGENT);
      while (xb_ld(&xb.w[XB_TOP]) < k * xb.nx) __builtin_amdgcn_s_sleep(1);
      __hip_atomic_store(&xb.w[XB_GEN(xb.x)], k, __ATOMIC_RELAXED, __HIP_MEMORY_SCOPE_AGENT);
    } else {
      while (xb_ld(&xb.w[XB_GEN(xb.x)]) < k) __builtin_amdgcn_s_sleep(1);
    }
    __builtin_amdgcn_fence(__ATOMIC_ACQUIRE, "agent");
    asm volatile("s_waitcnt vmcnt(0)" ::: "memory");
  }
  __syncthreads();
}
DI void grid_barrier(unsigned* bar, unsigned target) {
  asm volatile("s_waitcnt vmcnt(0)" ::: "memory");
  __syncthreads();
  if (threadIdx.x == 0) {
    __builtin_amdgcn_fence(__ATOMIC_RELEASE, "agent");
    asm volatile("s_waitcnt vmcnt(0)" ::: "memory");
    __hip_atomic_fetch_add(bar, 1u, __ATOMIC_RELAXED, __HIP_MEMORY_SCOPE_AGENT);
    while (__hip_atomic_load(bar, __ATOMIC_RELAXED, __HIP_MEMORY_SCOPE_AGENT) < target) __builtin_amdgcn_s_sleep(2);
    __builtin_amdgcn_fence(__ATOMIC_ACQUIRE, "agent");
    asm volatile("s_waitcnt vmcnt(0)" ::: "memory");
  }
  __syncthreads();
}
typedef float f2v __attribute__((ext_vector_type(2)));
DI float max3f(float a, float b, float c) {
  float d;
  asm("v_max3_f32 %0, %1, %2, %3" : "=v"(d) : "v"(a), "v"(b), "v"(c));
  return d;
}
DI float xhalf_max(float x) {
  const auto r = __builtin_amdgcn_permlane32_swap(__float_as_uint(x), __float_as_uint(x), false, false);
  float d;
  asm("v_max_f32 %0, %1, %2" : "=v"(d) : "v"(__uint_as_float(r[0])), "v"(__uint_as_float(r[1])));
  return d;
}
DI void mfma_settle() {
  __builtin_amdgcn_sched_barrier(0);
  asm volatile("s_nop 7\n\ts_nop 7");
  __builtin_amdgcn_sched_barrier(0);
}
DI float relu1(float x) { float d; asm("v_max_f32 %0, 0, %1" : "=v"(d) : "v"(x)); return d; }
#define MASKINIT(dst, im, BIT, nbv) asm volatile("v_bfe_i32 %0, %1, " #BIT ", 1\n\tv_and_b32 %0, %0, %2" : "=&v"(dst) : "v"(im), "v"(nbv))
#define MASKINIT16(S, im, nbv)                                                                                  \
  { float _t;                                                                                                   \
    MASKINIT(_t, im, 0, nbv); S[0] = _t; MASKINIT(_t, im, 1, nbv); S[1] = _t; MASKINIT(_t, im, 2, nbv); S[2] = _t;     \
    MASKINIT(_t, im, 3, nbv); S[3] = _t; MASKINIT(_t, im, 8, nbv); S[4] = _t; MASKINIT(_t, im, 9, nbv); S[5] = _t;     \
    MASKINIT(_t, im, 10, nbv); S[6] = _t; MASKINIT(_t, im, 11, nbv); S[7] = _t; MASKINIT(_t, im, 16, nbv); S[8] = _t;  \
    MASKINIT(_t, im, 17, nbv); S[9] = _t; MASKINIT(_t, im, 18, nbv); S[10] = _t; MASKINIT(_t, im, 19, nbv); S[11] = _t; \
    MASKINIT(_t, im, 24, nbv); S[12] = _t; MASKINIT(_t, im, 25, nbv); S[13] = _t; MASKINIT(_t, im, 26, nbv); S[14] = _t; \
    MASKINIT(_t, im, 27, nbv); S[15] = _t; }
DI void pin8(const h8& v) { asm volatile("" ::"v"(v)); }
DI void pinf(const float& v) { asm volatile("" ::"v"(v)); }
DI void wavebar() { asm volatile("s_waitcnt lgkmcnt(0)" ::: "memory"); }

__constant__ float c_inv_freq[16] = {1.000000000e+00f, 5.623413324e-01f, 3.162277639e-01f, 1.778279394e-01f,
                                     1.000000015e-01f, 5.623413250e-02f, 3.162277490e-02f, 1.778279431e-02f,
                                     9.999999776e-03f, 5.623413250e-03f, 3.162277630e-03f, 1.778279431e-03f,
                                     1.000000047e-03f, 5.623413017e-04f, 3.162277571e-04f, 1.778279402e-04f};

DI void sincos_acc(float angf, float* so, float* co) {
  const double a = (double)angf;
  const double q = rint(a * 0.6366197723675814);
  double t = fma(-q, 1.5707963267948966, a);
  t = fma(-q, 6.123233995736766e-17, t);
  const int qi = ((int)q) & 3;
  const double t2 = t * t;
  double sn = -1.0 / 1307674368000.0;
  sn = fma(sn, t2, 1.0 / 6227020800.0);
  sn = fma(sn, t2, -1.0 / 39916800.0);
  sn = fma(sn, t2, 1.0 / 362880.0);
  sn = fma(sn, t2, -1.0 / 5040.0);
  sn = fma(sn, t2, 1.0 / 120.0);
  sn = fma(sn, t2, -1.0 / 6.0);
  sn = fma(sn * t2, t, t);
  double cs = 1.0 / 20922789888000.0;
  cs = fma(cs, t2, -1.0 / 87178291200.0);
  cs = fma(cs, t2, 1.0 / 479001600.0);
  cs = fma(cs, t2, -1.0 / 3628800.0);
  cs = fma(cs, t2, 1.0 / 40320.0);
  cs = fma(cs, t2, -1.0 / 720.0);
  cs = fma(cs, t2, 1.0 / 24.0);
  cs = fma(cs, t2, -0.5);
  cs = fma(cs, t2, 1.0);
  double s, c;
  if (qi == 0) { s = sn; c = cs; }
  else if (qi == 1) { s = cs; c = -sn; }
  else if (qi == 2) { s = -sn; c = -cs; }
  else { s = -cs; c = sn; }
  *so = (float)s; *co = (float)c;
}

DI void transpose_to_h(const float* __restrict__ src, int K, int N, int Npad, h16* __restrict__ dst, char* smem) {
  float* tile = (float*)smem;
  const int tid = opaque_tid();
  const int ktn = K / 64, ntn = Npad / 64;
  for (int tix = blockIdx.x; tix < ktn * ntn; tix += gridDim.x) {
    const int k0 = (tix / ntn) * 64, n0 = (tix % ntn) * 64;
    {
      const int nn = tid & 63;
#pragma unroll
      for (int i = 0; i < 8; ++i) {
        const int kk = (tid >> 6) + 8 * i;
        const int n = n0 + nn;
        tile[kk * 65 + nn] = (n < N) ? src[(size_t)(k0 + kk) * N + n] : 0.f;
      }
    }
    __syncthreads();
    {
      const int kk = tid & 63;
#pragma unroll
      for (int i = 0; i < 8; ++i) {
        const int nn = (tid >> 6) + 8 * i;
        dst[(size_t)(n0 + nn) * K + k0 + kk] = (h16)tile[kk * 65 + nn];
      }
    }
    __syncthreads();
  }
}

DI void phase0(const P& p, char* smem) {
  const int tid = opaque_tid(), lane = tid & 63, w = tid >> 6;
  const int gw = blockIdx.x * 8 + w, nw = gridDim.x * 8;
  const int gt = blockIdx.x * NBLK_THREADS + tid, nt = gridDim.x * NBLK_THREADS;
  for (int k0 = 0; gw + nw * k0 < NTOK; k0 += 5) {
    float4 v[5][4];
    float ss[5];
#pragma unroll
    for (int rr = 0; rr < 5; ++rr) {
      const int row = gw + nw * (k0 + rr);
      if (row < NTOK) {
        const float* x = row < NP ? p.x_p + (size_t)row * DM : p.x_s + (size_t)(row - NP) * DM;
#pragma unroll
        for (int i = 0; i < 4; ++i) v[rr][i] = ((const float4*)x)[lane + 64 * i];
      } else {
#pragma unroll
        for (int i = 0; i < 4; ++i) v[rr][i] = make_float4(0.f, 0.f, 0.f, 0.f);
      }
    }
#pragma unroll
    for (int rr = 0; rr < 5; ++rr) {
      float a = 0.f;
#pragma unroll
      for (int i = 0; i < 4; ++i)
        a += v[rr][i].x * v[rr][i].x + v[rr][i].y * v[rr][i].y + v[rr][i].z * v[rr][i].z + v[rr][i].w * v[rr][i].w;
      ss[rr] = a;
    }
#pragma unroll
    for (int off = 32; off > 0; off >>= 1) {
#pragma unroll
      for (int rr = 0; rr < 5; ++rr) ss[rr] += __shfl_xor(ss[rr], off);
    }
    float4 g[4];
#pragma unroll
    for (int i = 0; i < 4; ++i) g[i] = ((const float4*)p.norm_g)[lane + 64 * i];
#pragma unroll
    for (int rr = 0; rr < 5; ++rr) {
      const int row = gw + nw * (k0 + rr);
      if (row < NTOK) {
        const float rstd = rsqrtf(ss[rr] * (1.f / 1024.f) + 1e-6f);
#pragma unroll
        for (int i = 0; i < 4; ++i) {
          h4 o;
          o[0] = (h16)(v[rr][i].x * rstd * g[i].x); o[1] = (h16)(v[rr][i].y * rstd * g[i].y);
          o[2] = (h16)(v[rr][i].z * rstd * g[i].z); o[3] = (h16)(v[rr][i].w * rstd * g[i].w);
          *(h4*)(p.hX + (size_t)row * DM + (lane + 64 * i) * 4) = o;
        }
      }
    }
  }
  transpose_to_h(p.w_in, 1024, INW, INWP, p.Wt_in, smem);
  transpose_to_h(p.w_out, 1024, 1024, 1024, p.Wt_out, smem);
  for (int wt = gw; wt < 256; wt += nw) {
    const int hd = wt >> 5, k0 = ((wt >> 2) & 7) * 32, c0 = (wt & 3) * 32;
    const int r = lane & 31, hh = lane >> 5;
    f16v D;
#pragma unroll
    for (int i = 0; i < 16; ++i) D[i] = 0.f;
#pragma unroll
    for (int t = 0; t < 4; ++t) {
      const float* ap = p.w_uq + (size_t)(k0 + r) * 768 + hd * 96 + 16 * t + 8 * hh;
      const float* bp = p.w_uk + (size_t)(c0 + r) * 512 + hd * 64 + 16 * t + 8 * hh;
      const h8 a = cvt8(*(const float4*)ap, *(const float4*)(ap + 4));
      const h8 bq = cvt8(*(const float4*)bp, *(const float4*)(bp + 4));
      D = MFMA32(a, bq, D);
    }
#pragma unroll
    for (int g4 = 0; g4 < 4; ++g4) {
      const int k = k0 + 8 * g4 + 4 * hh;
      const float4 g = *(const float4*)(p.qn_g + k);
      h4 o;
      o[0] = (h16)(D[4 * g4 + 0] * g.x); o[1] = (h16)(D[4 * g4 + 1] * g.y);
      o[2] = (h16)(D[4 * g4 + 2] * g.z); o[3] = (h16)(D[4 * g4 + 3] * g.w);
      *(h4*)(p.Wq + (size_t)(hd * 128 + c0 + r) * 256 + k) = o;
    }
  }
  for (int idx = gt; idx < 256 * 256; idx += nt) {
    const int n = 1024 + (idx >> 8), k = idx & 255;
    const int hd = (n - 1024) >> 5, rr = (n - 1024) & 31;
    p.Wq[(size_t)n * 256 + k] = (h16)(p.w_uq[(size_t)k * 768 + hd * 96 + 64 + rr] * p.qn_g[k]);
  }
  for (int idx = gt; idx < 8 * 64 * 128; idx += nt) {
    const int j = idx & 7, ln = (idx >> 3) & 63, sq = (idx >> 9) & 1, dt = (idx >> 10) & 3, vt = (idx >> 12) & 1, hd = idx >> 13;
    const int v = 32 * vt + (ln & 31);
    const int c = 32 * dt + 16 * sq + 8 * (j >> 2) + 4 * (ln >> 5) + (j & 3);
    p.Wuv[idx] = (h16)p.w_uv[(size_t)c * 512 + hd * 64 + v];
  }
  for (int idx = gt; idx < 2080 * 16; idx += nt) {
    const int pi = idx >> 4, j = idx & 15;
    const int pos = pi < 2048 ? pi : PAST + (pi - 2048);
    const float ang = (float)pos * c_inv_freq[j];
    float s, c;
    sincos_acc(ang, &s, &c);
    p.ropeC[idx] = c; p.ropeS[idx] = s;
  }
}

template <int BM, int BN, int WGM, int WGN>
DI void gemm_tile(const h16* __restrict__ A, int lda, const h16* __restrict__ B, int ldb, int K, int m0, int n0,
                  char* smem) {
  constexpr int LS = 72, TS = 136;
  constexpr int TM = BM / WGM, TN = BN / WGN, MI = TM / 32, NI = TN / 32;
  constexpr int ACH = BM * 8 / NBLK_THREADS, BCH = BN * 8 / NBLK_THREADS;
  h16* sA = (h16*)smem;
  h16* sB = sA + 2 * BM * LS;
  const int tid = opaque_tid(), lane = tid & 63, w = tid >> 6;
  const int wm = w / WGN, wn = w % WGN;
  const int r = lane & 31, hh = lane >> 5;
  f16v acc[MI][NI];
#pragma unroll
  for (int mi = 0; mi < MI; ++mi)
#pragma unroll
    for (int ni = 0; ni < NI; ++ni)
#pragma unroll
      for (int i = 0; i < 16; ++i) acc[mi][ni][i] = 0.f;
  h8 ra[ACH], rb[BCH];
  const int KT = K / 64;
#define GLOAD(kt)                                                                                   \
  {                                                                                                 \
    _Pragma("unroll") for (int i = 0; i < ACH; ++i) {                                               \
      const int q = tid + NBLK_THREADS * i;                                                         \
      ra[i] = *(const h8*)(A + (size_t)(m0 + (q >> 3)) * lda + (kt) * 64 + (q & 7) * 8);            \
    }                                                                                               \
    _Pragma("unroll") for (int i = 0; i < BCH; ++i) {                                               \
      const int q = tid + NBLK_THREADS * i;                                                         \
      rb[i] = *(const h8*)(B + (size_t)(n0 + (q >> 3)) * ldb + (kt) * 64 + (q & 7) * 8);            \
    }                                                                                               \
  }
#define SSTORE(buf)                                                                                 \
  {                                                                                                 \
    _Pragma("unroll") for (int i = 0; i < ACH; ++i) {                                               \
      const int q = tid + NBLK_THREADS * i;                                                         \
      *(h8*)(sA + ((buf) * BM + (q >> 3)) * LS + (q & 7) * 8) = ra[i];                              \
    }                                                                                               \
    _Pragma("unroll") for (int i = 0; i < BCH; ++i) {                                               \
      const int q = tid + NBLK_THREADS * i;                                                         \
      *(h8*)(sB + ((buf) * BN + (q >> 3)) * LS + (q & 7) * 8) = rb[i];                              \
    }                                                                                               \
  }
  GLOAD(0);
  SSTORE(0);
  __syncthreads();
  int buf = 0;
  for (int kt = 0; kt < KT; ++kt) {
    if (kt + 1 < KT) GLOAD(kt + 1);
    const h16* a_base = sA + (buf * BM + wm * TM + r) * LS + 8 * hh;
    const h16* b_base = sB + (buf * BN + wn * TN + r) * LS + 8 * hh;
#pragma unroll
    for (int t = 0; t < 4; ++t) {
      h8 af[MI], bf[NI];
#pragma unroll
      for (int mi = 0; mi < MI; ++mi) af[mi] = *(const h8*)(a_base + mi * 32 * LS + t * 16);
#pragma unroll
      for (int ni = 0; ni < NI; ++ni) bf[ni] = *(const h8*)(b_base + ni * 32 * LS + t * 16);
#pragma unroll
      for (int mi = 0; mi < MI; ++mi)
#pragma unroll
        for (int ni = 0; ni < NI; ++ni) acc[mi][ni] = MFMA32(bf[ni], af[mi], acc[mi][ni]);
    }
    if (kt + 1 < KT) SSTORE(buf ^ 1);
    __syncthreads();
    buf ^= 1;
  }
#undef GLOAD
#undef SSTORE
  h16* T = (h16*)smem;
#pragma unroll
  for (int mi = 0; mi < MI; ++mi)
#pragma unroll
    for (int ni = 0; ni < NI; ++ni)
#pragma unroll
      for (int g4 = 0; g4 < 4; ++g4) {
        h4 o;
#pragma unroll
        for (int jj = 0; jj < 4; ++jj) o[jj] = (h16)acc[mi][ni][4 * g4 + jj];
        *(h4*)(T + (wm * TM + mi * 32 + r) * TS + wn * TN + ni * 32 + 8 * g4 + 4 * hh) = o;
      }
  __syncthreads();
}

template <int OP>
DI void epi_simple(const h16* T, int m0, h16* dst, int ld, int col0, int tid) {
  h8 v[8];
#pragma unroll
  for (int it = 0; it < 8; ++it) {
    const int q = tid + NBLK_THREADS * it;
    v[it] = *(const h8*)(T + (q >> 4) * 136 + (q & 15) * 8);
  }
#pragma unroll
  for (int it = 0; it < 8; ++it) {
    const int q = tid + NBLK_THREADS * it;
    h8 o;
#pragma unroll
    for (int e = 0; e < 8; ++e) {
      const float x = (float)v[it][e];
      o[e] = (OP == 1) ? (h16)silu(x) : (OP == 2) ? (h16)(x * QB_SCALE) : v[it][e];
    }
    *(h8*)(dst + (size_t)(m0 + (q >> 4)) * ld + col0 + (q & 15) * 8) = o;
  }
}
DI float4 f4_lo(h8 v) { return make_float4((float)v[0], (float)v[1], (float)v[2], (float)v[3]); }
DI float4 f4_hi(h8 v) { return make_float4((float)v[4], (float)v[5], (float)v[6], (float)v[7]); }
typedef float f32x4 __attribute__((ext_vector_type(4)));
typedef __attribute__((address_space(3))) unsigned* lds_u32p;
DI int g8_lds_byte(int r, int c) {
  const int st = (r >> 4) * 2 + (c >> 5), rr = r & 15, cc = c & 31, ob = rr * 64 + cc * 2;
  return st * 1024 + (ob ^ (((ob >> 9) & 1) << 5));
}
DI void g8_stage_rc(int b, int& R, int& C) {
  const int st = b / 1024, sb = b % 1024, swz = sb ^ (((sb >> 9) & 1) << 5);
  R = (st >> 1) * 16 + swz / 64;
  C = (st & 1) * 32 + (swz % 64) / 2;
}
#define G8_HT (128 * 64)
DI void gemm8_mainloop(const h16* __restrict__ A, const h16* __restrict__ Bt, int K, int brow, int bcol, char* smem,
                       f32x4 (&acc)[2][2][4][2]) {
  h16* shm = (h16*)smem;
  const int tid = opaque_tid();
  const int wid = tid >> 6, lane = tid & 63, wr = wid >> 2, wc = wid & 3, fr = lane & 15, fq = lane >> 4;
  int so[2];
#pragma unroll
  for (int i = 0; i < 2; ++i) { int R, C; g8_stage_rc(tid * 16 + i * 8192, R, C); so[i] = R * K + C; }
#define G8_SA(b, h) (shm + ((b) * 2 + (h)) * G8_HT)
#define G8_SB(b, h) (shm + (4 + (b) * 2 + (h)) * G8_HT)
#define G8_STAGE(Pp, BASE, br, kt)                                                                        \
  do {                                                                                                    \
    const h16* _bp = (BASE) + (size_t)(br) * K + (kt) * 64;                              \
    _Pragma("unroll") for (int _i = 0; _i < 2; ++_i) {                                                    \
      const h16* _g = _bp + so[_i];                                                                       \
      __builtin_amdgcn_global_load_lds((const unsigned*)_g,                                               \
                                       (lds_u32p)((char*)(Pp) + tid * 16 + _i * 8192), 16, 0, 0);         \
    }                                                                                                     \
  } while (0)
#define G8_LDA(dst, b, h)                                                                                 \
  _Pragma("unroll") for (int m = 0; m < 4; ++m) _Pragma("unroll") for (int k = 0; k < 2; ++k)             \
    dst[m][k] = *(const h8*)((const char*)G8_SA(b, h) + g8_lds_byte(wr * 64 + m * 16 + fr, k * 32 + fq * 8))
#define G8_LDB(dst, b, h)                                                                                 \
  _Pragma("unroll") for (int n = 0; n < 2; ++n) _Pragma("unroll") for (int k = 0; k < 2; ++k)             \
    dst[n][k] = *(const h8*)((const char*)G8_SB(b, h) + g8_lds_byte(wc * 32 + n * 16 + fr, k * 32 + fq * 8))
#define G8_MMA(ai, bj, At, Bq)                                                                            \
  do {                                                                                                    \
    __builtin_amdgcn_s_setprio(1);                                                                        \
    _Pragma("unroll") for (int m = 0; m < 4; ++m) _Pragma("unroll") for (int n = 0; n < 2; ++n)           \
      _Pragma("unroll") for (int k = 0; k < 2; ++k)                                                       \
        acc[ai][bj][m][n] = __builtin_amdgcn_mfma_f32_16x16x32_f16(Bq[n][k], At[m][k], acc[ai][bj][m][n], 0, 0, 0); \
    __builtin_amdgcn_s_setprio(0);                                                                        \
  } while (0)
#define G8_WAIT_V(n) asm volatile("s_waitcnt vmcnt(" #n ")" ::: "memory")
#define G8_WAIT_L(n) asm volatile("s_waitcnt lgkmcnt(" #n ")" ::: "memory")
#define G8_BAR __builtin_amdgcn_s_barrier()
#define G8_SCHED __builtin_amdgcn_sched_barrier(0)
#pragma unroll
  for (int a = 0; a < 2; ++a)
#pragma unroll
    for (int b = 0; b < 2; ++b)
#pragma unroll
      for (int m = 0; m < 4; ++m)
#pragma unroll
        for (int n = 0; n < 2; ++n) acc[a][b][m][n] = f32x4{0.f, 0.f, 0.f, 0.f};
  h8 At[4][2], B0[2][2], B1[2][2];
  const int nt = K / 64;
  G8_STAGE(G8_SB(0, 0), Bt, bcol, 0); G8_STAGE(G8_SA(0, 0), A, brow, 0);
  G8_STAGE(G8_SB(0, 1), Bt, bcol + 128, 0); G8_STAGE(G8_SA(0, 1), A, brow + 128, 0);
  if (wr == 1) G8_BAR;
  G8_WAIT_V(4); G8_BAR;
  G8_STAGE(G8_SB(1, 0), Bt, bcol, 1); G8_STAGE(G8_SA(1, 0), A, brow, 1); G8_STAGE(G8_SB(1, 1), Bt, bcol + 128, 1);
  G8_WAIT_V(6); G8_BAR;
  for (int t = 0; t < nt - 2; t += 2) {
    G8_LDB(B0, 0, 0); G8_SCHED; G8_LDA(At, 0, 0); G8_STAGE(G8_SA(1, 1), A, brow + 128, t + 1);
    G8_WAIT_L(8); G8_BAR; G8_WAIT_L(0); G8_MMA(0, 0, At, B0); G8_BAR; G8_SCHED;
    G8_LDB(B1, 0, 1); G8_STAGE(G8_SB(0, 0), Bt, bcol, t + 2);
    G8_BAR; G8_WAIT_L(0); G8_MMA(0, 1, At, B1); G8_BAR;
    G8_LDA(At, 0, 1); G8_STAGE(G8_SA(0, 0), A, brow, t + 2);
    G8_BAR; G8_WAIT_L(0); G8_MMA(1, 0, At, B0); G8_BAR; G8_SCHED;
    G8_STAGE(G8_SB(0, 1), Bt, bcol + 128, t + 2);
    G8_WAIT_V(6); G8_BAR; G8_MMA(1, 1, At, B1); G8_BAR;
    G8_LDB(B0, 1, 0); G8_SCHED; G8_LDA(At, 1, 0); G8_STAGE(G8_SA(0, 1), A, brow + 128, t + 2);
    G8_WAIT_L(8); G8_BAR; G8_WAIT_L(0); G8_MMA(0, 0, At, B0); G8_BAR; G8_SCHED;
    G8_LDB(B1, 1, 1); G8_STAGE(G8_SB(1, 0), Bt, bcol, t + 3);
    G8_BAR; G8_WAIT_L(0); G8_MMA(0, 1, At, B1); G8_BAR;
    G8_LDA(At, 1, 1); G8_STAGE(G8_SA(1, 0), A, brow, t + 3);
    G8_BAR; G8_WAIT_L(0); G8_MMA(1, 0, At, B0); G8_BAR; G8_SCHED;
    G8_STAGE(G8_SB(1, 1), Bt, bcol + 128, t + 3);
    G8_WAIT_V(6); G8_BAR; G8_MMA(1, 1, At, B1); G8_BAR;
  }
  { G8_LDB(B0, 0, 0); G8_LDA(At, 0, 0); G8_STAGE(G8_SA(1, 1), A, brow + 128, nt - 1);
    G8_BAR; G8_WAIT_L(0); G8_MMA(0, 0, At, B0); G8_BAR;
    G8_LDB(B1, 0, 1); G8_BAR; G8_WAIT_L(0); G8_MMA(0, 1, At, B1); G8_BAR;
    G8_LDA(At, 0, 1); G8_WAIT_V(4); G8_BAR; G8_WAIT_L(0); G8_MMA(1, 0, At, B0); G8_MMA(1, 1, At, B1); G8_BAR; }
  { G8_LDB(B0, 1, 0); G8_LDA(At, 1, 0); G8_WAIT_V(2); G8_BAR; G8_WAIT_L(0); G8_MMA(0, 0, At, B0); G8_BAR;
    G8_LDB(B1, 1, 1); G8_WAIT_V(0); G8_BAR; G8_WAIT_L(0); G8_MMA(0, 1, At, B1); G8_BAR;
    G8_LDA(At, 1, 1); G8_BAR; G8_WAIT_L(0); G8_MMA(1, 0, At, B0); G8_MMA(1, 1, At, B1); G8_BAR; }
  if (wr == 0) G8_BAR;
#undef G8_SA
#undef G8_SB
#undef G8_STAGE
#undef G8_LDA
#undef G8_LDB
#undef G8_MMA
}

DI void p1_epilogue(const P& p, const h16* T, int m0, int n0, int nt, bool isP) {
  constexpr int TS = 136;
  const int tid = opaque_tid(), lane = tid & 63, w = tid >> 6;
  if (nt == 2) {
    for (int rr = w; rr < 256; rr += 8) {
      const int m = m0 + rr;
      const h2 v2 = *(const h2*)(T + rr * TS + 2 * lane);
      const float a = (float)v2[0], b = (float)v2[1];
      const float ss = wave_sum(a * a + b * b);
      const float rstd = rsqrtf(ss * (1.f / 128.f) + 1e-6f);
      const float2 g = *(const float2*)(p.kvn_g + 2 * lane);
      const float o0 = a * rstd * g.x, o1 = b * rstd * g.y;
      float* oc = isP ? p.out + OFF_P_CKV + (size_t)m * 128 : p.out + OFF_S_CKV + (size_t)(m - NP) * 128;
      *(float2*)(oc + 2 * lane) = make_float2(o0, o1);
      h2 o; o[0] = (h16)o0; o[1] = (h16)o1;
      *(h2*)(p.KM + (size_t)m * 160 + 2 * lane) = o;
    }
  } else if (nt >= 4 && nt <= 6) {
    epi_simple<1>(T, m0, p.GA, 512, n0 - ZC_GA, tid);
  } else if (nt >= 8 && nt <= 10) {
    epi_simple<2>(T, m0, p.QB, 512, n0 - ZC_QB, tid);
  } else if (nt >= 14 && nt <= 16) {
    epi_simple<0>(T, m0, p.QI, 512, n0 - ZC_QI, tid);
  } else if (nt >= 18 && nt <= 20) {
    epi_simple<1>(T, m0, p.GB, 512, n0 - ZC_GB, tid);
  } else {
#pragma unroll 1
    for (int it = 0; it < 8; ++it) {
      const int q = tid + NBLK_THREADS * it;
      const int row = q >> 4, ch = q & 15;
      const int col = n0 + ch * 8, m = m0 + row;
      const int ms = isP ? m : m - NP;
      const h8 v = *(const h8*)(T + row * TS + ch * 8);
      if (col < ZC_CKV) {
        *(h8*)(p.CQ + (size_t)m * 256 + col) = v;
        float ss = 0.f;
#pragma unroll
        for (int e = 0; e < 8; ++e) ss += (float)v[e] * (float)v[e];
        ss += __shfl_xor(ss, 1); ss += __shfl_xor(ss, 2); ss += __shfl_xor(ss, 4); ss += __shfl_xor(ss, 8);
        if (ch == 0) p.RQP[(size_t)m * 2 + nt] = ss;
      } else if (col < ZC_GA) {
        const int j0 = col - ZC_KPE;
        const bool hiHalf = j0 >= 16;
        const h8 u = *(const h8*)(T + row * TS + (hiHalf ? ch - 2 : ch + 2) * 8);
        const int ri = rope_idx(m) * 16 + (j0 & 15);
        const float4 c0 = *(const float4*)(p.ropeC + ri), c1 = *(const float4*)(p.ropeC + ri + 4);
        const float4 s0 = *(const float4*)(p.ropeS + ri), s1 = *(const float4*)(p.ropeS + ri + 4);
        const float cs[8] = {c0.x, c0.y, c0.z, c0.w, c1.x, c1.y, c1.z, c1.w};
        const float sn[8] = {s0.x, s0.y, s0.z, s0.w, s1.x, s1.y, s1.z, s1.w};
        float o[8];
        h8 oh;
#pragma unroll
        for (int e = 0; e < 8; ++e) {
          const float mine = (float)v[e], other = (float)u[e];
          o[e] = hiHalf ? (other * sn[e] + mine * cs[e]) : (mine * cs[e] - other * sn[e]);
          oh[e] = (h16)o[e];
        }
        float* oc = (isP ? p.out + OFF_P_KPE : p.out + OFF_S_KPE) + (size_t)ms * 32 + j0;
        *(float4*)oc = make_float4(o[0], o[1], o[2], o[3]);
        *(float4*)(oc + 4) = make_float4(o[4], o[5], o[6], o[7]);
        *(h8*)(p.KM + (size_t)m * 160 + 128 + j0) = oh;
      } else if (col < ZC_QB) {
        h8 o;
#pragma unroll
        for (int e = 0; e < 8; ++e) o[e] = (h16)silu((float)v[e]);
        *(h8*)(p.GA + (size_t)m * 512 + (col - ZC_GA)) = o;
      } else if (col < ZC_KB) {
        h8 o;
#pragma unroll
        for (int e = 0; e < 8; ++e) o[e] = (h16)((float)v[e] * QB_SCALE);
        *(h8*)(p.QB + (size_t)m * 512 + (col - ZC_QB)) = o;
      } else if (col < ZC_QI) {
        const bool isK = col < ZC_VB;
        const int c0 = col - (isK ? ZC_KB : ZC_VB);
        float* oc = (isK ? (isP ? p.out + OFF_P_K : p.out + OFF_S_K) : (isP ? p.out + OFF_P_V : p.out + OFF_S_V)) +
                    (size_t)ms * 128 + c0;
        *(float4*)oc = f4_lo(v);
        *(float4*)(oc + 4) = f4_hi(v);
        *(h8*)((isK ? p.KB : p.VB) + (size_t)m * 128 + c0) = v;
      } else if (col < ZC_KI) {
        *(h8*)(p.QI + (size_t)m * 512 + (col - ZC_QI)) = v;
      } else if (col < ZC_WI) {
        float* oc = (isP ? p.out + OFF_P_KIDX : p.out + OFF_S_KIDX) + (size_t)ms * 64 + (col - ZC_KI);
        *(float4*)oc = f4_lo(v);
        *(float4*)(oc + 4) = f4_hi(v);
        *(h8*)(p.KI + (size_t)m * 64 + (col - ZC_KI)) = v;
      } else if (col < ZC_GB) {
        float* oc = p.WI + (size_t)m * 8;
        const float4 a = f4_lo(v), b = f4_hi(v);
        *(float4*)oc = make_float4(a.x * WI_SCALE, a.y * WI_SCALE, a.z * WI_SCALE, a.w * WI_SCALE);
        *(float4*)(oc + 4) = make_float4(b.x * WI_SCALE, b.y * WI_SCALE, b.z * WI_SCALE, b.w * WI_SCALE);
      } else if (col < INW) {
        h8 o;
#pragma unroll
        for (int e = 0; e < 8; ++e) o[e] = (h16)silu((float)v[e]);
        *(h8*)(p.GB + (size_t)m * 512 + (col - ZC_GB)) = o;
      }
    }
  }
}

DI void phase1(const P& p, char* smem) {
  constexpr int TS = 136;
  h16* T = (h16*)smem;
  const int ntiles = 68 * 11;
  const int xcd = blockIdx.x & 7, lb = blockIdx.x >> 3, nlb = gridDim.x >> 3;
  const int per = (ntiles + 7) >> 3;
  const int tend = (xcd * per + per) < ntiles ? (xcd * per + per) : ntiles;
  for (int L = xcd * per + lb; L < tend; L += nlb) {
    const int pg = L / 44, rem = L - pg * 44;
    const int pn = rem >> 2, mt = pg * 4 + (rem & 3);
    const int m0 = mt * 256;
    const bool isP = mt < 64;
    f32x4 acc[2][2][4][2];
    gemm8_mainloop(p.hX, p.Wt_in, DM, m0, pn * 256, smem, acc);
    __syncthreads();
    const int tid = opaque_tid();
    const int wid = tid >> 6, lane = tid & 63, wr = wid >> 2, wc = wid & 3, fr = lane & 15, fq = lane >> 4;
#pragma unroll
    for (int bj = 0; bj < 2; ++bj) {
#pragma unroll
      for (int ai = 0; ai < 2; ++ai)
#pragma unroll
        for (int m = 0; m < 4; ++m)
#pragma unroll
          for (int n = 0; n < 2; ++n)
          {
            h4 o;
#pragma unroll
            for (int jj = 0; jj < 4; ++jj) o[jj] = (h16)acc[ai][bj][m][n][jj];
            *(h4*)(T + (ai * 128 + wr * 64 + m * 16 + fr) * TS + wc * 32 + n * 16 + fq * 4) = o;
          }
      __syncthreads();
      p1_epilogue(p, T, m0, pn * 256 + bj * 128, pn * 2 + bj, isP);
      __syncthreads();
    }
  }
}

DI size_t qm_index(int m, int hd, int d) {
  return ((((size_t)(m >> 5) * 8 + hd) * 10 + (d >> 4)) * 64 + (((d >> 3) & 1) * 32 + (m & 31))) * 8 + (d & 7);
}
DI void phase1b(const P& p, char* smem) {
  constexpr int TS = 136;
  h16* T = (h16*)smem;
  float* rq = (float*)(smem + 128 * 1024 - 2048);
  const int ntiles = 68 * 5;
  for (int tile = blockIdx.x; tile < ntiles; tile += gridDim.x) {
    const int mt = tile / 5, pn = tile % 5;
    const int m0 = mt * 256;
    f32x4 acc[2][2][4][2];
    gemm8_mainloop(p.CQ, p.Wq, 256, m0, pn * 256, smem, acc);
    __syncthreads();
    const int tid = opaque_tid();
    if (tid < 256) {
      const float2 pp = *(const float2*)(p.RQP + (size_t)(m0 + tid) * 2);
      rq[tid] = rsqrtf((pp.x + pp.y) * (1.f / 256.f) + 1e-6f) * QM_SCALE;
    }
    const int wid = tid >> 6, lane = tid & 63, wr = wid >> 2, wc = wid & 3, fr = lane & 15, fq = lane >> 4;
#pragma unroll
    for (int bj = 0; bj < 2; ++bj) {
      const int nt = pn * 2 + bj;
#pragma unroll
      for (int ai = 0; ai < 2; ++ai)
#pragma unroll
        for (int m = 0; m < 4; ++m)
#pragma unroll
          for (int n = 0; n < 2; ++n)
          {
            h4 o;
#pragma unroll
            for (int jj = 0; jj < 4; ++jj) o[jj] = (h16)acc[ai][bj][m][n][jj];
            *(h4*)(T + (ai * 128 + wr * 64 + m * 16 + fr) * TS + wc * 32 + n * 16 + fq * 4) = o;
          }
      __syncthreads();
#pragma unroll 2
      for (int it = 0; it < 8; ++it) {
        const int q = tid + NBLK_THREADS * it;
        const int row = q >> 4, ch = q & 15;
        const int m = m0 + row;
        const float sc = rq[row];
        const h8 v = *(const h8*)(T + row * TS + ch * 8);
        h8 o;
        int hd, d0;
        if (nt < 8) {
          hd = nt; d0 = ch * 8;
#pragma unroll
          for (int e = 0; e < 8; ++e) o[e] = (h16)((float)v[e] * sc);
        } else {
          hd = (nt - 8) * 4 + (ch >> 2);
          const int j0 = (ch & 3) * 8;
          d0 = 128 + j0;
          const bool hiHalf = j0 >= 16;
          const h8 u = *(const h8*)(T + row * TS + (hiHalf ? ch - 2 : ch + 2) * 8);
          const int ri = rope_idx(m) * 16 + (j0 & 15);
          const float4 c0 = *(const float4*)(p.ropeC + ri), c1 = *(const float4*)(p.ropeC + ri + 4);
          const float4 s0 = *(const float4*)(p.ropeS + ri), s1 = *(const float4*)(p.ropeS + ri + 4);
          const float cs[8] = {c0.x, c0.y, c0.z, c0.w, c1.x, c1.y, c1.z, c1.w};
          const float sn[8] = {s0.x, s0.y, s0.z, s0.w, s1.x, s1.y, s1.z, s1.w};
#pragma unroll
          for (int e = 0; e < 8; ++e) {
            const float mine = (float)v[e] * sc, other = (float)u[e] * sc;
            o[e] = (h16)(hiHalf ? (other * sn[e] + mine * cs[e]) : (mine * cs[e] - other * sn[e]));
          }
        }
        *(h8*)(p.QM + qm_index(m, hd, d0)) = o;
      }
      __syncthreads();
    }
  }
}

template <bool SAMPLE>
DI void mla_item(const P& p, int b, int tok0, int nkeys, char* smem, const int tid, unsigned* ctr, int& nxt) {
  constexpr int KS = 168;
  h16* sK = (h16*)smem;
  const int lane = tid & 63, w = tid >> 6;
  const int r = lane & 31, hh = lane >> 5;
  const int i16 = lane & 15, q4 = i16 >> 2, p4 = i16 & 3, blk = (lane >> 4) & 1;

  h8 qf[10];
  {
    const h16* qp = p.QM + ((size_t)((tok0 >> 5) * 8 + w) * 10 * 64 + lane) * 8;
#pragma unroll
    for (int t = 0; t < 10; ++t) qf[t] = *(const h8*)(qp + t * 512);
  }
  f16v O[4];
#pragma unroll
  for (int dt = 0; dt < 4; ++dt)
#pragma unroll
    for (int i = 0; i < 16; ++i) O[dt][i] = 0.f;
  float m = NEGBIG, l = 0.f;

  h8 sh[3];
  float4 sf[3][2];
  const int NT = (nkeys + 63) >> 6;

#define MLA_GLOAD(kt)                                                                                          \
  {                                                                                                            \
    _Pragma("unroll") for (int i = 0; i < 3; ++i) {                                                            \
      const int q = tid + NBLK_THREADS * i;                                                                    \
      const int row = q / 20, cc = q % 20;                                                                     \
      const int s = (kt) * 64 + row;                                                                           \
      if (q < 1280) {                                                                                          \
        if (!SAMPLE) {                                                                                         \
          sh[i] = *(const h8*)(p.KM + (size_t)(b * 2048 + s) * 160 + cc * 8);                                  \
        } else {                                                                                               \
          if (s < PAST) {                                                                                      \
            const float* src = (cc < 16) ? p.c_ckv + ((size_t)(b * PAST + s) * 128 + cc * 8)                   \
                                         : p.c_kpe + ((size_t)(b * PAST + s) * 32 + (cc - 16) * 8);            \
            sf[i][0] = *(const float4*)src; sf[i][1] = *(const float4*)(src + 4);                              \
          } else if (s < SKEYS) {                                                                              \
            sf[i][0] = __builtin_bit_cast(float4, *(const h8*)(p.KM + (size_t)(NP + b * 32 + (s - PAST)) * 160 + cc * 8)); \
          } else {                                                                                             \
            sf[i][0] = make_float4(0.f, 0.f, 0.f, 0.f);                                                        \
          }                                                                                                    \
        }                                                                                                      \
      }                                                                                                        \
    }                                                                                                          \
  }
#define MLA_SSTORE(kt, buf)                                                                                    \
  {                                                                                                            \
    _Pragma("unroll") for (int i = 0; i < 3; ++i) {                                                            \
      const int q = tid + NBLK_THREADS * i;                                                                    \
      const int row = q / 20, cc = q % 20;                                                                     \
      const int s = (kt) * 64 + row;                                                                           \
      if (q < 1280) {                                                                                          \
        h8 v;                                                                                                  \
        if (SAMPLE) v = (s < PAST) ? cvt8(sf[i][0], sf[i][1]) : __builtin_bit_cast(h8, sf[i][0]);              \
        else v = sh[i];                                                                                        \
        *(h8*)(sK + ((buf) * 64 + row) * KS + cc * 8) = v;                                                     \
      }                                                                                                        \
    }                                                                                                          \
  }

  if constexpr (!SAMPLE) {
  constexpr unsigned TB = 64 * KS * 2;
  unsigned goffb[3], loffb[3];
#pragma unroll
  for (int i = 0; i < 3; ++i) {
    const int q = tid + NBLK_THREADS * i;
    const int row = q / 20, cc = q % 20;
    goffb[i] = (unsigned)(row * 160 + cc * 8) * 2u;
    loffb[i] = (unsigned)(row * KS + cc * 8) * 2u;
  }
  const char* kmb = (const char*)(p.KM + (size_t)b * 2048 * 160);
  const unsigned sKo = lds_off(sK);
  const unsigned ka_off = sKo + (unsigned)(r * KS + 8 * hh) * 2u;
  const unsigned vb_off = sKo + (unsigned)((4 * hh + q4) * KS + 16 * blk + 4 * p4) * 2u;
#define MLAP_GLOAD(kt)                                                                                   \
  {                                                                                                      \
    const char* _src = kmb + (size_t)(kt) * (64 * 160 * 2);                                              \
    _Pragma("unroll") for (int i = 0; i < 3; ++i)                                                        \
      if (i < 2 || tid < 256) sh[i] = *(const h8*)(_src + goffb[i]);                                     \
  }
#define MLAP_SSTORE(buf)                                                                                 \
  {                                                                                                      \
    const unsigned _dst = sKo + (unsigned)(buf) * TB;                                                    \
    _Pragma("unroll") for (int i = 0; i < 3; ++i)                                                        \
      if (i < 2 || tid < 256) *(lds_h8p)(uintptr_t)(_dst + loffb[i]) = sh[i];                            \
  }
#define HS_VL(f, kv)                                                                                     \
  vf[(f) & 3] = cat8(lds_tr((kv) + (((f) >> 2) * 16 * KS + 32 * ((f) & 3)) * 2),                         \
                     lds_tr((kv) + (((f) >> 2) * 16 * KS + 32 * ((f) & 3) + 8 * KS) * 2));
#define HS_FILL(s, Sc, pbc)                                                                              \
  if ((s) < 16) {                                                                                        \
    const float e = fast_exp2(Sc[(s) & 15] - m);                                                         \
    Sc[(s) & 15] = e;                                                                                    \
    if ((s) & 1) rs1 += e; else rs0 += e;                                                                \
  }                                                                                                      \
  if ((s) >= 3 && ((s) & 1)) {                                                                           \
    const int _j = (((s) - 3) / 2) & 7;                                                                  \
    pbc[_j >> 2][2 * (_j & 3)] = (h16)Sc[2 * _j];                                                        \
    pbc[_j >> 2][2 * (_j & 3) + 1] = (h16)Sc[2 * _j + 1];                                                \
  }
#define MLAP_HALFSTEP(Sc, Sx, pbp, pbc, kq, kv, chk)                                                     \
  {                                                                                                      \
    float rs0 = 0.f, rs1 = 0.f, mx = NEGBIG;                                                             \
    h8 ka[3], vf[4];                                                                                     \
    _Pragma("unroll") for (int t = 0; t < 3; ++t) ka[t] = lds_ld8((kq) + 32 * t);                        \
    _Pragma("unroll") for (int i = 0; i < 16; ++i) Sx[i] = 0.f;                                          \
    _Pragma("unroll") for (int t = 0; t < 10; ++t) {                                                     \
      Sx = MFMA32(ka[t % 3], qf[t], Sx);                                                                 \
      if (t + 3 < 10) ka[t % 3] = lds_ld8((kq) + 32 * (t + 3));                                          \
      if (t >= 6) { HS_VL(t - 6, kv) }                                                                   \
      HS_FILL(t, Sc, pbc)                                                                                \
      __builtin_amdgcn_sched_barrier(0);                                                                 \
    }                                                                                                    \
    _Pragma("unroll") for (int f = 0; f < 8; ++f) {                                                      \
      O[f & 3] = MFMA32(vf[f & 3], pbp[f >> 2], O[f & 3]);                                               \
      if (f + 4 < 8) { HS_VL(f + 4, kv) }                                                                \
      HS_FILL(10 + f, Sc, pbc)                                                                           \
      if (f == 3) mx = max3f(mx, Sx[0], Sx[1]);                                                          \
      if (f == 4) mx = max3f(mx, Sx[2], Sx[3]);                                                          \
      if (f == 5) { mx = max3f(mx, Sx[4], Sx[5]); mx = max3f(mx, Sx[6], Sx[7]); }                        \
      if (f == 6) { mx = max3f(mx, Sx[8], Sx[9]); mx = max3f(mx, Sx[10], Sx[11]); }                      \
      if (f == 7) { mx = max3f(mx, Sx[12], Sx[13]); mx = max3f(mx, Sx[14], Sx[15]); }                    \
      __builtin_amdgcn_sched_barrier(0);                                                                 \
    }                                                                                                    \
    l += rs0 + rs1;                                                                                      \
    if (chk) {                                                                                           \
      mx = xhalf_max(mx);                                                                                \
      if (__any(mx > m + RESC_T)) {   \
        const float mn = fmaxf(m, mx);                                                                   \
        const float alpha = fast_exp2(m - mn);                                                           \
        m = mn;                                                                                          \
        l *= alpha;                                                                                      \
        const h16 ah = (h16)alpha;                                                                       \
        _Pragma("unroll") for (int g = 0; g < 2; ++g)                                                    \
          _Pragma("unroll") for (int jj = 0; jj < 8; ++jj) pbc[g][jj] *= ah;                             \
        _Pragma("unroll") for (int dt = 0; dt < 4; ++dt)                                                 \
          _Pragma("unroll") for (int i = 0; i < 16; ++i) O[dt][i] *= alpha;                              \
      }                                                                                                  \
    }                                                                                                    \
  }
  MLAP_GLOAD(0);
#pragma unroll
  for (int t = 0; t < 10; ++t) pin8(qf[t]);
  MLAP_SSTORE(0);
  if (NT > 1) { MLAP_GLOAD(1); MLAP_SSTORE(1); }
  __syncthreads();
  f16v SA, SB;
  h8 pbA[2], pbB[2];
  pbA[0] = zero8(); pbA[1] = zero8(); pbB[0] = zero8(); pbB[1] = zero8();
  {
#pragma unroll
    for (int i = 0; i < 16; ++i) SA[i] = 0.f;
#pragma unroll
    for (int t = 0; t < 10; ++t) SA = MFMA32(lds_ld8(ka_off + 32 * t), qf[t], SA);
    mfma_settle();
    float mx = max3f(SA[0], SA[1], SA[2]);
#pragma unroll
    for (int i = 3; i < 15; i += 2) mx = max3f(mx, SA[i], SA[i + 1]);
    mx = fmaxf(mx, SA[15]);
    m = xhalf_max(mx);
  }
  for (int kt = 0; kt < NT; ++kt) {
    const bool more = kt + 1 < NT;
    if (kt + 2 < NT) MLAP_GLOAD(kt + 2);
    const unsigned bc = (unsigned)(kt & 3) * TB, bn = (unsigned)((kt + 1) & 3) * TB;
    const unsigned bp = (kt > 0) ? (unsigned)((kt - 1) & 3) * TB + 32u * KS * 2u : 0u;
    {
      const unsigned kq = opaque_u(ka_off + bc + 32u * KS * 2u), kv = opaque_u(vb_off + bp);
      MLAP_HALFSTEP(SA, SB, pbB, pbA, kq, kv, true);
    }
    {
      const unsigned kq = opaque_u(ka_off + bn), kv = opaque_u(vb_off + bc);
      MLAP_HALFSTEP(SB, SA, pbA, pbB, kq, kv, more);
    }
    if (kt + 2 < NT) MLAP_SSTORE((kt + 2) & 3);
    __syncthreads();
  }
  {
    const unsigned kv = opaque_u(vb_off + (unsigned)((NT - 1) & 3) * TB + 32u * KS * 2u);
    h8 vf[4];
#pragma unroll
    for (int f = 0; f < 4; ++f) { HS_VL(f, kv) }
#pragma unroll
    for (int f = 0; f < 8; ++f) {
      O[f & 3] = MFMA32(vf[f & 3], pbB[f >> 2], O[f & 3]);
      if (f + 4 < 8) { HS_VL(f + 4, kv) }
    }
  }
#undef MLAP_GLOAD
#undef MLAP_SSTORE
#undef HS_VL
#undef HS_FILL
#undef MLAP_HALFSTEP
  } else {
  MLA_GLOAD(0);
#pragma unroll
  for (int t = 0; t < 10; ++t) pin8(qf[t]);
  MLA_SSTORE(0, 0);
  __syncthreads();
  int buf = 0;
  for (int kt = 0; kt < NT; ++kt) {
    if (kt + 1 < NT) MLA_GLOAD(kt + 1);
    const bool two = (nkeys - kt * 64) > 32;
    const h16* kbase = sK + buf * 64 * KS;
    const h16* ka_ptr = kbase + r * KS + 8 * hh;
    const h16* vb_ptr = kbase + (4 * hh + q4) * KS + 16 * blk + 4 * p4;
    f16v S0, S1;
#pragma unroll
    for (int i = 0; i < 16; ++i) { S0[i] = 0.f; S1[i] = 0.f; }
    {
      h8 ka0[3], ka1[3];
#pragma unroll
      for (int t = 0; t < 3; ++t) {
        ka0[t] = *(const h8*)(ka_ptr + 16 * t);
        ka1[t] = *(const h8*)(ka_ptr + 32 * KS + 16 * t);
      }
#pragma unroll
      for (int t = 0; t < 10; ++t) {
        S0 = MFMA32(ka0[t % 3], qf[t], S0);
        S1 = MFMA32(ka1[t % 3], qf[t], S1);
        if (t + 3 < 10) {
          ka0[t % 3] = *(const h8*)(ka_ptr + 16 * (t + 3));
          ka1[t % 3] = *(const h8*)(ka_ptr + 32 * KS + 16 * (t + 3));
        }
      }
    }
    h8 vf[4];
#define MLA_VLOAD(f)                                                                   \
  {                                                                                    \
    const h16* vp = vb_ptr + ((((f) >> 3) * 32) + ((((f) >> 2) & 1) * 16)) * KS + 32 * ((f) & 3); \
    vf[(f) & 3] = cat8(trread(vp), trread(vp + 8 * KS));                               \
  }
#pragma unroll
    for (int f = 0; f < 4; ++f) MLA_VLOAD(f);
    if (!two) {
      asm volatile("" ::: "memory");
#pragma unroll
      for (int i = 0; i < 16; ++i) S1[i] = NEGBIG;
    }
    mfma_settle();
    float mx = max3f(S0[0], S0[1], S1[0]);
    mx = max3f(mx, S1[1], S0[2]);
#pragma unroll
    for (int i = 2; i < 15; ++i) mx = max3f(mx, S1[i], S0[i + 1]);
    mx = fmaxf(mx, S1[15]);
    mx = xhalf_max(mx);
    if (__any(mx > m + RESC_T)) {
      const float mn = fmaxf(m, mx);
      const float alpha = fast_exp2(m - mn);
      m = mn;
      l *= alpha;
#pragma unroll
      for (int dt = 0; dt < 4; ++dt)
#pragma unroll
        for (int i = 0; i < 16; ++i) O[dt][i] *= alpha;
    }
    {
      const f2v m2 = {m, m};
      f2v rs2 = {0.f, 0.f};
#pragma unroll
      for (int i = 0; i < 16; i += 2) {
        f2v a = {S0[i], S0[i + 1]};
        f2v b = {S1[i], S1[i + 1]};
        a -= m2; b -= m2;
        a[0] = fast_exp2(a[0]); a[1] = fast_exp2(a[1]);
        b[0] = fast_exp2(b[0]); b[1] = fast_exp2(b[1]);
        rs2 += a; rs2 += b;
        S0[i] = a[0]; S0[i + 1] = a[1]; S1[i] = b[0]; S1[i + 1] = b[1];
      }
      l += rs2[0] + rs2[1];
    }
    h8 pb[4];
#pragma unroll
    for (int g = 0; g < 4; ++g)
#pragma unroll
      for (int jj = 0; jj < 8; ++jj) pb[g][jj] = (h16)((g < 2) ? S0[8 * (g & 1) + jj] : S1[8 * (g & 1) + jj]);
#pragma unroll
    for (int f = 0; f < 16; ++f) {
      O[f & 3] = MFMA32(vf[f & 3], pb[f >> 2], O[f & 3]);
      if (f + 4 < 16) MLA_VLOAD(f + 4);
    }
#undef MLA_VLOAD
    if (kt + 1 < NT) MLA_SSTORE(kt + 1, buf ^ 1);
    __syncthreads();
    buf ^= 1;
  }
  }
#undef MLA_GLOAD
#undef MLA_SSTORE
  if (threadIdx.x == 0) nxt = (int)atomicAdd(ctr, 1u);
  const float inv = 1.f / (l + __shfl_xor(l, 32));
  f16v Y[2];
#pragma unroll
  for (int vt = 0; vt < 2; ++vt)
#pragma unroll
    for (int i = 0; i < 16; ++i) Y[vt][i] = 0.f;
#pragma unroll
  for (int dt = 0; dt < 4; ++dt) {
#pragma unroll
    for (int s = 0; s < 2; ++s) {
      h8 ob;
#pragma unroll
      for (int j = 0; j < 8; ++j) ob[j] = (h16)(O[dt][8 * s + j] * inv);
#pragma unroll
      for (int vt = 0; vt < 2; ++vt) {
        const h8 a = *(const h8*)(p.Wuv + ((size_t)((((w * 2 + vt) * 4 + dt) * 2 + s) * 64 + lane)) * 8);
        Y[vt] = MFMA32(a, ob, Y[vt]);
      }
    }
  }
  h16* Yt = (h16*)smem + w * (32 * 72);
#pragma unroll
  for (int vt = 0; vt < 2; ++vt) {
#pragma unroll
    for (int g4 = 0; g4 < 4; ++g4) {
      h4 o;
#pragma unroll
      for (int j = 0; j < 4; ++j) o[j] = (h16)Y[vt][4 * g4 + j];
      *(h4*)(Yt + r * 72 + 32 * vt + 8 * g4 + 4 * hh) = o;
    }
  }
  wavebar();
#pragma unroll
  for (int i = 0; i < 4; ++i) {
    const int q = lane + 64 * i;
    const int row = q >> 3, ch = q & 7;
    const h8 y = *(const h8*)(Yt + row * 72 + ch * 8);
    const h8 ga = *(const h8*)(p.GA + (size_t)(tok0 + row) * 512 + w * 64 + ch * 8);
    h8 o;
#pragma unroll
    for (int j = 0; j < 8; ++j) o[j] = (h16)((float)y[j] * (float)ga[j]);
    *(h8*)(p.mix + (size_t)(tok0 + row) * 1024 + w * 64 + ch * 8) = o;
  }
  __syncthreads();
}

#define SEL_CAP 256
DI int sel_bin(float v, float lo, float scale, bool degen) {
  if (degen) return v > lo ? 1023 : 0;
  int b = (int)((v - lo) * scale);
  return b > 1023 ? 1023 : b;
}
template <int NR, int NH>
DI void wave_select(const float* sc, int N, unsigned* maskrow, unsigned* hist, float* candv, int* candi, int lane,
                 float (&vpre)[NR], const float* scnext) {
  const int nwords = N >> 5;
  if (lane == 0) maskrow[nwords] = 0u;
  if (N <= 256) {
    for (int wd = lane; wd < nwords; wd += 64) maskrow[wd] = 0xffffffffu;
    return;
  }
  float v[NR];
#define SEL_LOAD(hf)                                                     \
  {                                                                      \
    _Pragma("unroll") for (int i = 0; i < NR; ++i) {                     \
      const int e = 64 * ((hf) * NR + i) + lane;                         \
      v[i] = (e < N) ? sc[e] : -INFINITY;                                \
    }                                                                    \
  }
  if (NH == 1) {
#pragma unroll
    for (int i = 0; i < NR; ++i) v[i] = vpre[i];
    if (scnext) {
#pragma unroll
      for (int i = 0; i < NR; ++i) {
        const int e = 64 * i + lane;
        vpre[i] = (e < N) ? scnext[e] : -INFINITY;
      }
    }
  }
  float lo = INFINITY, hi = -INFINITY;
#pragma unroll 1
  for (int hf = 0; hf < NH; ++hf) {
    if (NH > 1) SEL_LOAD(hf);
#pragma unroll
    for (int i = 0; i < NR; ++i) {
      hi = fmaxf(hi, v[i]);
      lo = fminf(lo, (v[i] == -INFINITY) ? INFINITY : v[i]);
    }
  }
  lo = wave_min(lo); hi = wave_max(hi);
  int need = 256;
  int T = 0, above = 0;
  float scale = 0.f;
  bool degen = false;
  bool rankmode = false;
  bool first = true;
  for (int iter = 0; iter < 64; ++iter) {
    if (!(lo < hi)) break;
    scale = 1024.f / (hi - lo);
    degen = !(scale < 1.0e37f);
    for (int i = lane; i < 1024; i += 64) hist[i] = 0u;
    wavebar();
    if (first && !degen) {
#pragma unroll 1
      for (int hf = 0; hf < NH; ++hf) {
        if (NH > 1) SEL_LOAD(hf);
#pragma unroll
        for (int i = 0; i < NR; ++i) {
          const int eb = 64 * (hf * NR + i);
          if (eb < N) {
            int bn = (int)((v[i] - lo) * scale);
            bn = bn > 1023 ? 1023 : bn;
            if (eb + 64 <= N) atomicAdd(&hist[bn], 1u);
            else if (eb + lane < N) atomicAdd(&hist[bn], 1u);
          }
        }
      }
    } else {
#pragma unroll 1
      for (int hf = 0; hf < NH; ++hf) {
        if (NH > 1) SEL_LOAD(hf);
#pragma unroll
        for (int i = 0; i < NR; ++i) {
          if (v[i] >= lo && v[i] <= hi) atomicAdd(&hist[sel_bin(v[i], lo, scale, degen)], 1u);
          if ((i & 7) == 7) __builtin_amdgcn_sched_barrier(0);
        }
      }
    }
    wavebar();
    unsigned ssum = 0;
#pragma unroll
    for (int i = 0; i < 16; ++i) ssum += hist[16 * lane + i];
    unsigned x = ssum;
#pragma unroll
    for (int off = 1; off < 64; off <<= 1) {
      const unsigned y = __shfl_down(x, off);
      if (lane + off < 64) x += y;
    }
    const unsigned sufx = x - ssum;
    const bool cross = (sufx < (unsigned)need) && (x >= (unsigned)need);
    int myT = 0, myAbove = 0, myC = 0;
    if (cross) {
      unsigned run = sufx;
      for (int i = 15; i >= 0; --i) {
        const unsigned c = hist[16 * lane + i];
        if (run + c >= (unsigned)need) { myT = 16 * lane + i; myAbove = (int)run; myC = (int)c; break; }
        run += c;
      }
    }
    const unsigned long long bal = __ballot(cross);
    const int src = bal ? (int)__builtin_ctzll(bal) : 0;
    T = __shfl(myT, src); above = __shfl(myAbove, src);
    const int cT = __shfl(myC, src);
    if (cT <= SEL_CAP) { rankmode = true; break; }
    first = false;
    need -= above;
    float nlo = INFINITY, nhi = -INFINITY;
#pragma unroll 1
    for (int hf = 0; hf < NH; ++hf) {
      if (NH > 1) SEL_LOAD(hf);
#pragma unroll
      for (int i = 0; i < NR; ++i) {
        if (v[i] >= lo && v[i] <= hi && sel_bin(v[i], lo, scale, degen) == T) { nlo = fminf(nlo, v[i]); nhi = fmaxf(nhi, v[i]); }
      }
    }
    lo = wave_min(nlo); hi = wave_max(nhi);
  }
  const int pick = rankmode ? need - above : need;
  int running = 0;
  const unsigned long long ltmask = (lane == 0) ? 0ull : (~0ull >> (64 - lane));
  const bool fastfinal = rankmode && first && !degen;
#pragma unroll 1
  for (int hf = 0; hf < NH; ++hf) {
    if (NH > 1) SEL_LOAD(hf);
    int mlo = 0, mhi = 0;
#pragma unroll
    for (int i = 0; i < NR; ++i) {
      const int eb = 64 * (hf * NR + i);
      if (eb < N) {
        const float vv = v[i];
        unsigned long long bs, bc;
        if (fastfinal) {
          int bn = (int)((vv - lo) * scale);
          bn = bn > 1023 ? 1023 : bn;
          bs = __ballot(bn > T);
          bc = __ballot(bn == T);
        } else {
          bool s = vv > hi;
          bool c;
          if (rankmode) {
            const bool inr = (vv >= lo && vv <= hi);
            const int bn = inr ? sel_bin(vv, lo, scale, degen) : -1;
            s = s || (bn > T);
            c = (bn == T);
          } else {
            c = (vv == hi);
          }
          bc = __ballot(c);
          if (!rankmode) {
            const int pos = running + __popcll(bc & ltmask);
            s = s || (c && pos < pick);
          }
          bs = __ballot(s);
        }
        if (bc != 0ull) {
          if (rankmode) {
            const bool c = (bc >> lane) & 1ull;
            const int pos = running + __popcll(bc & ltmask);
            if (c) { candv[pos] = vv; candi[pos] = eb + lane; }
          }
          running += __popcll(bc);
        }
        if (lane == i) { mlo = (int)(unsigned)bs; mhi = (int)(unsigned)(bs >> 32); }
      }
      if ((i & 7) == 7) __builtin_amdgcn_sched_barrier(0);
    }
    {
      const int wd = 2 * (hf * NR + lane);
      if (lane < NR && wd < nwords) {
        maskrow[wd] = (unsigned)mlo;
        if (wd + 1 < nwords) maskrow[wd + 1] = (unsigned)mhi;
      }
    }
  }
#undef SEL_LOAD
  if (rankmode) {
    wavebar();
    const int ncand = running;
    for (int i = lane; i < ncand; i += 64) {
      const float vi = candv[i];
      const int ii = candi[i];
      int rank = 0;
      for (int j = 0; j < ncand; ++j) {
        const float vj = candv[j];
        const int ij = candi[j];
        rank += ((vj > vi) || (vj == vi && ij < ii)) ? 1 : 0;
      }
      if (rank < pick) atomicOr(&maskrow[ii >> 5], 1u << (ii & 31));
    }
  }
  wavebar();
}

template <bool SAMPLE>
DI void dsa_item(const P& p, int b, int tok0, int qpos0, int nkeys, float* sc, int scs,
                         char* smem, const int tid, unsigned* ctr, int& nxt) {
  const int lane = tid & 63, w = tid >> 6;
  const int r = lane & 31, hh = lane >> 5;
  const int NT = (nkeys + 63) >> 6;
  unsigned* sMask = (unsigned*)(smem + 73728);
  float* sBias = (float*)(smem + 73728 + 32 * MASK_W * 4);
  if (tid < 256) sBias[tid] = p.rel_bias[tid] * LOG2E;
  float* sBT = sBias + 256;
  for (int e = tid; e < 249 * 8; e += NBLK_THREADS) {
    const int rel = (e >> 3) - 185;
    const int n = rel < 0 ? -rel : rel;
    int bk = n;
    if (n >= 8) bk = 8 + (n >= 12) + (n >= 16) + (n >= 23) + (n >= 32) + (n >= 46) + (n >= 64) + (n >= 91);
    if (rel > 0) bk += 16;
    sBT[e] = p.rel_bias[bk * 8 + (e & 7)] * LOG2E;
  }
  {
    constexpr int LS = 72;
    h16* sKI = (h16*)smem;
    const int NTA = (nkeys + 127) >> 7;
    h8 ai[4];
    {
      const int aq = ((r >> 2) & 1) * 2 + (r >> 4), ah = (r & 3) + 4 * ((r >> 3) & 1);
      const h16* qp = p.QI + ((size_t)(tok0 + 4 * w + aq) * 8 + ah) * 64 + 8 * hh;
#pragma unroll
      for (int t = 0; t < 4; ++t) ai[t] = *(const h8*)(qp + 16 * t);
    }
    float w16[16];
#pragma unroll
    for (int i = 0; i < 16; ++i)
      w16[i] = p.WI[(size_t)(tok0 + 4 * w + 2 * hh + (i >> 3)) * 8 + (i & 3) + 4 * ((i >> 2) & 1)];
    h8 sh[2];
    float4 sf[2][2];
#define KI_GLOAD(kt)                                                                                  \
  {                                                                                                   \
    _Pragma("unroll") for (int i = 0; i < 2; ++i) {                                                   \
      const int q = tid + NBLK_THREADS * i;                                                           \
      const int s = (kt) * 128 + (q >> 3), lcc = q & 7;                                               \
      if (!SAMPLE) {                                                                                  \
        sh[i] = (s < nkeys) ? *(const h8*)(p.KI + (size_t)(b * 2048 + s) * 64 + lcc * 8) : zero8();   \
      } else if (s < PAST) {                                                                          \
        const float* src = p.c_kidx + ((size_t)(b * PAST + s) * 64 + lcc * 8);                        \
        sf[i][0] = *(const float4*)src; sf[i][1] = *(const float4*)(src + 4);                         \
      } else if (s < SKEYS) {                                                                         \
        sf[i][0] = __builtin_bit_cast(float4, *(const h8*)(p.KI + (size_t)(NP + b * 32 + (s - PAST)) * 64 + lcc * 8)); \
      } else {                                                                                        \
        sf[i][0] = make_float4(0.f, 0.f, 0.f, 0.f);                                                   \
      }                                                                                               \
    }                                                                                                 \
  }
#define KI_SSTORE(kt, buf)                                                                            \
  {                                                                                                   \
    _Pragma("unroll") for (int i = 0; i < 2; ++i) {                                                   \
      const int q = tid + NBLK_THREADS * i;                                                           \
      const int s = (kt) * 128 + (q >> 3), lcc = q & 7;                                               \
      h8 v;                                                                                           \
      if (SAMPLE) v = (s < PAST) ? cvt8(sf[i][0], sf[i][1]) : __builtin_bit_cast(h8, sf[i][0]);       \
      else v = sh[i];                                                                                 \
      *(h8*)(sKI + ((buf) * 128 + (q >> 3)) * LS + lcc * 8) = v;                                      \
    }                                                                                                 \
  }
    KI_GLOAD(0);
#pragma unroll
    for (int t = 0; t < 4; ++t) pin8(ai[t]);
#pragma unroll
    for (int i = 0; i < 16; ++i) pinf(w16[i]);
    KI_SSTORE(0, 0);
    __syncthreads();
    int buf = 0;
    for (int kt = 0; kt < NTA; ++kt) {
      if (kt + 1 < NTA) KI_GLOAD(kt + 1);
      const h16* kbase = sKI + buf * 128 * LS + r * LS + 8 * hh;
#pragma unroll
      for (int sub = 0; sub < 4; ++sub) {
        const int key0 = kt * 128 + 32 * sub;
        if (key0 < nkeys) {
          f16v D;
#pragma unroll
          for (int i = 0; i < 16; ++i) D[i] = 0.f;
#pragma unroll
          for (int t = 0; t < 4; ++t) {
            const h8 bf = *(const h8*)(kbase + 32 * sub * LS + 16 * t);
            D = MFMA32(ai[t], bf, D);
          }
          mfma_settle();
          float ps0 = 0.f, ps1 = 0.f;
#pragma unroll
          for (int i = 0; i < 8; ++i) {
            ps0 = fmaf(relu1(D[i]), w16[i], ps0);
            ps1 = fmaf(relu1(D[8 + i]), w16[8 + i], ps1);
          }
          float* so = sc + (size_t)(4 * w + 2 * hh) * scs + key0 + r;
          so[0] = ps0;
          so[scs] = ps1;
        }
      }
      if (kt + 1 < NTA) KI_SSTORE(kt + 1, buf ^ 1);
      __syncthreads();
      buf ^= 1;
    }
#undef KI_GLOAD
#undef KI_SSTORE
  }
    constexpr int LS = 136;
    h16* sKb = (h16*)smem;
    h16* sVb = sKb + 2 * 64 * LS;
    const int kv = w >> 2, ql = 8 * (w & 3) + (r >> 2), g = r & 3, head = 4 * kv + g;
    const int i16 = lane & 15, q4 = i16 >> 2, p4 = i16 & 3, blk = (lane >> 4) & 1;
    const int tq = tok0 + ql;
    const int pq = qpos0 + ql;
    h8 qf[4];
#define DSA_QLOAD                                                                  \
    {                                                                              \
      const h16* qp = p.QB + (size_t)tq * 512 + head * 64 + 8 * hh;                \
      _Pragma("unroll") for (int t = 0; t < 4; ++t) qf[t] = *(const h8*)(qp + 16 * t); \
    }
    if (!SAMPLE) DSA_QLOAD;
    h8 sh[4];
    float4 sf[4][2];
#define KV_GLOAD(kt)                                                                                   \
  {                                                                                                    \
    _Pragma("unroll") for (int i = 0; i < 4; ++i) {                                                    \
      const int q = tid + NBLK_THREADS * i;                                                            \
      const int row = q >> 5, cc = q & 31, c16 = cc & 15;                                              \
      const int s = (kt) * 64 + row;                                                                   \
      if (!SAMPLE) {                                                                                   \
        sh[i] = *(const h8*)(((cc < 16) ? p.KB : p.VB) + (size_t)(b * 2048 + s) * 128 + c16 * 8);      \
      } else if (s < PAST) {                                                                           \
        const float* src = ((cc < 16) ? p.c_k : p.c_v) + ((size_t)(b * PAST + s) * 128 + c16 * 8);     \
        sf[i][0] = *(const float4*)src; sf[i][1] = *(const float4*)(src + 4);                          \
      } else if (s < SKEYS) {                                                                          \
        sf[i][0] = __builtin_bit_cast(float4, *(const h8*)(((cc < 16) ? p.KB : p.VB) + (size_t)(NP + b * 32 + (s - PAST)) * 128 + c16 * 8)); \
      } else {                                                                                         \
        sf[i][0] = make_float4(0.f, 0.f, 0.f, 0.f);                                                    \
      }                                                                                                \
    }                                                                                                  \
  }
#define KV_SSTORE(kt, buf)                                                                             \
  {                                                                                                    \
    _Pragma("unroll") for (int i = 0; i < 4; ++i) {                                                    \
      const int q = tid + NBLK_THREADS * i;                                                            \
      const int row = q >> 5, cc = q & 31, c16 = cc & 15;                                              \
      const int s = (kt) * 64 + row;                                                                   \
      h8 v;                                                                                            \
      if (SAMPLE) v = (s < PAST) ? cvt8(sf[i][0], sf[i][1]) : __builtin_bit_cast(h8, sf[i][0]);        \
      else v = sh[i];                                                                                  \
      *(h8*)(((cc < 16) ? sKb : sVb) + ((buf) * 64 + row) * LS + c16 * 8) = v;                         \
    }                                                                                                  \
  }
    if (!SAMPLE) KV_GLOAD(0);
  __syncthreads();
  {
    unsigned* hist = (unsigned*)(smem + w * 8192);
    float* candv = (float*)(smem + w * 8192 + 4096);
    int* candi = (int*)(smem + w * 8192 + 4096 + 1024);
    constexpr int SNR = SAMPLE ? 33 : 32;
    float vpre[SNR];
    if (!SAMPLE && nkeys > 256) {
#pragma unroll
      for (int i = 0; i < SNR; ++i) {
        const int e = 64 * i + lane;
        vpre[i] = (e < nkeys) ? sc[(size_t)(4 * w) * scs + e] : -INFINITY;
      }
    } else {
#pragma unroll
      for (int i = 0; i < SNR; ++i) vpre[i] = 0.f;
    }
#pragma unroll 1
    for (int qw = 0; qw < 4; ++qw) {
      const int ql = 4 * w + qw;
      wave_select<SNR, SAMPLE ? 2 : 1>(sc + (size_t)ql * scs, nkeys, sMask + ql * MASK_W, hist, candv, candi, lane, vpre,
                                      (qw < 3) ? sc + (size_t)(ql + 1) * scs : (const float*)nullptr);
    }
  }
  __syncthreads();
  {
    const float bias_far = sBias[15 * 8 + head];
    f16v O[2];
#pragma unroll
    for (int dt = 0; dt < 2; ++dt)
#pragma unroll
      for (int i = 0; i < 16; ++i) O[dt][i] = 0.f;
    float m = -1.0e29f, l = 0.f;
    if (SAMPLE) { DSA_QLOAD; KV_GLOAD(0); }
#undef DSA_QLOAD
#pragma unroll
    for (int t = 0; t < 4; ++t) pin8(qf[t]);
    KV_SSTORE(0, 0);
    __syncthreads();
    int buf = 0;
    for (int kt = 0; kt < NT; ++kt) {
      if (kt + 1 < NT) KV_GLOAD(kt + 1);
      const h16* ka_ptr = sKb + buf * 64 * LS + 64 * kv + r * LS + 8 * hh;
      const h16* vb_ptr = sVb + buf * 64 * LS + 64 * kv + (4 * hh + q4) * LS + 16 * blk + 4 * p4;
      const bool nearb = (qpos0 - (kt * 64 + 63)) < 91;
      const unsigned mw0 = sMask[ql * MASK_W + kt * 2] >> (4 * hh);
      const unsigned mw1 = sMask[ql * MASK_W + kt * 2 + 1] >> (4 * hh);
      f16v S0, S1;
      const int nb = __float_as_int(NEGBIG);
      const int im0 = (int)~mw0, im1 = (int)~mw1;
      const float boff = nearb ? 0.f : bias_far;
      MASKINIT16(S0, im0, nb);
      MASKINIT16(S1, im1, nb);
      asm volatile("s_nop 1");
      if (nearb) {
        const float* bt = sBT + (kt * 64 + 4 * hh - pq + 185) * 8 + head;
#pragma unroll
        for (int i = 0; i < 16; ++i) {
          S0[i] += bt[((i & 3) + 8 * (i >> 2)) * 8];
          S1[i] += bt[(32 + (i & 3) + 8 * (i >> 2)) * 8];
        }
      }
      {
        h8 ka0[2], ka1[2];
#pragma unroll
        for (int t = 0; t < 2; ++t) {
          ka0[t] = *(const h8*)(ka_ptr + 16 * t);
          ka1[t] = *(const h8*)(ka_ptr + 32 * LS + 16 * t);
        }
#pragma unroll
        for (int t = 0; t < 4; ++t) {
          S0 = MFMA32(ka0[t & 1], qf[t], S0);
          S1 = MFMA32(ka1[t & 1], qf[t], S1);
          if (t + 2 < 4) {
            ka0[t & 1] = *(const h8*)(ka_ptr + 16 * (t + 2));
            ka1[t & 1] = *(const h8*)(ka_ptr + 32 * LS + 16 * (t + 2));
          }
        }
      }
      h8 vf[4];
#define DSA_VLOAD(f)                                                                              \
  {                                                                                               \
    const h16* vp = vb_ptr + ((((f) >> 2) * 32) + ((((f) >> 1) & 1) * 16)) * LS + 32 * ((f) & 1); \
    vf[(f) & 3] = cat8(trread(vp), trread(vp + 8 * LS));                                          \
  }
#pragma unroll
      for (int f = 0; f < 4; ++f) DSA_VLOAD(f);
      mfma_settle();
      float mx = max3f(S0[0], S0[1], S1[0]);
      mx = max3f(mx, S1[1], S0[2]);
#pragma unroll
      for (int i = 2; i < 15; ++i) mx = max3f(mx, S1[i], S0[i + 1]);
      mx = fmaxf(mx, S1[15]);
      mx = xhalf_max(mx) + boff;
      if (__any(mx > m + RESC_T)) {
        const float mn = fmaxf(m, mx);
        const float alpha = fast_exp2(m - mn);
        m = mn;
        l *= alpha;
#pragma unroll
        for (int dt = 0; dt < 2; ++dt)
#pragma unroll
          for (int i = 0; i < 16; ++i) O[dt][i] *= alpha;
      }
      {
        const float msub = m - boff;
        const f2v m2 = {msub, msub};
        f2v rs2 = {0.f, 0.f};
#pragma unroll
        for (int i = 0; i < 16; i += 2) {
          f2v a = {S0[i], S0[i + 1]};
          f2v c = {S1[i], S1[i + 1]};
          a -= m2; c -= m2;
          a[0] = fast_exp2(a[0]); a[1] = fast_exp2(a[1]);
          c[0] = fast_exp2(c[0]); c[1] = fast_exp2(c[1]);
          rs2 += a; rs2 += c;
          S0[i] = a[0]; S0[i + 1] = a[1]; S1[i] = c[0]; S1[i + 1] = c[1];
        }
        l += rs2[0] + rs2[1];
      }
      h8 pb[4];
#pragma unroll
      for (int gg = 0; gg < 4; ++gg)
#pragma unroll
        for (int jj = 0; jj < 8; ++jj) pb[gg][jj] = (h16)((gg < 2) ? S0[8 * (gg & 1) + jj] : S1[8 * (gg & 1) + jj]);
#pragma unroll
      for (int f = 0; f < 8; ++f) {
        O[f & 1] = MFMA32(vf[f & 3], pb[f >> 1], O[f & 1]);
        if (f + 4 < 8) DSA_VLOAD(f + 4);
      }
#undef DSA_VLOAD
      if (kt + 1 < NT) KV_SSTORE(kt + 1, buf ^ 1);
      __syncthreads();
      buf ^= 1;
    }
#undef KV_GLOAD
#undef KV_SSTORE
    if (threadIdx.x == 0) nxt = (int)atomicAdd(ctr, 1u);
    const float inv = 1.f / (l + __shfl_xor(l, 32));
    h16* Ot = (h16*)smem + w * (8 * 264);
    {
      const int q8 = r >> 2;
#pragma unroll
      for (int dt = 0; dt < 2; ++dt) {
#pragma unroll
        for (int g4 = 0; g4 < 4; ++g4) {
          h4 o;
#pragma unroll
          for (int j = 0; j < 4; ++j) o[j] = (h16)(O[dt][4 * g4 + j] * inv);
          *(h4*)(Ot + q8 * 264 + g * 64 + 32 * dt + 8 * g4 + 4 * hh) = o;
        }
      }
    }
    wavebar();
#pragma unroll
    for (int i = 0; i < 4; ++i) {
      const int q = lane + 64 * i;
      const int row = q >> 5, ch = q & 31;
      const int tk = tok0 + 8 * (w & 3) + row;
      const h8 y = *(const h8*)(Ot + row * 264 + ch * 8);
      const h8 gb = *(const h8*)(p.GB + (size_t)tk * 512 + kv * 256 + ch * 8);
      h8 o;
#pragma unroll
      for (int j = 0; j < 8; ++j) o[j] = (h16)((float)y[j] * (float)gb[j]);
      *(h8*)(p.mix + (size_t)tk * 1024 + 512 + kv * 256 + ch * 8) = o;
    }
  }
  __syncthreads();
}

#define ITEMS_PER_Q 136
DI void phase2(const P& p, char* smem, int cidx = 0) {
  volatile int& s_item = *(volatile int*)(smem + SMEM_BYTES - 16);
  const int xq = blockIdx.x & 7;
  unsigned* ctr = &p.counters[cidx * 8 + xq];
  if (threadIdx.x == 0) s_item = (int)atomicAdd(ctr, 1u);
  __syncthreads();
  int item = s_item;
  while (item < ITEMS_PER_Q) {
    int nxt = 0;
    const int tid = opaque_tid();
    if (item < 4) {
      const int b = xq + 8 * item;
      mla_item<true>(p, b, NP + b * 32, SKEYS, smem, tid, ctr, nxt);
    } else if (item < 8) {
      const int b = xq + 8 * (item - 4);
      dsa_item<true>(p, b, NP + b * 32, PAST, SKEYS, p.scS + (size_t)b * 32 * SC_STRIDE_S, SC_STRIDE_S, smem, tid, ctr, nxt);
    } else {
      const int k = item - 8;
      const int kind = k & 1, sub = (k >> 1) & 1, b = xq, c = 31 - (k >> 2);
      const int tok0 = b * 2048 + c * 64 + sub * 32;
      const int nkeys = 64 * (c + 1);
      if (kind == 0) mla_item<false>(p, b, tok0, nkeys, smem, tid, ctr, nxt);
      else dsa_item<false>(p, b, tok0, c * 64 + sub * 32, nkeys, p.scP + (size_t)blockIdx.x * 32 * SC_STRIDE_P,
                           SC_STRIDE_P, smem, tid, ctr, nxt);
    }
    if (threadIdx.x == 0) s_item = nxt;
    __syncthreads();
    item = s_item;
    __syncthreads();
  }
}

template <int BM>
DI void p3_epilogue(const P& p, const h16* T, int m0, int n0) {
  constexpr int TS = 136;
  const int tid = opaque_tid();
  constexpr int NIT = BM / 32;
  float4 x0[NIT], x1[NIT];
#pragma unroll
  for (int it = 0; it < NIT; ++it) {
    const int q = tid + NBLK_THREADS * it;
    const int m = m0 + (q >> 4), n = n0 + (q & 15) * 8;
    const float* xr = (m < NP ? p.x_p + (size_t)m * DM : p.x_s + (size_t)(m - NP) * DM) + n;
    x0[it] = *(const float4*)xr; x1[it] = *(const float4*)(xr + 4);
  }
#pragma unroll
  for (int it = 0; it < NIT; ++it) {
    const int q = tid + NBLK_THREADS * it;
    const int row = q >> 4, ch = q & 15;
    const int m = m0 + row, n = n0 + ch * 8;
    const h8 v = *(const h8*)(T + row * TS + ch * 8);
    h8 o;
    o[0] = (h16)(x0[it].x + (float)v[0]); o[1] = (h16)(x0[it].y + (float)v[1]);
    o[2] = (h16)(x0[it].z + (float)v[2]); o[3] = (h16)(x0[it].w + (float)v[3]);
    o[4] = (h16)(x1[it].x + (float)v[4]); o[5] = (h16)(x1[it].y + (float)v[5]);
    o[6] = (h16)(x1[it].z + (float)v[6]); o[7] = (h16)(x1[it].w + (float)v[7]);
    *(h8*)(p.XN + (size_t)m * DM + n) = o;
  }
}
DI void phase3(const P& p, char* smem) {
  constexpr int TS = 136;
  h16* T = (h16*)smem;
  for (int tile = blockIdx.x; tile < 256; tile += gridDim.x) {
    const int xcd = tile & 7, idx = tile >> 3;
    const int mt = xcd * 8 + (idx >> 2), pn = idx & 3;
    const int m0 = mt * 256;
    f32x4 acc[2][2][4][2];
    gemm8_mainloop(p.mix, p.Wt_out, DM, m0, pn * 256, smem, acc);
    __syncthreads();
    const int tid = opaque_tid();
    const int wid = tid >> 6, lane = tid & 63, wr = wid >> 2, wc = wid & 3, fr = lane & 15, fq = lane >> 4;
#pragma unroll
    for (int bj = 0; bj < 2; ++bj) {
#pragma unroll
      for (int ai = 0; ai < 2; ++ai)
#pragma unroll
        for (int m = 0; m < 4; ++m)
#pragma unroll
          for (int n = 0; n < 2; ++n)
          {
            h4 o;
#pragma unroll
            for (int jj = 0; jj < 4; ++jj) o[jj] = (h16)acc[ai][bj][m][n][jj];
            *(h4*)(T + (ai * 128 + wr * 64 + m * 16 + fr) * TS + wc * 32 + n * 16 + fq * 4) = o;
          }
      __syncthreads();
      p3_epilogue<256>(p, T, m0, pn * 256 + bj * 128);
      __syncthreads();
    }
  }
  for (int tile = blockIdx.x; tile < 128; tile += gridDim.x) {
    const int m0 = NP + (tile >> 3) * 64, n0 = (tile & 7) * 128;
    gemm_tile<64, 128, 2, 4>(p.mix, 1024, p.Wt_out, 1024, 1024, m0, n0, smem);
    p3_epilogue<64>(p, T, m0, n0);
    __syncthreads();
  }
}

DI void phase4(const P& p) {
  const int tid = opaque_tid(), lane = tid & 63, w = tid >> 6;
  const int gw = blockIdx.x * 8 + w, nw = gridDim.x * 8;
  for (int k0 = 0; gw + nw * k0 < NTOK; k0 += 5) {
    h4 v[5][4];
    float ss[5];
#pragma unroll
    for (int rr = 0; rr < 5; ++rr) {
      const int row = gw + nw * (k0 + rr);
#pragma unroll
      for (int k = 0; k < 4; ++k) {
        if (row < NTOK) v[rr][k] = *(const h4*)(p.XN + (size_t)row * DM + 4 * lane + 256 * k);
        else { v[rr][k][0] = (h16)0.f; v[rr][k][1] = (h16)0.f; v[rr][k][2] = (h16)0.f; v[rr][k][3] = (h16)0.f; }
      }
    }
#pragma unroll
    for (int rr = 0; rr < 5; ++rr) {
      float a = 0.f;
#pragma unroll
      for (int k = 0; k < 4; ++k)
#pragma unroll
        for (int e = 0; e < 4; ++e) a += (float)v[rr][k][e] * (float)v[rr][k][e];
      ss[rr] = a;
    }
#pragma unroll
    for (int off = 32; off > 0; off >>= 1) {
#pragma unroll
      for (int rr = 0; rr < 5; ++rr) ss[rr] += __shfl_xor(ss[rr], off);
    }
    float4 g[4];
#pragma unroll
    for (int k = 0; k < 4; ++k) g[k] = *(const float4*)(p.fn_g + 4 * lane + 256 * k);
#pragma unroll
    for (int rr = 0; rr < 5; ++rr) {
      const int row = gw + nw * (k0 + rr);
      if (row < NTOK) {
        const float rstd = rsqrtf(ss[rr] * (1.f / 1024.f) + 1e-6f);
        float* o = p.out + (size_t)row * DM;
#pragma unroll
        for (int k = 0; k < 4; ++k)
          *(float4*)(o + 4 * lane + 256 * k) = make_float4((float)v[rr][k][0] * rstd * g[k].x, (float)v[rr][k][1] * rstd * g[k].y,
                                                           (float)v[rr][k][2] * rstd * g[k].z, (float)v[rr][k][3] * rstd * g[k].w);
      }
    }
  }
}

__global__ void __launch_bounds__(NBLK_THREADS) mega_kernel(P p) {
  __shared__ __attribute__((aligned(16))) char smem[SMEM_BYTES];
  XBar xb;
  xb.w = p.counters;
  xb.x = (unsigned)__builtin_amdgcn_s_getreg((3 << 11) | 20) & 0xFu;
  xb.nloc = 0u; xb.nx = 0u;
  if (threadIdx.x == 0) __hip_atomic_fetch_add(&xb.w[XB_CNT(xb.x)], 1u, __ATOMIC_RELAXED, __HIP_MEMORY_SCOPE_AGENT);
  phase0(p, smem);
  xcd_barrier(xb, 1u, smem);
  phase1(p, smem);
  xcd_barrier(xb, 2u, smem);
  phase1b(p, smem);
  xcd_barrier(xb, 3u, smem);
  phase2(p, smem);
  xcd_barrier(xb, 4u, smem);
  phase3(p, smem);
  xcd_barrier(xb, 5u, smem);
  phase4(p);
}

extern "C" void kernel_launch(void* const* d_in, const int* in_sizes, int n_in, void* d_out, int out_size, void* d_ws,
                              size_t ws_size, hipStream_t stream) {
  P p{};
  p.x_p = (const float*)d_in[0];
  p.x_s = (const float*)d_in[1];
  p.c_ckv = (const float*)d_in[2];
  p.c_kpe = (const float*)d_in[3];
  p.c_k = (const float*)d_in[4];
  p.c_v = (const float*)d_in[5];
  p.c_kidx = (const float*)d_in[6];
  p.norm_g = (const float*)d_in[7];
  p.w_in = (const float*)d_in[8];
  p.qn_g = (const float*)d_in[9];
  p.kvn_g = (const float*)d_in[10];
  p.w_uq = (const float*)d_in[11];
  p.w_uk = (const float*)d_in[12];
  p.w_uv = (const float*)d_in[13];
  p.rel_bias = (const float*)d_in[14];
  p.w_out = (const float*)d_in[15];
  p.fn_g = (const float*)d_in[16];
  p.out = (float*)d_out;

  char* ws = (char*)d_ws;
  size_t off = 0;
  auto carve = [&](size_t bytes) {
    char* r = ws + off;
    off += (bytes + 255) & ~(size_t)255;
    return r;
  };
  p.counters = (unsigned*)carve(XB_WORDS * 4);
  p.hX = (h16*)carve((size_t)NTOK * DM * 2);
  p.mix = p.hX;
  p.scP = (float*)carve((size_t)256 * 32 * SC_STRIDE_P * 4);
  p.CQ = (h16*)carve((size_t)NTOK * 256 * 2);
  p.Wt_in = (h16*)carve((size_t)INWP * DM * 2);
  p.Wt_out = (h16*)carve((size_t)DM * DM * 2);
  p.Wq = (h16*)carve((size_t)1280 * 256 * 2);
  p.Wuv = (h16*)carve((size_t)8 * 64 * 128 * 2);
  p.QM = (h16*)carve((size_t)NTOK * 1280 * 2);
  p.XN = (h16*)carve((size_t)NTOK * DM * 2);
  p.KM = (h16*)carve((size_t)NTOK * 160 * 2);
  p.GA = (h16*)carve((size_t)NTOK * 512 * 2);
  p.GB = (h16*)carve((size_t)NTOK * 512 * 2);
  p.QB = (h16*)carve((size_t)NTOK * 512 * 2);
  p.KB = (h16*)carve((size_t)NTOK * 128 * 2);
  p.VB = (h16*)carve((size_t)NTOK * 128 * 2);
  p.QI = (h16*)carve((size_t)NTOK * 512 * 2);
  p.KI = (h16*)carve((size_t)NTOK * 64 * 2);
  p.WI = (float*)carve((size_t)NTOK * 8 * 4);
  p.RQP = (float*)carve((size_t)NTOK * 2 * 4);
  p.ropeC = (float*)carve((size_t)2080 * 16 * 4);
  p.ropeS = (float*)carve((size_t)2080 * 16 * 4);
  p.scS = (float*)carve((size_t)32 * 32 * SC_STRIDE_S * 4);
  if (off > ws_size) {
    fprintf(stderr, "workspace too small: need %zu have %zu\n", off, ws_size);
    return;
  }
  static int grid_blocks = 0;
  if (!grid_blocks) {
    int dev = 0, cus = 0, per_cu = 0;
    hipGetDevice(&dev);
    hipDeviceGetAttribute(&cus, hipDeviceAttributeMultiprocessorCount, dev);
    hipOccupancyMaxActiveBlocksPerMultiprocessor(&per_cu, mega_kernel, NBLK_THREADS, 0);
    if (per_cu > 1) per_cu = 1;
    grid_blocks = cus * per_cu;
    if (grid_blocks > 256) grid_blocks = 256;
  }
  hipMemsetAsync(p.counters, 0, XB_WORDS * 4, stream);
  hipLaunchKernelGGL(mega_kernel, dim3(grid_blocks), dim3(NBLK_THREADS), 0, stream, p);
}
```

```cpp
#include <hip/hip_runtime.h>
#include <stdint.h>
#include <stdio.h>

typedef _Float16 h16;
typedef h16 h8 __attribute__((ext_vector_type(8)));
typedef h16 h4 __attribute__((ext_vector_type(4)));
typedef h16 h2 __attribute__((ext_vector_type(2)));
typedef float f16v __attribute__((ext_vector_type(16)));
typedef short s4v __attribute__((vector_size(8)));
typedef __attribute__((address_space(3))) s4v* lds_s4p;

#define DI __device__ __forceinline__
#define MFMA32(a, b, c) __builtin_amdgcn_mfma_f32_32x32x16_f16((a), (b), (c), 0, 0, 0)

#define NTOK 17408
#define NP 16384
#define DM 1024
#define INW 2792
#define INWP 2816
#define PAST 4096
#define SKEYS 4128
#define NBLK_THREADS 512

#define OFF_Y 0
#define OFF_P_CKV 17825792
#define OFF_P_KPE 19922944
#define OFF_P_K 20447232
#define OFF_P_V 22544384
#define OFF_P_KIDX 24641536
#define OFF_S_CKV 25690112
#define OFF_S_KPE 25821184
#define OFF_S_K 25853952
#define OFF_S_V 25985024
#define OFF_S_KIDX 26116096

#define ZC_CQ 0
#define ZC_CKV 256
#define ZC_KPE 384
#define ZC_GA 416
#define ZC_QB 928
#define ZC_KB 1440
#define ZC_VB 1568
#define ZC_QI 1696
#define ZC_KI 2208
#define ZC_WI 2272
#define ZC_GB 2280

#define LOG2E 1.4426950408889634f
#define QM_SCALE 0.14724444602590306f
#define QB_SCALE 0.18033688011112042f
#define WI_SCALE 0.04419417382415922f
#define NEGBIG (-1.0e30f)
#define RESC_T 8.0f

#define SMEM_BYTES 131072
#define SC_STRIDE_P 2048
#define SC_STRIDE_S 4160
#define MASK_W 132
#define N_ITEMS 1088

struct P {
  const float *x_p, *x_s, *c_ckv, *c_kpe, *c_k, *c_v, *c_kidx, *norm_g, *w_in, *qn_g, *kvn_g, *w_uq, *w_uk, *w_uv,
      *rel_bias, *w_out, *fn_g;
  float* out;
  h16 *hX, *CQ, *Wt_in, *Wt_out, *Wq, *Wuv, *QM, *KM, *GA, *GB, *QB, *KB, *VB, *QI, *KI, *mix, *XN;
  float *WI, *ropeC, *ropeS, *scP, *scS, *RQP;
  unsigned* counters;
};

DI int crow(int i, int hh) { return (i & 3) + 8 * (i >> 2) + 4 * hh; }
DI float wave_sum(float v) {
#pragma unroll
  for (int off = 32; off > 0; off >>= 1) v += __shfl_xor(v, off);
  return v;
}
DI float wave_max(float v) {
#pragma unroll
  for (int off = 32; off > 0; off >>= 1) v = fmaxf(v, __shfl_xor(v, off));
  return v;
}
DI float wave_min(float v) {
#pragma unroll
  for (int off = 32; off > 0; off >>= 1) v = fminf(v, __shfl_xor(v, off));
  return v;
}
DI h4 trread(const h16* p) {
  s4v r = __builtin_amdgcn_ds_read_tr16_b64_v4i16((lds_s4p)(p));
  return __builtin_bit_cast(h4, r);
}
DI h8 cat8(h4 a, h4 b) { return __builtin_shufflevector(a, b, 0, 1, 2, 3, 4, 5, 6, 7); }
typedef __attribute__((address_space(3))) h8* lds_h8p;
typedef __attribute__((address_space(3))) const char* lds_ccp;
DI unsigned lds_off(const void* p) { return (unsigned)(uintptr_t)(lds_ccp)p; }
DI h8 lds_ld8(unsigned a) { return *(lds_h8p)(uintptr_t)a; }
DI h4 lds_tr(unsigned a) { return __builtin_bit_cast(h4, __builtin_amdgcn_ds_read_tr16_b64_v4i16((lds_s4p)(uintptr_t)a)); }
DI unsigned opaque_u(unsigned x) { asm volatile("" : "+v"(x)); return x; }
DI h8 cvt8(float4 a, float4 b) {
  h8 r;
  r[0] = (h16)a.x; r[1] = (h16)a.y; r[2] = (h16)a.z; r[3] = (h16)a.w;
  r[4] = (h16)b.x; r[5] = (h16)b.y; r[6] = (h16)b.z; r[7] = (h16)b.w;
  return r;
}
DI h8 zero8() { h8 r; for (int i = 0; i < 8; ++i) r[i] = (h16)0.f; return r; }
DI float fast_exp2(float x) { return __builtin_amdgcn_exp2f(x); }
DI float silu(float x) { return x * __builtin_amdgcn_rcpf(1.f + __expf(-x)); }
DI int rope_idx(int t) { return t < NP ? (t & 2047) : 2048 + ((t - NP) & 31); }
DI int opaque_tid() { int t = threadIdx.x; asm volatile("" : "+v"(t)); return t; }
#define XB_CNT(x) (256 + 64 * (x))
#define XB_ARR(x) (256 + 64 * (16 + (x)))
#define XB_GEN(x) (256 + 64 * (32 + (x)))
#define XB_TOP (256 + 64 * 48)
#define XB_WORDS (256 + 64 * 49)
DI unsigned xb_ld(unsigned* q) { return __hip_atomic_load(q, __ATOMIC_RELAXED, __HIP_MEMORY_SCOPE_AGENT); }
struct XBar { unsigned* w; unsigned x, nloc, nx; };
DI void xcd_barrier(XBar& xb, unsigned k, char* smem) {
  asm volatile("s_waitcnt vmcnt(0)" ::: "memory");
  __syncthreads();
  volatile unsigned* bc = (volatile unsigned*)(smem + SMEM_BYTES - 64);
  if (threadIdx.x == 0) {
    if (k == 1u) {
      const unsigned G = gridDim.x;
      unsigned sum, nxx;
      do {
        sum = 0u; nxx = 0u;
        for (int j = 0; j < 16; ++j) { const unsigned c = xb_ld(&xb.w[XB_CNT(j)]); sum += c; nxx += (c != 0u); }
        if (sum != G) __builtin_amdgcn_s_sleep(2);
      } while (sum != G);
      bc[0] = xb_ld(&xb.w[XB_CNT(xb.x)]);
      bc[1] = nxx;
    }
  }
  if (k == 1u) {
    __syncthreads();
    xb.nloc = (unsigned)__builtin_amdgcn_readfirstlane((int)bc[0]);
    xb.nx = (unsigned)__builtin_amdgcn_readfirstlane((int)bc[1]);
  }
  if (threadIdx.x == 0) {
    const unsigned old = __hip_atomic_fetch_add(&xb.w[XB_ARR(xb.x)], 1u, __ATOMIC_RELAXED, __HIP_MEMORY_SCOPE_AGENT);
    if (old + 1u == k * xb.nloc) {
      __builtin_amdgcn_fence(__ATOMIC_RELEASE, "agent");
      asm volatile("s_waitcnt vmcnt(0)" ::: "memory");
      __hip_atomic_fetch_add(&xb.w[XB_TOP], 1u, __ATOMIC_RELAXED, __HIP_MEMORY_SCOPE_AGENT);
      while (xb_ld(&xb.w[XB_TOP]) < k * xb.nx) __builtin_amdgcn_s_sleep(1);
      __hip_atomic_store(&xb.w[XB_GEN(xb.x)], k, __ATOMIC_RELAXED, __HIP_MEMORY_SCOPE_AGENT);
    } else {
      while (xb_ld(&xb.w[XB_GEN(xb.x)]) < k) __builtin_amdgcn_s_sleep(1);
    }
    __builtin_amdgcn_fence(__ATOMIC_ACQUIRE, "agent");
    asm volatile("s_waitcnt vmcnt(0)" ::: "memory");
  }
  __syncthreads();
}
DI void xcd_arrive(XBar& xb, unsigned k) {
  asm volatile("s_waitcnt vmcnt(0)" ::: "memory");
  __syncthreads();
  if (threadIdx.x == 0) {
    const unsigned old = __hip_atomic_fetch_add(&xb.w[XB_ARR(xb.x)], 1u, __ATOMIC_RELAXED, __HIP_MEMORY_SCOPE_AGENT);
    if (old + 1u == k * xb.nloc) {
      __builtin_amdgcn_fence(__ATOMIC_RELEASE, "agent");
      asm volatile("s_waitcnt vmcnt(0)" ::: "memory");
      __hip_atomic_fetch_add(&xb.w[XB_TOP], 1u, __ATOMIC_RELAXED, __HIP_MEMORY_SCOPE_AGENT);
    }
  }
}
DI void xcd_wait(XBar& xb, unsigned k) {
  if (threadIdx.x == 0) {
    while (xb_ld(&xb.w[XB_TOP]) < k * xb.nx) __builtin_amdgcn_s_sleep(1);
    __builtin_amdgcn_fence(__ATOMIC_ACQUIRE, "agent");
    asm volatile("s_waitcnt vmcnt(0)" ::: "memory");
  }
  __syncthreads();
}
DI void grid_barrier(unsigned* bar, unsigned target) {
  asm volatile("s_waitcnt vmcnt(0)" ::: "memory");
  __syncthreads();
  if (threadIdx.x == 0) {
    __builtin_amdgcn_fence(__ATOMIC_RELEASE, "agent");
    asm volatile("s_waitcnt vmcnt(0)" ::: "memory");
    __hip_atomic_fetch_add(bar, 1u, __ATOMIC_RELAXED, __HIP_MEMORY_SCOPE_AGENT);
    while (__hip_atomic_load(bar, __ATOMIC_RELAXED, __HIP_MEMORY_SCOPE_AGENT) < target) __builtin_amdgcn_s_sleep(2);
    __builtin_amdgcn_fence(__ATOMIC_ACQUIRE, "agent");
    asm volatile("s_waitcnt vmcnt(0)" ::: "memory");
  }
  __syncthreads();
}
typedef float f2v __attribute__((ext_vector_type(2)));
DI float max3f(float a, float b, float c) {
  float d;
  asm("v_max3_f32 %0, %1, %2, %3" : "=v"(d) : "v"(a), "v"(b), "v"(c));
  return d;
}
DI float xhalf_max(float x) {
  const auto r = __builtin_amdgcn_permlane32_swap(__float_as_uint(x), __float_as_uint(x), false, false);
  float d;
  asm("v_max_f32 %0, %1, %2" : "=v"(d) : "v"(__uint_as_float(r[0])), "v"(__uint_as_float(r[1])));
  return d;
}
DI void mfma_settle() {
  __builtin_amdgcn_sched_barrier(0);
  asm volatile("s_nop 7\n\ts_nop 7");
  __builtin_amdgcn_sched_barrier(0);
}
DI float relu1(float x) { return __builtin_bit_cast(float, max(__builtin_bit_cast(int, x), 0)); }
#define MASKINIT(dst, im, BIT, nbv) asm volatile("v_bfe_i32 %0, %1, " #BIT ", 1\n\tv_and_b32 %0, %0, %2" : "=&v"(dst) : "v"(im), "v"(nbv))
#define MASKINITB(dst, im, BIT, nbv, basev) asm volatile("v_bfe_i32 %0, %1, " #BIT ", 1\n\tv_bfi_b32 %0, %0, %2, %3" : "=&v"(dst) : "v"(im), "v"(nbv), "v"(basev))
#define MASKINIT16(S, im, nbv)                                                                                  \
  { float _t;                                                                                                   \
    MASKINIT(_t, im, 0, nbv); S[0] = _t; MASKINIT(_t, im, 1, nbv); S[1] = _t; MASKINIT(_t, im, 2, nbv); S[2] = _t;     \
    MASKINIT(_t, im, 3, nbv); S[3] = _t; MASKINIT(_t, im, 8, nbv); S[4] = _t; MASKINIT(_t, im, 9, nbv); S[5] = _t;     \
    MASKINIT(_t, im, 10, nbv); S[6] = _t; MASKINIT(_t, im, 11, nbv); S[7] = _t; MASKINIT(_t, im, 16, nbv); S[8] = _t;  \
    MASKINIT(_t, im, 17, nbv); S[9] = _t; MASKINIT(_t, im, 18, nbv); S[10] = _t; MASKINIT(_t, im, 19, nbv); S[11] = _t; \
    MASKINIT(_t, im, 24, nbv); S[12] = _t; MASKINIT(_t, im, 25, nbv); S[13] = _t; MASKINIT(_t, im, 26, nbv); S[14] = _t; \
    MASKINIT(_t, im, 27, nbv); S[15] = _t; }
#define MASKINITB16(S, im, nbv, basev)                                                                          \
  { float _t;                                                                                                   \
    MASKINITB(_t, im, 0, nbv, basev); S[0] = _t; MASKINITB(_t, im, 1, nbv, basev); S[1] = _t;                   \
    MASKINITB(_t, im, 2, nbv, basev); S[2] = _t; MASKINITB(_t, im, 3, nbv, basev); S[3] = _t;                   \
    MASKINITB(_t, im, 8, nbv, basev); S[4] = _t; MASKINITB(_t, im, 9, nbv, basev); S[5] = _t;                   \
    MASKINITB(_t, im, 10, nbv, basev); S[6] = _t; MASKINITB(_t, im, 11, nbv, basev); S[7] = _t;                 \
    MASKINITB(_t, im, 16, nbv, basev); S[8] = _t; MASKINITB(_t, im, 17, nbv, basev); S[9] = _t;                 \
    MASKINITB(_t, im, 18, nbv, basev); S[10] = _t; MASKINITB(_t, im, 19, nbv, basev); S[11] = _t;               \
    MASKINITB(_t, im, 24, nbv, basev); S[12] = _t; MASKINITB(_t, im, 25, nbv, basev); S[13] = _t;               \
    MASKINITB(_t, im, 26, nbv, basev); S[14] = _t; MASKINITB(_t, im, 27, nbv, basev); S[15] = _t; }
DI void pin8(const h8& v) { asm volatile("" ::"v"(v)); }
DI void pinf(const float& v) { asm volatile("" ::"v"(v)); }
DI void wavebar() { asm volatile("s_waitcnt lgkmcnt(0)" ::: "memory"); }

__constant__ float c_inv_freq[16] = {1.000000000e+00f, 5.623413324e-01f, 3.162277639e-01f, 1.778279394e-01f,
                                     1.000000015e-01f, 5.623413250e-02f, 3.162277490e-02f, 1.778279431e-02f,
                                     9.999999776e-03f, 5.623413250e-03f, 3.162277630e-03f, 1.778279431e-03f,
                                     1.000000047e-03f, 5.623413017e-04f, 3.162277571e-04f, 1.778279402e-04f};

DI void sincos_acc(float angf, float* so, float* co) {
  const double a = (double)angf;
  const double q = rint(a * 0.6366197723675814);
  double t = fma(-q, 1.5707963267948966, a);
  t = fma(-q, 6.123233995736766e-17, t);
  const int qi = ((int)q) & 3;
  const double t2 = t * t;
  double sn = -1.0 / 1307674368000.0;
  sn = fma(sn, t2, 1.0 / 6227020800.0);
  sn = fma(sn, t2, -1.0 / 39916800.0);
  sn = fma(sn, t2, 1.0 / 362880.0);
  sn = fma(sn, t2, -1.0 / 5040.0);
  sn = fma(sn, t2, 1.0 / 120.0);
  sn = fma(sn, t2, -1.0 / 6.0);
  sn = fma(sn * t2, t, t);
  double cs = 1.0 / 20922789888000.0;
  cs = fma(cs, t2, -1.0 / 87178291200.0);
  cs = fma(cs, t2, 1.0 / 479001600.0);
  cs = fma(cs, t2, -1.0 / 3628800.0);
  cs = fma(cs, t2, 1.0 / 40320.0);
  cs = fma(cs, t2, -1.0 / 720.0);
  cs = fma(cs, t2, 1.0 / 24.0);
  cs = fma(cs, t2, -0.5);
  cs = fma(cs, t2, 1.0);
  double s, c;
  if (qi == 0) { s = sn; c = cs; }
  else if (qi == 1) { s = cs; c = -sn; }
  else if (qi == 2) { s = -sn; c = -cs; }
  else { s = -cs; c = sn; }
  *so = (float)s; *co = (float)c;
}

DI void transpose_to_h(const float* __restrict__ src, int K, int N, int Npad, h16* __restrict__ dst, char* smem) {
  float* tile = (float*)smem;
  const int tid = opaque_tid();
  const int ktn = K / 64, ntn = Npad / 64;
  const int nn = tid & 63, kr = tid >> 6;
  float rv[8];
#define TR_LOAD(tix)                                                                    \
  {                                                                                     \
    const int k0 = ((tix) / ntn) * 64, n = ((tix) % ntn) * 64 + nn;                     \
    _Pragma("unroll") for (int i = 0; i < 8; ++i)                                       \
      rv[i] = (n < N) ? src[(size_t)(k0 + kr + 8 * i) * N + n] : 0.f;                   \
  }
  int tix = blockIdx.x;
  if (tix < ktn * ntn) TR_LOAD(tix);
  for (; tix < ktn * ntn; tix += gridDim.x) {
    const int k0 = (tix / ntn) * 64, n0 = (tix % ntn) * 64;
#pragma unroll
    for (int i = 0; i < 8; ++i) tile[(kr + 8 * i) * 65 + nn] = rv[i];
    __syncthreads();
    if (tix + (int)gridDim.x < ktn * ntn) TR_LOAD(tix + (int)gridDim.x);
    {
      const int n2 = tid >> 3, ks = tid & 7;
      h8 o;
#pragma unroll
      for (int e = 0; e < 8; ++e) o[e] = (h16)tile[(ks * 8 + e) * 65 + n2];
      *(h8*)(dst + (size_t)(n0 + n2) * K + k0 + ks * 8) = o;
    }
    __syncthreads();
  }
#undef TR_LOAD
}

DI void phase0(const P& p, char* smem) {
  const int tid = opaque_tid(), lane = tid & 63, w = tid >> 6;
  const int gw = blockIdx.x * 8 + w, nw = gridDim.x * 8;
  const int gt = blockIdx.x * NBLK_THREADS + tid, nt = gridDim.x * NBLK_THREADS;
  for (int k0 = 0; gw + nw * k0 < NTOK; k0 += 5) {
    float4 v[5][4];
    float ss[5];
#pragma unroll
    for (int rr = 0; rr < 5; ++rr) {
      const int row = gw + nw * (k0 + rr);
      if (row < NTOK) {
        const float* x = row < NP ? p.x_p + (size_t)row * DM : p.x_s + (size_t)(row - NP) * DM;
#pragma unroll
        for (int i = 0; i < 4; ++i) v[rr][i] = ((const float4*)x)[lane + 64 * i];
      } else {
#pragma unroll
        for (int i = 0; i < 4; ++i) v[rr][i] = make_float4(0.f, 0.f, 0.f, 0.f);
      }
    }
#pragma unroll
    for (int rr = 0; rr < 5; ++rr) {
      float a = 0.f;
#pragma unroll
      for (int i = 0; i < 4; ++i)
        a += v[rr][i].x * v[rr][i].x + v[rr][i].y * v[rr][i].y + v[rr][i].z * v[rr][i].z + v[rr][i].w * v[rr][i].w;
      ss[rr] = a;
    }
#pragma unroll
    for (int off = 32; off > 0; off >>= 1) {
#pragma unroll
      for (int rr = 0; rr < 5; ++rr) ss[rr] += __shfl_xor(ss[rr], off);
    }
    float4 g[4];
#pragma unroll
    for (int i = 0; i < 4; ++i) g[i] = ((const float4*)p.norm_g)[lane + 64 * i];
#pragma unroll
    for (int rr = 0; rr < 5; ++rr) {
      const int row = gw + nw * (k0 + rr);
      if (row < NTOK) {
        const float rstd = rsqrtf(ss[rr] * (1.f / 1024.f) + 1e-6f);
#pragma unroll
        for (int i = 0; i < 4; ++i) {
          h4 o;
          o[0] = (h16)(v[rr][i].x * rstd * g[i].x); o[1] = (h16)(v[rr][i].y * rstd * g[i].y);
          o[2] = (h16)(v[rr][i].z * rstd * g[i].z); o[3] = (h16)(v[rr][i].w * rstd * g[i].w);
          *(h4*)(p.hX + (size_t)row * DM + (lane + 64 * i) * 4) = o;
        }
      }
    }
  }
  transpose_to_h(p.w_in, 1024, INW, INWP, p.Wt_in, smem);
  transpose_to_h(p.w_out, 1024, 1024, 1024, p.Wt_out, smem);
  for (int wt = gw; wt < 256; wt += nw) {
    const int hd = wt >> 5, k0 = ((wt >> 2) & 7) * 32, c0 = (wt & 3) * 32;
    const int r = lane & 31, hh = lane >> 5;
    f16v D;
#pragma unroll
    for (int i = 0; i < 16; ++i) D[i] = 0.f;
#pragma unroll
    for (int t = 0; t < 4; ++t) {
      const float* ap = p.w_uq + (size_t)(k0 + r) * 768 + hd * 96 + 16 * t + 8 * hh;
      const float* bp = p.w_uk + (size_t)(c0 + r) * 512 + hd * 64 + 16 * t + 8 * hh;
      const h8 a = cvt8(*(const float4*)ap, *(const float4*)(ap + 4));
      const h8 bq = cvt8(*(const float4*)bp, *(const float4*)(bp + 4));
      D = MFMA32(a, bq, D);
    }
#pragma unroll
    for (int g4 = 0; g4 < 4; ++g4) {
      const int k = k0 + 8 * g4 + 4 * hh;
      const float4 g = *(const float4*)(p.qn_g + k);
      h4 o;
      o[0] = (h16)(D[4 * g4 + 0] * g.x); o[1] = (h16)(D[4 * g4 + 1] * g.y);
      o[2] = (h16)(D[4 * g4 + 2] * g.z); o[3] = (h16)(D[4 * g4 + 3] * g.w);
      *(h4*)(p.Wq + (size_t)(hd * 128 + c0 + r) * 256 + k) = o;
    }
  }
  for (int idx = gt; idx < 256 * 256; idx += nt) {
    const int n = 1024 + (idx >> 8), k = idx & 255;
    const int hd = (n - 1024) >> 5, rr = (n - 1024) & 31;
    p.Wq[(size_t)n * 256 + k] = (h16)(p.w_uq[(size_t)k * 768 + hd * 96 + 64 + rr] * p.qn_g[k]);
  }
  for (int idx = gt; idx < 8 * 64 * 128; idx += nt) {
    const int j = idx & 7, ln = (idx >> 3) & 63, sq = (idx >> 9) & 1, dt = (idx >> 10) & 3, vt = (idx >> 12) & 1, hd = idx >> 13;
    const int v = 32 * vt + (ln & 31);
    const int c = 32 * dt + 16 * sq + 8 * (j >> 2) + 4 * (ln >> 5) + (j & 3);
    p.Wuv[idx] = (h16)p.w_uv[(size_t)c * 512 + hd * 64 + v];
  }
  for (int idx = gt; idx < 2080 * 16; idx += nt) {
    const int pi = idx >> 4, j = idx & 15;
    const int pos = pi < 2048 ? pi : PAST + (pi - 2048);
    const float ang = (float)pos * c_inv_freq[j];
    float s, c;
    sincos_acc(ang, &s, &c);
    p.ropeC[idx] = c; p.ropeS[idx] = s;
  }
}

template <int BM, int BN, int WGM, int WGN>
DI void gemm_tile(const h16* __restrict__ A, int lda, const h16* __restrict__ B, int ldb, int K, int m0, int n0,
                  char* smem) {
  constexpr int LS = 72, TS = 136;
  constexpr int TM = BM / WGM, TN = BN / WGN, MI = TM / 32, NI = TN / 32;
  constexpr int ACH = BM * 8 / NBLK_THREADS, BCH = BN * 8 / NBLK_THREADS;
  h16* sA = (h16*)smem;
  h16* sB = sA + 3 * BM * LS;
  const int tid = opaque_tid(), lane = tid & 63, w = tid >> 6;
  const int wm = w / WGN, wn = w % WGN;
  const int r = lane & 31, hh = lane >> 5;
  f16v acc[MI][NI];
#pragma unroll
  for (int mi = 0; mi < MI; ++mi)
#pragma unroll
    for (int ni = 0; ni < NI; ++ni)
#pragma unroll
      for (int i = 0; i < 16; ++i) acc[mi][ni][i] = 0.f;
  h8 raA[ACH], rbA[BCH], raB[ACH], rbB[BCH];
  const int KT = K / 64;
#define GLOAD(kt, ra, rb)                                                                           \
  {                                                                                                 \
    _Pragma("unroll") for (int i = 0; i < ACH; ++i) {                                               \
      const int q = tid + NBLK_THREADS * i;                                                         \
      ra[i] = *(const h8*)(A + (size_t)(m0 + (q >> 3)) * lda + (kt) * 64 + (q & 7) * 8);            \
    }                                                                                               \
    _Pragma("unroll") for (int i = 0; i < BCH; ++i) {                                               \
      const int q = tid + NBLK_THREADS * i;                                                         \
      rb[i] = *(const h8*)(B + (size_t)(n0 + (q >> 3)) * ldb + (kt) * 64 + (q & 7) * 8);            \
    }                                                                                               \
  }
#define SSTORE(buf, ra, rb)                                                                         \
  {                                                                                                 \
    _Pragma("unroll") for (int i = 0; i < ACH; ++i) {                                               \
      const int q = tid + NBLK_THREADS * i;                                                         \
      *(h8*)(sA + ((buf) * BM + (q >> 3)) * LS + (q & 7) * 8) = ra[i];                              \
    }                                                                                               \
    _Pragma("unroll") for (int i = 0; i < BCH; ++i) {                                               \
      const int q = tid + NBLK_THREADS * i;                                                         \
      *(h8*)(sB + ((buf) * BN + (q >> 3)) * LS + (q & 7) * 8) = rb[i];                              \
    }                                                                                               \
  }
#define GT_COMPUTE(buf)                                                                             \
  {                                                                                                 \
    const h16* a_base = sA + ((buf) * BM + wm * TM + r) * LS + 8 * hh;                              \
    const h16* b_base = sB + ((buf) * BN + wn * TN + r) * LS + 8 * hh;                              \
    _Pragma("unroll") for (int t = 0; t < 4; ++t) {                                                 \
      h8 af[MI], bf[NI];                                                                            \
      _Pragma("unroll") for (int mi = 0; mi < MI; ++mi) af[mi] = *(const h8*)(a_base + mi * 32 * LS + t * 16); \
      _Pragma("unroll") for (int ni = 0; ni < NI; ++ni) bf[ni] = *(const h8*)(b_base + ni * 32 * LS + t * 16); \
      _Pragma("unroll") for (int mi = 0; mi < MI; ++mi)                                             \
        _Pragma("unroll") for (int ni = 0; ni < NI; ++ni) acc[mi][ni] = MFMA32(bf[ni], af[mi], acc[mi][ni]);   \
    }                                                                                               \
  }
  GLOAD(0, raA, rbA);
  SSTORE(0, raA, rbA);
  if (KT > 1) GLOAD(1, raA, rbA);
  if (KT > 2) GLOAD(2, raB, rbB);
  __syncthreads();
  for (int kt = 0; kt < KT; kt += 2) {
    GT_COMPUTE(kt % 3);
    if (kt + 1 < KT) SSTORE((kt + 1) % 3, raA, rbA);
    if (kt + 3 < KT) GLOAD(kt + 3, raA, rbA);
    __syncthreads();
    if (kt + 1 < KT) {
      GT_COMPUTE((kt + 1) % 3);
      if (kt + 2 < KT) SSTORE((kt + 2) % 3, raB, rbB);
      if (kt + 4 < KT) GLOAD(kt + 4, raB, rbB);
      __syncthreads();
    }
  }
#undef GT_COMPUTE
#undef GLOAD
#undef SSTORE
  h16* T = (h16*)smem;
#pragma unroll
  for (int mi = 0; mi < MI; ++mi)
#pragma unroll
    for (int ni = 0; ni < NI; ++ni)
#pragma unroll
      for (int g4 = 0; g4 < 4; ++g4) {
        h4 o;
#pragma unroll
        for (int jj = 0; jj < 4; ++jj) o[jj] = (h16)acc[mi][ni][4 * g4 + jj];
        *(h4*)(T + (wm * TM + mi * 32 + r) * TS + wn * TN + ni * 32 + 8 * g4 + 4 * hh) = o;
      }
  __syncthreads();
}

template <int OP>
DI void epi_simple(const h16* T, int m0, h16* dst, int ld, int col0, int tid) {
  h8 v[8];
#pragma unroll
  for (int it = 0; it < 8; ++it) {
    const int q = tid + NBLK_THREADS * it;
    v[it] = *(const h8*)(T + (q >> 4) * 136 + (q & 15) * 8);
  }
#pragma unroll
  for (int it = 0; it < 8; ++it) {
    const int q = tid + NBLK_THREADS * it;
    h8 o;
#pragma unroll
    for (int e = 0; e < 8; ++e) {
      const float x = (float)v[it][e];
      o[e] = (OP == 1) ? (h16)silu(x) : (OP == 2) ? (h16)(x * QB_SCALE) : v[it][e];
    }
    *(h8*)(dst + (size_t)(m0 + (q >> 4)) * ld + col0 + (q & 15) * 8) = o;
  }
}
DI float4 f4_lo(h8 v) { return make_float4((float)v[0], (float)v[1], (float)v[2], (float)v[3]); }
DI float4 f4_hi(h8 v) { return make_float4((float)v[4], (float)v[5], (float)v[6], (float)v[7]); }
typedef float f32x4 __attribute__((ext_vector_type(4)));
typedef __attribute__((address_space(3))) unsigned* lds_u32p;
DI int g8_lds_byte(int r, int c) {
  const int st = (r >> 4) * 2 + (c >> 5), rr = r & 15, cc = c & 31, ob = rr * 64 + cc * 2;
  return st * 1024 + (ob ^ (((ob >> 9) & 1) << 5));
}
DI void g8_stage_rc(int b, int& R, int& C) {
  const int st = b / 1024, sb = b % 1024, swz = sb ^ (((sb >> 9) & 1) << 5);
  R = (st >> 1) * 16 + swz / 64;
  C = (st & 1) * 32 + (swz % 64) / 2;
}
#define G8_HT (128 * 64)
DI void gemm8_mainloop(const h16* __restrict__ A, const h16* __restrict__ Bt, int K, int brow, int bcol, char* smem,
                       f32x4 (&acc)[2][2][4][2]) {
  h16* shm = (h16*)smem;
  const int tid = opaque_tid();
  const int wid = tid >> 6, lane = tid & 63, wr = wid >> 2, wc = wid & 3, fr = lane & 15, fq = lane >> 4;
  int so[2];
#pragma unroll
  for (int i = 0; i < 2; ++i) { int R, C; g8_stage_rc(tid * 16 + i * 8192, R, C); so[i] = R * K + C; }
#define G8_SA(b, h) (shm + ((b) * 2 + (h)) * G8_HT)
#define G8_SB(b, h) (shm + (4 + (b) * 2 + (h)) * G8_HT)
#define G8_STAGE(Pp, BASE, br, kt)                                                                        \
  do {                                                                                                    \
    const h16* _bp = (BASE) + (size_t)(br) * K + (kt) * 64;                              \
    _Pragma("unroll") for (int _i = 0; _i < 2; ++_i) {                                                    \
      const h16* _g = _bp + so[_i];                                                                       \
      __builtin_amdgcn_global_load_lds((const unsigned*)_g,                                               \
                                       (lds_u32p)((char*)(Pp) + tid * 16 + _i * 8192), 16, 0, 0);         \
    }                                                                                                     \
  } while (0)
#define G8_LDA(dst, b, h)                                                                                 \
  _Pragma("unroll") for (int m = 0; m < 4; ++m) _Pragma("unroll") for (int k = 0; k < 2; ++k)             \
    dst[m][k] = *(const h8*)((const char*)G8_SA(b, h) + g8_lds_byte(wr * 64 + m * 16 + fr, k * 32 + fq * 8))
#define G8_LDB(dst, b, h)                                                                                 \
  _Pragma("unroll") for (int n = 0; n < 2; ++n) _Pragma("unroll") for (int k = 0; k < 2; ++k)             \
    dst[n][k] = *(const h8*)((const char*)G8_SB(b, h) + g8_lds_byte(wc * 32 + n * 16 + fr, k * 32 + fq * 8))
#define G8_MMA(ai, bj, At, Bq)                                                                            \
  do {                                                                                                    \
    __builtin_amdgcn_s_setprio(1);                                                                        \
    _Pragma("unroll") for (int m = 0; m < 4; ++m) _Pragma("unroll") for (int n = 0; n < 2; ++n)           \
      _Pragma("unroll") for (int k = 0; k < 2; ++k)                                                       \
        acc[ai][bj][m][n] = __builtin_amdgcn_mfma_f32_16x16x32_f16(Bq[n][k], At[m][k], acc[ai][bj][m][n], 0, 0, 0); \
    __builtin_amdgcn_s_setprio(0);                                                                        \
  } while (0)
#define G8_WAIT_V(n) asm volatile("s_waitcnt vmcnt(" #n ")" ::: "memory")
#define G8_WAIT_L(n) asm volatile("s_waitcnt lgkmcnt(" #n ")" ::: "memory")
#define G8_BAR __builtin_amdgcn_s_barrier()
#define G8_SCHED __builtin_amdgcn_sched_barrier(0)
#pragma unroll
  for (int a = 0; a < 2; ++a)
#pragma unroll
    for (int b = 0; b < 2; ++b)
#pragma unroll
      for (int m = 0; m < 4; ++m)
#pragma unroll
        for (int n = 0; n < 2; ++n) acc[a][b][m][n] = f32x4{0.f, 0.f, 0.f, 0.f};
  h8 At[4][2], B0[2][2], B1[2][2];
  const int nt = K / 64;
  G8_STAGE(G8_SB(0, 0), Bt, bcol, 0); G8_STAGE(G8_SA(0, 0), A, brow, 0);
  G8_STAGE(G8_SB(0, 1), Bt, bcol + 128, 0); G8_STAGE(G8_SA(0, 1), A, brow + 128, 0);
  if (wr == 1) G8_BAR;
  G8_WAIT_V(4); G8_BAR;
  G8_STAGE(G8_SB(1, 0), Bt, bcol, 1); G8_STAGE(G8_SA(1, 0), A, brow, 1); G8_STAGE(G8_SB(1, 1), Bt, bcol + 128, 1);
  G8_WAIT_V(6); G8_BAR;
  for (int t = 0; t < nt - 2; t += 2) {
    G8_LDB(B0, 0, 0); G8_SCHED; G8_LDA(At, 0, 0); G8_STAGE(G8_SA(1, 1), A, brow + 128, t + 1);
    G8_WAIT_L(8); G8_BAR; G8_WAIT_L(0); G8_MMA(0, 0, At, B0); G8_BAR; G8_SCHED;
    G8_LDB(B1, 0, 1); G8_STAGE(G8_SB(0, 0), Bt, bcol, t + 2);
    G8_BAR; G8_WAIT_L(0); G8_MMA(0, 1, At, B1); G8_BAR;
    G8_LDA(At, 0, 1); G8_STAGE(G8_SA(0, 0), A, brow, t + 2);
    G8_BAR; G8_WAIT_L(0); G8_MMA(1, 0, At, B0); G8_BAR; G8_SCHED;
    G8_STAGE(G8_SB(0, 1), Bt, bcol + 128, t + 2);
    G8_WAIT_V(6); G8_BAR; G8_MMA(1, 1, At, B1); G8_BAR;
    G8_LDB(B0, 1, 0); G8_SCHED; G8_LDA(At, 1, 0); G8_STAGE(G8_SA(0, 1), A, brow + 128, t + 2);
    G8_WAIT_L(8); G8_BAR; G8_WAIT_L(0); G8_MMA(0, 0, At, B0); G8_BAR; G8_SCHED;
    G8_LDB(B1, 1, 1); G8_STAGE(G8_SB(1, 0), Bt, bcol, t + 3);
    G8_BAR; G8_WAIT_L(0); G8_MMA(0, 1, At, B1); G8_BAR;
    G8_LDA(At, 1, 1); G8_STAGE(G8_SA(1, 0), A, brow, t + 3);
    G8_BAR; G8_WAIT_L(0); G8_MMA(1, 0, At, B0); G8_BAR; G8_SCHED;
    G8_STAGE(G8_SB(1, 1), Bt, bcol + 128, t + 3);
    G8_WAIT_V(6); G8_BAR; G8_MMA(1, 1, At, B1); G8_BAR;
  }
  { G8_LDB(B0, 0, 0); G8_LDA(At, 0, 0); G8_STAGE(G8_SA(1, 1), A, brow + 128, nt - 1);
    G8_BAR; G8_WAIT_L(0); G8_MMA(0, 0, At, B0); G8_BAR;
    G8_LDB(B1, 0, 1); G8_BAR; G8_WAIT_L(0); G8_MMA(0, 1, At, B1); G8_BAR;
    G8_LDA(At, 0, 1); G8_WAIT_V(4); G8_BAR; G8_WAIT_L(0); G8_MMA(1, 0, At, B0); G8_MMA(1, 1, At, B1); G8_BAR; }
  { G8_LDB(B0, 1, 0); G8_LDA(At, 1, 0); G8_WAIT_V(2); G8_BAR; G8_WAIT_L(0); G8_MMA(0, 0, At, B0); G8_BAR;
    G8_LDB(B1, 1, 1); G8_WAIT_V(0); G8_BAR; G8_WAIT_L(0); G8_MMA(0, 1, At, B1); G8_BAR;
    G8_LDA(At, 1, 1); G8_BAR; G8_WAIT_L(0); G8_MMA(1, 0, At, B0); G8_MMA(1, 1, At, B1); G8_BAR; }
  if (wr == 0) G8_BAR;
#undef G8_SA
#undef G8_SB
#undef G8_STAGE
#undef G8_LDA
#undef G8_LDB
#undef G8_MMA
}

DI void p1_epilogue(const P& p, const h16* T, int m0, int n0, int nt, bool isP) {
  constexpr int TS = 136;
  const int tid = opaque_tid(), lane = tid & 63, w = tid >> 6;
  if (nt == 2) {
    const float2 g = *(const float2*)(p.kvn_g + 2 * lane);
    for (int r0 = w; r0 < 256; r0 += 32) {
      float a[4], b[4], ss[4];
#pragma unroll
      for (int k = 0; k < 4; ++k) {
        const h2 v2 = *(const h2*)(T + (r0 + 8 * k) * TS + 2 * lane);
        a[k] = (float)v2[0]; b[k] = (float)v2[1];
        ss[k] = a[k] * a[k] + b[k] * b[k];
      }
#pragma unroll
      for (int off = 32; off > 0; off >>= 1) {
#pragma unroll
        for (int k = 0; k < 4; ++k) ss[k] += __shfl_xor(ss[k], off);
      }
#pragma unroll
      for (int k = 0; k < 4; ++k) {
        const int m = m0 + r0 + 8 * k;
        const float rstd = rsqrtf(ss[k] * (1.f / 128.f) + 1e-6f);
        const float o0 = a[k] * rstd * g.x, o1 = b[k] * rstd * g.y;
        float* oc = isP ? p.out + OFF_P_CKV + (size_t)m * 128 : p.out + OFF_S_CKV + (size_t)(m - NP) * 128;
        *(float2*)(oc + 2 * lane) = make_float2(o0, o1);
        h2 o; o[0] = (h16)o0; o[1] = (h16)o1;
        *(h2*)(p.KM + (size_t)m * 160 + 2 * lane) = o;
      }
    }
  } else if (nt >= 4 && nt <= 6) {
    epi_simple<1>(T, m0, p.GA, 512, n0 - ZC_GA, tid);
  } else if (nt >= 8 && nt <= 10) {
    epi_simple<2>(T, m0, p.QB, 512, n0 - ZC_QB, tid);
  } else if (nt >= 14 && nt <= 16) {
    epi_simple<0>(T, m0, p.QI, 512, n0 - ZC_QI, tid);
  } else if (nt >= 18 && nt <= 20) {
    epi_simple<1>(T, m0, p.GB, 512, n0 - ZC_GB, tid);
  } else {
#pragma unroll 2
    for (int it = 0; it < 8; ++it) {
      const int q = tid + NBLK_THREADS * it;
      const int row = q >> 4, ch = q & 15;
      const int col = n0 + ch * 8, m = m0 + row;
      const int ms = isP ? m : m - NP;
      const h8 v = *(const h8*)(T + row * TS + ch * 8);
      if (col < ZC_CKV) {
        *(h8*)(p.CQ + (size_t)m * 256 + col) = v;
        float ss = 0.f;
#pragma unroll
        for (int e = 0; e < 8; ++e) ss += (float)v[e] * (float)v[e];
        ss += __shfl_xor(ss, 1); ss += __shfl_xor(ss, 2); ss += __shfl_xor(ss, 4); ss += __shfl_xor(ss, 8);
        if (ch == 0) p.RQP[(size_t)m * 2 + nt] = ss;
      } else if (col < ZC_GA) {
        const int j0 = col - ZC_KPE;
        const bool hiHalf = j0 >= 16;
        const h8 u = *(const h8*)(T + row * TS + (hiHalf ? ch - 2 : ch + 2) * 8);
        const int ri = rope_idx(m) * 16 + (j0 & 15);
        const float4 c0 = *(const float4*)(p.ropeC + ri), c1 = *(const float4*)(p.ropeC + ri + 4);
        const float4 s0 = *(const float4*)(p.ropeS + ri), s1 = *(const float4*)(p.ropeS + ri + 4);
        const float cs[8] = {c0.x, c0.y, c0.z, c0.w, c1.x, c1.y, c1.z, c1.w};
        const float sn[8] = {s0.x, s0.y, s0.z, s0.w, s1.x, s1.y, s1.z, s1.w};
        float o[8];
        h8 oh;
#pragma unroll
        for (int e = 0; e < 8; ++e) {
          const float mine = (float)v[e], other = (float)u[e];
          o[e] = hiHalf ? (other * sn[e] + mine * cs[e]) : (mine * cs[e] - other * sn[e]);
          oh[e] = (h16)o[e];
        }
        float* oc = (isP ? p.out + OFF_P_KPE : p.out + OFF_S_KPE) + (size_t)ms * 32 + j0;
        *(float4*)oc = make_float4(o[0], o[1], o[2], o[3]);
        *(float4*)(oc + 4) = make_float4(o[4], o[5], o[6], o[7]);
        *(h8*)(p.KM + (size_t)m * 160 + 128 + j0) = oh;
      } else if (col < ZC_QB) {
        h8 o;
#pragma unroll
        for (int e = 0; e < 8; ++e) o[e] = (h16)silu((float)v[e]);
        *(h8*)(p.GA + (size_t)m * 512 + (col - ZC_GA)) = o;
      } else if (col < ZC_KB) {
        h8 o;
#pragma unroll
        for (int e = 0; e < 8; ++e) o[e] = (h16)((float)v[e] * QB_SCALE);
        *(h8*)(p.QB + (size_t)m * 512 + (col - ZC_QB)) = o;
      } else if (col < ZC_QI) {
        const bool isK = col < ZC_VB;
        const int c0 = col - (isK ? ZC_KB : ZC_VB);
        float* oc = (isK ? (isP ? p.out + OFF_P_K : p.out + OFF_S_K) : (isP ? p.out + OFF_P_V : p.out + OFF_S_V)) +
                    (size_t)ms * 128 + c0;
        *(float4*)oc = f4_lo(v);
        *(float4*)(oc + 4) = f4_hi(v);
        *(h8*)((isK ? p.KB : p.VB) + (size_t)m * 128 + c0) = v;
      } else if (col < ZC_KI) {
        *(h8*)(p.QI + (size_t)m * 512 + (col - ZC_QI)) = v;
      } else if (col < ZC_WI) {
        float* oc = (isP ? p.out + OFF_P_KIDX : p.out + OFF_S_KIDX) + (size_t)ms * 64 + (col - ZC_KI);
        *(float4*)oc = f4_lo(v);
        *(float4*)(oc + 4) = f4_hi(v);
        *(h8*)(p.KI + (size_t)m * 64 + (col - ZC_KI)) = v;
      } else if (col < ZC_GB) {
        float* oc = p.WI + (size_t)m * 8;
        const float4 a = f4_lo(v), b = f4_hi(v);
        *(float4*)oc = make_float4(a.x * WI_SCALE, a.y * WI_SCALE, a.z * WI_SCALE, a.w * WI_SCALE);
        *(float4*)(oc + 4) = make_float4(b.x * WI_SCALE, b.y * WI_SCALE, b.z * WI_SCALE, b.w * WI_SCALE);
      } else if (col < INW) {
        h8 o;
#pragma unroll
        for (int e = 0; e < 8; ++e) o[e] = (h16)silu((float)v[e]);
        *(h8*)(p.GB + (size_t)m * 512 + (col - ZC_GB)) = o;
      }
    }
  }
}

DI void phase1(const P& p, char* smem) {
  constexpr int TS = 136;
  h16* T = (h16*)smem;
  const int ntiles = 68 * 11;
  const int xcd = blockIdx.x & 7, lb = blockIdx.x >> 3, nlb = gridDim.x >> 3;
  const int per = (ntiles + 7) >> 3;
  const int tend = (xcd * per + per) < ntiles ? (xcd * per + per) : ntiles;
  for (int L = xcd * per + lb; L < tend; L += nlb) {
    const int pg = L / 44, rem = L - pg * 44;
    const int pn = rem >> 2, mt = pg * 4 + (rem & 3);
    const int m0 = mt * 256;
    const bool isP = mt < 64;
    f32x4 acc[2][2][4][2];
    gemm8_mainloop(p.hX, p.Wt_in, DM, m0, pn * 256, smem, acc);
    __syncthreads();
    const int tid = opaque_tid();
    const int wid = tid >> 6, lane = tid & 63, wr = wid >> 2, wc = wid & 3, fr = lane & 15, fq = lane >> 4;
#pragma unroll
    for (int bj = 0; bj < 2; ++bj) {
#pragma unroll
      for (int ai = 0; ai < 2; ++ai)
#pragma unroll
        for (int m = 0; m < 4; ++m)
#pragma unroll
          for (int n = 0; n < 2; ++n)
          {
            h4 o;
#pragma unroll
            for (int jj = 0; jj < 4; ++jj) o[jj] = (h16)acc[ai][bj][m][n][jj];
            *(h4*)(T + (ai * 128 + wr * 64 + m * 16 + fr) * TS + wc * 32 + n * 16 + fq * 4) = o;
          }
      __syncthreads();
      p1_epilogue(p, T, m0, pn * 256 + bj * 128, pn * 2 + bj, isP);
      __syncthreads();
    }
  }
}

DI size_t qm_index(int m, int hd, int d) {
  return ((((size_t)(m >> 5) * 8 + hd) * 10 + (d >> 4)) * 64 + (((d >> 3) & 1) * 32 + (m & 31))) * 8 + (d & 7);
}
DI void phase1b(const P& p, char* smem) {
  constexpr int TS = 136;
  h16* T = (h16*)smem;
  float* rq = (float*)(smem + 128 * 1024 - 2048);
  const int ntiles = 68 * 5;
  const int nskip = gridDim.x >= 64 ? 32 : 0;
  if ((int)blockIdx.x < nskip) return;
  for (int tile = blockIdx.x - nskip; tile < ntiles; tile += gridDim.x - nskip) {
    const int mt = tile / 5, pn = tile % 5;
    const int m0 = mt * 256;
    f32x4 acc[2][2][4][2];
    gemm8_mainloop(p.CQ, p.Wq, 256, m0, pn * 256, smem, acc);
    __syncthreads();
    const int tid = opaque_tid();
    if (tid < 256) {
      const float2 pp = *(const float2*)(p.RQP + (size_t)(m0 + tid) * 2);
      rq[tid] = rsqrtf((pp.x + pp.y) * (1.f / 256.f) + 1e-6f) * QM_SCALE;
    }
    const int wid = tid >> 6, lane = tid & 63, wr = wid >> 2, wc = wid & 3, fr = lane & 15, fq = lane >> 4;
#pragma unroll
    for (int bj = 0; bj < 2; ++bj) {
      const int nt = pn * 2 + bj;
#pragma unroll
      for (int ai = 0; ai < 2; ++ai)
#pragma unroll
        for (int m = 0; m < 4; ++m)
#pragma unroll
          for (int n = 0; n < 2; ++n)
          {
            h4 o;
#pragma unroll
            for (int jj = 0; jj < 4; ++jj) o[jj] = (h16)acc[ai][bj][m][n][jj];
            *(h4*)(T + (ai * 128 + wr * 64 + m * 16 + fr) * TS + wc * 32 + n * 16 + fq * 4) = o;
          }
      __syncthreads();
#pragma unroll 2
      for (int it = 0; it < 8; ++it) {
        const int q = tid + NBLK_THREADS * it;
        const int row = q >> 4, ch = q & 15;
        const int m = m0 + row;
        const float sc = rq[row];
        const h8 v = *(const h8*)(T + row * TS + ch * 8);
        h8 o;
        int hd, d0;
        if (nt < 8) {
          hd = nt; d0 = ch * 8;
#pragma unroll
          for (int e = 0; e < 8; ++e) o[e] = (h16)((float)v[e] * sc);
        } else {
          hd = (nt - 8) * 4 + (ch >> 2);
          const int j0 = (ch & 3) * 8;
          d0 = 128 + j0;
          const bool hiHalf = j0 >= 16;
          const h8 u = *(const h8*)(T + row * TS + (hiHalf ? ch - 2 : ch + 2) * 8);
          const int ri = rope_idx(m) * 16 + (j0 & 15);
          const float4 c0 = *(const float4*)(p.ropeC + ri), c1 = *(const float4*)(p.ropeC + ri + 4);
          const float4 s0 = *(const float4*)(p.ropeS + ri), s1 = *(const float4*)(p.ropeS + ri + 4);
          const float cs[8] = {c0.x, c0.y, c0.z, c0.w, c1.x, c1.y, c1.z, c1.w};
          const float sn[8] = {s0.x, s0.y, s0.z, s0.w, s1.x, s1.y, s1.z, s1.w};
#pragma unroll
          for (int e = 0; e < 8; ++e) {
            const float mine = (float)v[e] * sc, other = (float)u[e] * sc;
            o[e] = (h16)(hiHalf ? (other * sn[e] + mine * cs[e]) : (mine * cs[e] - other * sn[e]));
          }
        }
        *(h8*)(p.QM + qm_index(m, hd, d0)) = o;
      }
      __syncthreads();
    }
  }
}

template <bool SAMPLE>
DI void mla_item(const P& p, int b, int tok0, int nkeys, char* smem, const int tid, unsigned* ctr, int& nxt) {
  constexpr int KS = 168;
  h16* sK = (h16*)smem;
  const int lane = tid & 63, w = __builtin_amdgcn_readfirstlane(tid >> 6);
  const int r = lane & 31, hh = lane >> 5;
  const int i16 = lane & 15, q4 = i16 >> 2, p4 = i16 & 3, blk = (lane >> 4) & 1;

  h8 qf[10];
  {
    const h16* qp = p.QM + ((size_t)((tok0 >> 5) * 8 + w) * 10 * 64 + lane) * 8;
#pragma unroll
    for (int t = 0; t < 10; ++t) qf[t] = *(const h8*)(qp + t * 512);
  }
  f16v O[4];
#pragma unroll
  for (int dt = 0; dt < 4; ++dt)
#pragma unroll
    for (int i = 0; i < 16; ++i) O[dt][i] = 0.f;
  float m = NEGBIG, l = 0.f;

  h8 wf[16], gav[4];
#define MLA_EPI_LOADS                                                                                   \
  {                                                                                                     \
    _Pragma("unroll") for (int e = 0; e < 16; ++e)                                                      \
      wf[e] = *(const h8*)(p.Wuv + ((size_t)(((w * 2 + (e & 1)) * 8 + (e >> 1)) * 64 + lane)) * 8);     \
    _Pragma("unroll") for (int i = 0; i < 4; ++i) {                                                     \
      const int q = lane + 64 * i;                                                                      \
      gav[i] = *(const h8*)(p.GA + (size_t)(tok0 + (q >> 3)) * 512 + w * 64 + (q & 7) * 8);             \
    }                                                                                                   \
  }
  h8 sh[3];
  float4 sf[3][2];
  const int NT = (nkeys + 63) >> 6;

#define MLA_GLOAD(kt)                                                                                          \
  {                                                                                                            \
    _Pragma("unroll") for (int i = 0; i < 3; ++i) {                                                            \
      const int q = tid + NBLK_THREADS * i;                                                                    \
      const int row = q / 20, cc = q % 20;                                                                     \
      const int s = (kt) * 64 + row;                                                                           \
      if (q < 1280) {                                                                                          \
        if (!SAMPLE) {                                                                                         \
          sh[i] = *(const h8*)(p.KM + (size_t)(b * 2048 + s) * 160 + cc * 8);                                  \
        } else {                                                                                               \
          if ((kt) * 64 + 63 < PAST || s < PAST) {           \
            const float* src = (cc < 16) ? p.c_ckv + ((size_t)(b * PAST + s) * 128 + cc * 8)                   \
                                         : p.c_kpe + ((size_t)(b * PAST + s) * 32 + (cc - 16) * 8);            \
            sf[i][0] = *(const float4*)src; sf[i][1] = *(const float4*)(src + 4);                              \
          } else if (s < SKEYS) {                                                                              \
            sf[i][0] = __builtin_bit_cast(float4, *(const h8*)(p.KM + (size_t)(NP + b * 32 + (s - PAST)) * 160 + cc * 8)); \
          } else {                                                                                             \
            sf[i][0] = make_float4(0.f, 0.f, 0.f, 0.f);                                                        \
          }                                                                                                    \
        }                                                                                                      \
      }                                                                                                        \
    }                                                                                                          \
  }
#define MLA_SSTORE(kt, buf)                                                                                    \
  {                                                                                                            \
    _Pragma("unroll") for (int i = 0; i < 3; ++i) {                                                            \
      const int q = tid + NBLK_THREADS * i;                                                                    \
      const int row = q / 20, cc = q % 20;                                                                     \
      const int s = (kt) * 64 + row;                                                                           \
      if (q < 1280) {                                                                                          \
        h8 v;                                                                                                  \
        if (SAMPLE) v = ((kt) * 64 + 63 < PAST || s < PAST) ? cvt8(sf[i][0], sf[i][1]) : __builtin_bit_cast(h8, sf[i][0]); \
        else v = sh[i];                                                                                        \
        *(h8*)(sK + ((buf) * 64 + row) * KS + cc * 8) = v;                                                     \
      }                                                                                                        \
    }                                                                                                          \
  }

  if constexpr (!SAMPLE) {
  constexpr unsigned TB = 64 * KS * 2;
  unsigned goffb[3], loffb[3];
#pragma unroll
  for (int i = 0; i < 3; ++i) {
    const int q = tid + NBLK_THREADS * i;
    const int row = q / 20, cc = q % 20;
    goffb[i] = (unsigned)(row * 160 + cc * 8) * 2u;
    loffb[i] = (unsigned)(row * KS + cc * 8) * 2u;
  }
  const char* kmb = (const char*)(p.KM + (size_t)b * 2048 * 160);
  const unsigned sKo = lds_off(sK);
  const unsigned ka_off = sKo + (unsigned)(r * KS + 8 * hh) * 2u;
  const unsigned vb_off = sKo + (unsigned)((4 * hh + q4) * KS + 16 * blk + 4 * p4) * 2u;
#define MLAP_GLOAD(kt)                                                                                   \
  {                                                                                                      \
    const char* _src = kmb + (size_t)(kt) * (64 * 160 * 2);                                              \
    _Pragma("unroll") for (int i = 0; i < 3; ++i)                                                        \
      if (i < 2 || tid < 256) sh[i] = *(const h8*)(_src + goffb[i]);                                     \
  }
#define MLAP_SSTORE(buf)                                                                                 \
  {                                                                                                      \
    const unsigned _dst = sKo + (unsigned)(buf) * TB;                                                    \
    _Pragma("unroll") for (int i = 0; i < 3; ++i)                                                        \
      if (i < 2 || tid < 256) *(lds_h8p)(uintptr_t)(_dst + loffb[i]) = sh[i];                            \
  }
#define HS_VL(f, kv)                                                                                     \
  vf[(f) & 3] = cat8(lds_tr((kv) + (((f) >> 2) * 16 * KS + 32 * ((f) & 3)) * 2),                         \
                     lds_tr((kv) + (((f) >> 2) * 16 * KS + 32 * ((f) & 3) + 8 * KS) * 2));
#define HS_FILL(s, Sc, pbc)                                                                              \
  if ((s) < 16) {                                                                                        \
    const float e = fast_exp2(Sc[(s) & 15]);                                                             \
    Sc[(s) & 15] = e;                                                                                    \
    if ((s) & 1) rs1 += e; else rs0 += e;                                                                \
  }                                                                                                      \
  if ((s) >= 3 && ((s) & 1)) {                                                                           \
    const int _j = (((s) - 3) / 2) & 7;                                                                  \
    pbc[_j >> 2][2 * (_j & 3)] = (h16)Sc[2 * _j];                                                        \
    pbc[_j >> 2][2 * (_j & 3) + 1] = (h16)Sc[2 * _j + 1];                                                \
  }
#define MLAP_HALFSTEP(Sc, Sx, pbp, pbc, kq, kv, chk)                                                     \
  {                                                                                                      \
    float rs0 = 0.f, rs1 = 0.f, mx = NEGBIG;                                                             \
    h8 ka[3], vf[4];                                                                                     \
    _Pragma("unroll") for (int t = 0; t < 3; ++t) ka[t] = lds_ld8((kq) + 32 * t);                        \
    _Pragma("unroll") for (int t = 0; t < 10; ++t) {                                                     \
      Sx = MFMA32(ka[t % 3], qf[t], (t == 0) ? NM : Sx);         \
      if (t + 3 < 10) ka[t % 3] = lds_ld8((kq) + 32 * (t + 3));                                          \
      if (t >= 6) { HS_VL(t - 6, kv) }                                                                   \
      HS_FILL(t, Sc, pbc)                                                                                \
      __builtin_amdgcn_sched_barrier(0);                                                                 \
    }                                                                                                    \
    _Pragma("unroll") for (int f = 0; f < 8; ++f) {                                                      \
      O[f & 3] = MFMA32(vf[f & 3], pbp[f >> 2], O[f & 3]);                                               \
      if (f + 4 < 8) { HS_VL(f + 4, kv) }                                                                \
      HS_FILL(10 + f, Sc, pbc)                                                                           \
      if (f == 3) mx = max3f(mx, Sx[0], Sx[1]);                                                          \
      if (f == 4) mx = max3f(mx, Sx[2], Sx[3]);                                                          \
      if (f == 5) { mx = max3f(mx, Sx[4], Sx[5]); mx = max3f(mx, Sx[6], Sx[7]); }                        \
      if (f == 6) { mx = max3f(mx, Sx[8], Sx[9]); mx = max3f(mx, Sx[10], Sx[11]); }                      \
      if (f == 7) { mx = max3f(mx, Sx[12], Sx[13]); mx = max3f(mx, Sx[14], Sx[15]); }                    \
      __builtin_amdgcn_sched_barrier(0);                                                                 \
    }                                                                                                    \
    l += rs0 + rs1;                                                                                      \
    if (chk) {                                                                                           \
      mx = xhalf_max(mx);                                                                                \
      if (__builtin_expect(__any(mx > RESC_T), 0)) {   \
        const float d = fmaxf(mx, 0.f);   \
        const float alpha = fast_exp2(-d);                                                               \
        _Pragma("unroll") for (int i = 0; i < 16; ++i) { NM[i] -= d; Sx[i] -= d; }                       \
        l *= alpha;                                                                                      \
        const h16 ah = (h16)alpha;                                                                       \
        _Pragma("unroll") for (int g = 0; g < 2; ++g)                                                    \
          _Pragma("unroll") for (int jj = 0; jj < 8; ++jj) pbc[g][jj] *= ah;                             \
        _Pragma("unroll") for (int dt = 0; dt < 4; ++dt)                                                 \
          _Pragma("unroll") for (int i = 0; i < 16; ++i) O[dt][i] *= alpha;                              \
      }                                                                                                  \
    }                                                                                                    \
  }
  MLAP_GLOAD(0);
#pragma unroll
  for (int t = 0; t < 10; ++t) pin8(qf[t]);
  MLAP_SSTORE(0);
  if (NT > 1) { MLAP_GLOAD(1); MLAP_SSTORE(1); }
  __syncthreads();
  f16v SA, SB;
  f16v NM;
  h8 pbA[2], pbB[2];
  pbA[0] = zero8(); pbA[1] = zero8(); pbB[0] = zero8(); pbB[1] = zero8();
  {
#pragma unroll
    for (int i = 0; i < 16; ++i) SA[i] = 0.f;
#pragma unroll
    for (int t = 0; t < 10; ++t) SA = MFMA32(lds_ld8(ka_off + 32 * t), qf[t], SA);
    mfma_settle();
    float mx = max3f(SA[0], SA[1], SA[2]);
#pragma unroll
    for (int i = 3; i < 15; i += 2) mx = max3f(mx, SA[i], SA[i + 1]);
    mx = fmaxf(mx, SA[15]);
    m = xhalf_max(mx);
#pragma unroll
    for (int i = 0; i < 16; ++i) { NM[i] = -m; SA[i] -= m; }
  }
  for (int kt = 0; kt < NT; ++kt) {
    const bool more = kt + 1 < NT;
    if (kt + 2 < NT) MLAP_GLOAD(kt + 2);
    const unsigned bc = (unsigned)(kt & 3) * TB, bn = (unsigned)((kt + 1) & 3) * TB;
    const unsigned bp = (kt > 0) ? (unsigned)((kt - 1) & 3) * TB + 32u * KS * 2u : 0u;
    {
      const unsigned kq = opaque_u(ka_off + bc + 32u * KS * 2u), kv = opaque_u(vb_off + bp);
      MLAP_HALFSTEP(SA, SB, pbB, pbA, kq, kv, true);
    }
    {
      const unsigned kq = opaque_u(ka_off + bn), kv = opaque_u(vb_off + bc);
      MLAP_HALFSTEP(SB, SA, pbA, pbB, kq, kv, more);
    }
    if (kt + 2 < NT) MLAP_SSTORE((kt + 2) & 3);
    __syncthreads();
  }
  MLA_EPI_LOADS;
  {
    const unsigned kv = opaque_u(vb_off + (unsigned)((NT - 1) & 3) * TB + 32u * KS * 2u);
    h8 vf[4];
#pragma unroll
    for (int f = 0; f < 4; ++f) { HS_VL(f, kv) }
#pragma unroll
    for (int f = 0; f < 8; ++f) {
      O[f & 3] = MFMA32(vf[f & 3], pbB[f >> 2], O[f & 3]);
      if (f + 4 < 8) { HS_VL(f + 4, kv) }
    }
  }
#undef MLAP_GLOAD
#undef MLAP_SSTORE
#undef HS_VL
#undef HS_FILL
#undef MLAP_HALFSTEP
  } else {
  MLA_GLOAD(0);
#pragma unroll
  for (int t = 0; t < 10; ++t) pin8(qf[t]);
  MLA_SSTORE(0, 0);
  __syncthreads();
  int buf = 0;
  for (int kt = 0; kt < NT; ++kt) {
    if (kt + 1 < NT) MLA_GLOAD(kt + 1);
    const bool two = (nkeys - kt * 64) > 32;
    const h16* kbase = sK + buf * 64 * KS;
    const h16* ka_ptr = kbase + r * KS + 8 * hh;
    const h16* vb_ptr = kbase + (4 * hh + q4) * KS + 16 * blk + 4 * p4;
    f16v S0, S1;
#pragma unroll
    for (int i = 0; i < 16; ++i) { S0[i] = 0.f; S1[i] = 0.f; }
    {
      h8 ka0[3], ka1[3];
#pragma unroll
      for (int t = 0; t < 3; ++t) {
        ka0[t] = *(const h8*)(ka_ptr + 16 * t);
        ka1[t] = *(const h8*)(ka_ptr + 32 * KS + 16 * t);
      }
#pragma unroll
      for (int t = 0; t < 10; ++t) {
        S0 = MFMA32(ka0[t % 3], qf[t], S0);
        S1 = MFMA32(ka1[t % 3], qf[t], S1);
        if (t + 3 < 10) {
          ka0[t % 3] = *(const h8*)(ka_ptr + 16 * (t + 3));
          ka1[t % 3] = *(const h8*)(ka_ptr + 32 * KS + 16 * (t + 3));
        }
      }
    }
    h8 vf[4];
#define MLA_VLOAD(f)                                                                   \
  {                                                                                    \
    const h16* vp = vb_ptr + ((((f) >> 3) * 32) + ((((f) >> 2) & 1) * 16)) * KS + 32 * ((f) & 3); \
    vf[(f) & 3] = cat8(trread(vp), trread(vp + 8 * KS));                               \
  }
#pragma unroll
    for (int f = 0; f < 4; ++f) MLA_VLOAD(f);
    if (!two) {
      asm volatile("" ::: "memory");
#pragma unroll
      for (int i = 0; i < 16; ++i) S1[i] = NEGBIG;
    }
    mfma_settle();
    float mx = max3f(S0[0], S0[1], S1[0]);
    mx = max3f(mx, S1[1], S0[2]);
#pragma unroll
    for (int i = 2; i < 15; ++i) mx = max3f(mx, S1[i], S0[i + 1]);
    mx = fmaxf(mx, S1[15]);
    mx = xhalf_max(mx);
    if (__builtin_expect(__any(mx > m + RESC_T), 0)) {
      const float mn = fmaxf(m, mx);
      const float alpha = fast_exp2(m - mn);
      m = mn;
      l *= alpha;
#pragma unroll
      for (int dt = 0; dt < 4; ++dt)
#pragma unroll
        for (int i = 0; i < 16; ++i) O[dt][i] *= alpha;
    }
    {
      const f2v m2 = {m, m};
      f2v rs2 = {0.f, 0.f};
#pragma unroll
      for (int i = 0; i < 16; i += 2) {
        f2v a = {S0[i], S0[i + 1]};
        f2v b = {S1[i], S1[i + 1]};
        a -= m2; b -= m2;
        a[0] = fast_exp2(a[0]); a[1] = fast_exp2(a[1]);
        b[0] = fast_exp2(b[0]); b[1] = fast_exp2(b[1]);
        rs2 += a; rs2 += b;
        S0[i] = a[0]; S0[i + 1] = a[1]; S1[i] = b[0]; S1[i + 1] = b[1];
      }
      l += rs2[0] + rs2[1];
    }
    h8 pb[4];
#pragma unroll
    for (int g = 0; g < 4; ++g)
#pragma unroll
      for (int jj = 0; jj < 8; ++jj) pb[g][jj] = (h16)((g < 2) ? S0[8 * (g & 1) + jj] : S1[8 * (g & 1) + jj]);
#pragma unroll
    for (int f = 0; f < 16; ++f) {
      O[f & 3] = MFMA32(vf[f & 3], pb[f >> 2], O[f & 3]);
      if (f + 4 < 16) MLA_VLOAD(f + 4);
    }
#undef MLA_VLOAD
    if (kt + 1 < NT) MLA_SSTORE(kt + 1, buf ^ 1);
    __syncthreads();
    buf ^= 1;
  }
  }
  if constexpr (SAMPLE) MLA_EPI_LOADS;
#undef MLA_EPI_LOADS
#undef MLA_GLOAD
#undef MLA_SSTORE
  if (threadIdx.x == 0) nxt = (int)atomicAdd(ctr, 1u);
  const float inv = 1.f / (l + __shfl_xor(l, 32));
  f16v Y[2];
#pragma unroll
  for (int vt = 0; vt < 2; ++vt)
#pragma unroll
    for (int i = 0; i < 16; ++i) Y[vt][i] = 0.f;
#pragma unroll
  for (int dt = 0; dt < 4; ++dt) {
#pragma unroll
    for (int s = 0; s < 2; ++s) {
      h8 ob;
#pragma unroll
      for (int j = 0; j < 8; ++j) ob[j] = (h16)(O[dt][8 * s + j] * inv);
#pragma unroll
      for (int vt = 0; vt < 2; ++vt) {
        Y[vt] = MFMA32(wf[(dt * 2 + s) * 2 + vt], ob, Y[vt]);
      }
    }
  }
  h16* Yt = SAMPLE ? (h16*)(smem + 43008) + w * (32 * 72)
                   : (h16*)(smem + ((NT + 1 + (w >> 2)) & 3) * 21504) + (w & 3) * (32 * 72);
#pragma unroll
  for (int vt = 0; vt < 2; ++vt) {
#pragma unroll
    for (int g4 = 0; g4 < 4; ++g4) {
      h4 o;
#pragma unroll
      for (int j = 0; j < 4; ++j) o[j] = (h16)Y[vt][4 * g4 + j];
      *(h4*)(Yt + r * 72 + 32 * vt + 8 * g4 + 4 * hh) = o;
    }
  }
  wavebar();
#pragma unroll
  for (int i = 0; i < 4; ++i) {
    const int q = lane + 64 * i;
    const int row = q >> 3, ch = q & 7;
    const h8 y = *(const h8*)(Yt + row * 72 + ch * 8);
    const h8 ga = gav[i];
    h8 o;
#pragma unroll
    for (int j = 0; j < 8; ++j) o[j] = (h16)((float)y[j] * (float)ga[j]);
    *(h8*)(p.mix + (size_t)(tok0 + row) * 1024 + w * 64 + ch * 8) = o;
  }
  __syncthreads();
}

DI unsigned wave_prefix_incl(unsigned x) {
  x += (unsigned)__builtin_amdgcn_update_dpp(0, (int)x, 0x111, 0xf, 0xf, true);
  x += (unsigned)__builtin_amdgcn_update_dpp(0, (int)x, 0x112, 0xf, 0xf, true);
  x += (unsigned)__builtin_amdgcn_update_dpp(0, (int)x, 0x114, 0xf, 0xf, true);
  x += (unsigned)__builtin_amdgcn_update_dpp(0, (int)x, 0x118, 0xf, 0xf, true);
  x += (unsigned)__builtin_amdgcn_update_dpp(0, (int)x, 0x142, 0xa, 0xf, true);
  x += (unsigned)__builtin_amdgcn_update_dpp(0, (int)x, 0x143, 0xc, 0xf, true);
  return x;
}
#define SEL_CAP 256
DI int sel_bin(float v, float lo, float scale, bool degen) {
  if (degen) return v > lo ? 1023 : 0;
  int b = (int)((v - lo) * scale);
  return b > 1023 ? 1023 : b;
}
template <int NR, int NH>
DI void wave_select(const float* sc, int N, unsigned* maskrow, unsigned* hist, float* candv, int* candi, int lane,
                 float (&vpre)[NR], const float* scnext, float rowlo, float rowhi) {
  const int nwords = N >> 5;
  if (lane == 0) maskrow[nwords] = 0u;
  if (N <= 256) {
    for (int wd = lane; wd < nwords; wd += 64) maskrow[wd] = 0xffffffffu;
    return;
  }
  float v[NR];
#define SEL_LOAD(hf)                                                     \
  {                                                                      \
    _Pragma("unroll") for (int i = 0; i < NR; ++i) {                     \
      const int e = 64 * ((hf) * NR + i) + lane;                         \
      v[i] = (e < N) ? sc[e] : -INFINITY;                                \
    }                                                                    \
  }
  if (NH == 1) {
#pragma unroll
    for (int i = 0; i < NR; ++i) v[i] = vpre[i];
    if (scnext) {
#pragma unroll
      for (int i = 0; i < NR; ++i) {
        const int e = 64 * i + lane;
        vpre[i] = (e < N) ? scnext[e] : -INFINITY;
      }
    }
  }
  float lo = __builtin_bit_cast(float, __builtin_amdgcn_readfirstlane(__builtin_bit_cast(int, rowlo)));
  float hi = __builtin_bit_cast(float, __builtin_amdgcn_readfirstlane(__builtin_bit_cast(int, rowhi)));
  int need = 256;
  int T = 0, above = 0;
  float scale = 0.f;
  bool degen = false;
  bool rankmode = false;
  bool first = true;
  for (int iter = 0; iter < 64; ++iter) {
    if (__builtin_expect(!(lo < hi), 0)) break;
    scale = 1024.f / (hi - lo);
    degen = !(scale < 1.0e37f);
    {
      const uint4 z4 = make_uint4(0u, 0u, 0u, 0u);
#pragma unroll
      for (int i = 0; i < 4; ++i) *(uint4*)(hist + 16 * lane + 4 * i) = z4;
    }
    wavebar();
    if (__builtin_expect(first && !degen, 1)) {
#define SEL_HISTO(arr, hf)                                                     \
      _Pragma("unroll") for (int i = 0; i < NR; ++i) {                         \
        const int eb = 64 * ((hf) * NR + i);                                   \
        if (eb < N) {                                         \
          int bn = (int)((arr[i] - lo) * scale);                               \
          bn = bn > 1023 ? 1023 : bn;                                          \
          if (eb + 64 <= N) atomicAdd(&hist[bn], 1u);                          \
          else if (eb + lane < N) atomicAdd(&hist[bn], 1u);                    \
        }                                                                      \
      }
      if constexpr (NH == 2) {
        SEL_LOAD(0);
#pragma unroll
        for (int i = 0; i < NR; ++i) {
          const int e = 64 * (NR + i) + lane;
          vpre[i] = (e < N) ? sc[e] : -INFINITY;
        }
        SEL_HISTO(v, 0)
        SEL_HISTO(vpre, 1)
      } else {
#pragma unroll 1
        for (int hf = 0; hf < NH; ++hf) {
          if (NH > 1) SEL_LOAD(hf);
          SEL_HISTO(v, hf)
        }
      }
#undef SEL_HISTO
    } else {
#pragma unroll 1
      for (int hf = 0; hf < NH; ++hf) {
        if (NH > 1) SEL_LOAD(hf);
#pragma unroll
        for (int i = 0; i < NR; ++i) {
          if (v[i] >= lo && v[i] <= hi) atomicAdd(&hist[sel_bin(v[i], lo, scale, degen)], 1u);
          if ((i & 7) == 7) __builtin_amdgcn_sched_barrier(0);
        }
      }
    }
    wavebar();
    unsigned ssum = 0;
#pragma unroll
    for (int i = 0; i < 16; ++i) ssum += hist[16 * lane + i];
    const unsigned pre = wave_prefix_incl(ssum);
    const unsigned tot = (unsigned)__builtin_amdgcn_readlane((int)pre, 63);
    const unsigned sufx = tot - pre;
    const unsigned x = sufx + ssum;
    const bool cross = (sufx < (unsigned)need) && (x >= (unsigned)need);
    int myT = 0, myAbove = 0, myC = 0;
    if (cross) {
      unsigned run = sufx;
      for (int i = 15; i >= 0; --i) {
        const unsigned c = hist[16 * lane + i];
        if (run + c >= (unsigned)need) { myT = 16 * lane + i; myAbove = (int)run; myC = (int)c; break; }
        run += c;
      }
    }
    const unsigned long long bal = __ballot(cross);
    const int src = bal ? (int)__builtin_ctzll(bal) : 0;
    T = __builtin_amdgcn_readlane(myT, src); above = __builtin_amdgcn_readlane(myAbove, src);
    const int cT = __builtin_amdgcn_readlane(myC, src);
    if (__builtin_expect(cT <= SEL_CAP, 1)) { rankmode = true; break; }
    first = false;
    need -= above;
    float nlo = INFINITY, nhi = -INFINITY;
#pragma unroll 1
    for (int hf = 0; hf < NH; ++hf) {
      if (NH > 1) SEL_LOAD(hf);
#pragma unroll
      for (int i = 0; i < NR; ++i) {
        if (v[i] >= lo && v[i] <= hi && sel_bin(v[i], lo, scale, degen) == T) { nlo = fminf(nlo, v[i]); nhi = fmaxf(nhi, v[i]); }
      }
    }
    lo = __builtin_bit_cast(float, __builtin_amdgcn_readfirstlane(__builtin_bit_cast(int, wave_min(nlo))));
    hi = __builtin_bit_cast(float, __builtin_amdgcn_readfirstlane(__builtin_bit_cast(int, wave_max(nhi))));
  }
  const int pick = rankmode ? need - above : need;
  int running = 0;
  const bool fastfinal = rankmode && first && !degen;
#pragma unroll 1
  for (int hf = 0; hf < NH; ++hf) {
    if (NH > 1) {
      if (NH == 2 && fastfinal) {
        if (hf == 1) {
#pragma unroll
          for (int i = 0; i < NR; ++i) v[i] = vpre[i];
        }
      } else {
        SEL_LOAD(hf);
      }
    }
    int mlo = 0, mhi = 0;
#define FIN_GROUP(I)                                                                                    \
    if constexpr ((I) < NR) {                                                                           \
      const int eb = 64 * (hf * NR + (I));                                                              \
      if (eb < N) {                                                                    \
        const float vv = v[(I)];                                                                        \
        unsigned long long bs, bc;                                                                      \
        if (__builtin_expect(fastfinal, 1)) {                                                           \
          int bn = (int)((vv - lo) * scale);   \
          bn = bn > 1023 ? 1023 : bn;                                                                   \
          bs = __ballot(bn > T);                                                                        \
          bc = __ballot(bn == T);                                                                       \
        } else {                                                                                        \
          bool s_ = vv > hi;                                                                            \
          bool c_;                                                                                      \
          if (rankmode) {                                                                               \
            const bool inr = (vv >= lo && vv <= hi);                                                    \
            const int bn = inr ? sel_bin(vv, lo, scale, degen) : -1;                                    \
            s_ = s_ || (bn > T);                                                                        \
            c_ = (bn == T);                                                                             \
          } else {                                                                                      \
            c_ = (vv == hi);                                                                            \
          }                                                                                             \
          bc = __ballot(c_);                                                                            \
          if (!rankmode) {                                                                              \
            const int pos = running + (int)__builtin_amdgcn_mbcnt_hi((unsigned)(bc >> 32), __builtin_amdgcn_mbcnt_lo((unsigned)bc, 0u)); \
            s_ = s_ || (c_ && pos < pick);                                                              \
          }                                                                                             \
          bs = __ballot(s_);                                                                            \
        }                                                                                               \
        if (__builtin_expect(bc != 0ull, 0)) {                                   \
          if (rankmode) {                                                                               \
            const bool c_ = (bc >> lane) & 1ull;                                                        \
            const int pos = running + (int)__builtin_amdgcn_mbcnt_hi((unsigned)(bc >> 32), __builtin_amdgcn_mbcnt_lo((unsigned)bc, 0u)); \
            if (c_) { candv[pos] = vv; candi[pos] = eb + lane; }                                        \
          }                                                                                             \
          running += __popcll(bc);                                                                      \
        }                                                                                               \
        asm volatile("s_nop 1\n\tv_writelane_b32 %0, %2, " #I "\n\tv_writelane_b32 %1, %3, " #I         \
                     : "+v"(mlo), "+v"(mhi)                                                            \
                     : "s"(__builtin_amdgcn_readfirstlane((int)(unsigned)bs)),                          \
                       "s"(__builtin_amdgcn_readfirstlane((int)(unsigned)(bs >> 32))));                 \
      }                                                                                                 \
    }
    FIN_GROUP(0) FIN_GROUP(1) FIN_GROUP(2) FIN_GROUP(3) FIN_GROUP(4) FIN_GROUP(5) FIN_GROUP(6) FIN_GROUP(7)
    __builtin_amdgcn_sched_barrier(0);
    FIN_GROUP(8) FIN_GROUP(9) FIN_GROUP(10) FIN_GROUP(11) FIN_GROUP(12) FIN_GROUP(13) FIN_GROUP(14) FIN_GROUP(15)
    __builtin_amdgcn_sched_barrier(0);
    FIN_GROUP(16) FIN_GROUP(17) FIN_GROUP(18) FIN_GROUP(19) FIN_GROUP(20) FIN_GROUP(21) FIN_GROUP(22) FIN_GROUP(23)
    __builtin_amdgcn_sched_barrier(0);
    FIN_GROUP(24) FIN_GROUP(25) FIN_GROUP(26) FIN_GROUP(27) FIN_GROUP(28) FIN_GROUP(29) FIN_GROUP(30) FIN_GROUP(31)
    __builtin_amdgcn_sched_barrier(0);
    FIN_GROUP(32)
#undef FIN_GROUP
    {
      const int wd = 2 * (hf * NR + lane);
      if (lane < NR && wd < nwords) {
        maskrow[wd] = (unsigned)mlo;
        if (wd + 1 < nwords) maskrow[wd + 1] = (unsigned)mhi;
      }
    }
  }
#undef SEL_LOAD
  if (rankmode) {
    wavebar();
    const int ncand = running;
    for (int i = lane; i < ncand; i += 64) {
      const float vi = candv[i];
      const int ii = candi[i];
      int rank = 0;
      for (int j = 0; j < ncand; ++j) {
        const float vj = candv[j];
        const int ij = candi[j];
        rank += ((vj > vi) || (vj == vi && ij < ii)) ? 1 : 0;
      }
      if (rank < pick) atomicOr(&maskrow[ii >> 5], 1u << (ii & 31));
    }
  }
  wavebar();
}

template <bool SAMPLE>
DI void dsa_item(const P& p, int b, int tok0, int qpos0, int nkeys, float* sc, int scs,
                         char* smem, const int tid, unsigned* ctr, int& nxt) {
  const int lane = tid & 63, w = __builtin_amdgcn_readfirstlane(tid >> 6);
  const int r = lane & 31, hh = lane >> 5;
  const int NT = (nkeys + 63) >> 6;
  unsigned* sMask = (unsigned*)(smem + 73728);
  float* sBias = (float*)(smem + 73728 + 32 * MASK_W * 4);
  float* sBT = sBias + 256;
  float rmn0 = INFINITY, rmx0 = -INFINITY, rmn1 = INFINITY, rmx1 = -INFINITY;
  {
    constexpr int LS = 72;
    h16* sKI = (h16*)smem;
    const int NTA = (nkeys + 127) >> 7;
    h8 ai[4];
    {
      const int aq = ((r >> 2) & 1) * 2 + (r >> 4), ah = (r & 3) + 4 * ((r >> 3) & 1);
      const h16* qp = p.QI + ((size_t)(tok0 + 4 * w + aq) * 8 + ah) * 64 + 8 * hh;
#pragma unroll
      for (int t = 0; t < 4; ++t) ai[t] = *(const h8*)(qp + 16 * t);
    }
    float w16[16];
#pragma unroll
    for (int i = 0; i < 16; ++i)
      w16[i] = p.WI[(size_t)(tok0 + 4 * w + 2 * hh + (i >> 3)) * 8 + (i & 3) + 4 * ((i >> 2) & 1)];
    h8 shA[2], shB[2];
    float4 sfA[2][2], sfB[2][2];
#define KI_GLOAD(kt, sh, sf)                                                                          \
  {                                                                                                   \
    _Pragma("unroll") for (int i = 0; i < 2; ++i) {                                                   \
      const int q = tid + NBLK_THREADS * i;                                                           \
      const int s = (kt) * 128 + (q >> 3), lcc = q & 7;                                               \
      if (!SAMPLE) {                                                                                  \
        sh[i] = (s < nkeys) ? *(const h8*)(p.KI + (size_t)(b * 2048 + s) * 64 + lcc * 8) : zero8();   \
      } else if ((kt) * 128 + 127 < PAST || s < PAST) {   \
        const float* src = p.c_kidx + ((size_t)(b * PAST + s) * 64 + lcc * 8);                        \
        sf[i][0] = *(const float4*)src; sf[i][1] = *(const float4*)(src + 4);                         \
      } else if (s < SKEYS) {                                                                         \
        sf[i][0] = __builtin_bit_cast(float4, *(const h8*)(p.KI + (size_t)(NP + b * 32 + (s - PAST)) * 64 + lcc * 8)); \
      } else {                                                                                        \
        sf[i][0] = make_float4(0.f, 0.f, 0.f, 0.f);                                                   \
      }                                                                                               \
    }                                                                                                 \
  }
#define KI_SSTORE(kt, buf, sh, sf)                                                                    \
  {                                                                                                   \
    _Pragma("unroll") for (int i = 0; i < 2; ++i) {                                                   \
      const int q = tid + NBLK_THREADS * i;                                                           \
      const int s = (kt) * 128 + (q >> 3), lcc = q & 7;                                               \
      h8 v;                                                                                           \
      if (SAMPLE) v = ((kt) * 128 + 127 < PAST || s < PAST) ? cvt8(sf[i][0], sf[i][1]) : __builtin_bit_cast(h8, sf[i][0]); \
      else v = sh[i];                                                                                 \
      *(h8*)(sKI + ((buf) * 128 + (q >> 3)) * LS + lcc * 8) = v;                                      \
    }                                                                                                 \
  }
#define IDX_TILE(kt, buf)                                                                             \
  {                                                                                                   \
    const h16* kbase = sKI + (buf) * 128 * LS + r * LS + 8 * hh;                                      \
    _Pragma("unroll") for (int sub = 0; sub < 4; ++sub) {                                             \
      const int key0 = (kt) * 128 + 32 * sub;                                                         \
      if (key0 < nkeys) {                                                            \
        f16v D;                                                                                       \
        _Pragma("unroll") for (int i = 0; i < 16; ++i) D[i] = 0.f;                                    \
        _Pragma("unroll") for (int t = 0; t < 4; ++t) {                                               \
          const h8 bf = *(const h8*)(kbase + 32 * sub * LS + 16 * t);                                 \
          D = MFMA32(ai[t], bf, D);                                                                   \
        }                                                                                             \
        float ps0 = 0.f, ps1 = 0.f;   \
        _Pragma("unroll") for (int i = 0; i < 8; ++i) {                                               \
          ps0 = fmaf(relu1(D[i]), w16[i], ps0);                                                       \
          ps1 = fmaf(relu1(D[8 + i]), w16[8 + i], ps1);                                               \
        }                                                                                             \
        float* so = sc + (size_t)(4 * w + 2 * hh) * scs + key0 + r;                                   \
        so[0] = ps0;                                                                                  \
        so[scs] = ps1;                                                                                \
        rmn0 = fminf(rmn0, ps0); rmx0 = fmaxf(rmx0, ps0);                                             \
        rmn1 = fminf(rmn1, ps1); rmx1 = fmaxf(rmx1, ps1);                                             \
      }                                                                                               \
    }                                                                                                 \
  }
    KI_GLOAD(0, shA, sfA);
#pragma unroll
    for (int t = 0; t < 4; ++t) pin8(ai[t]);
#pragma unroll
    for (int i = 0; i < 16; ++i) pinf(w16[i]);
    KI_SSTORE(0, 0, shA, sfA);
    if (NTA > 1) KI_GLOAD(1, shA, sfA);
    __syncthreads();
    for (int kt = 0; kt < NTA; kt += 2) {
      if (kt + 2 < NTA) KI_GLOAD(kt + 2, shB, sfB);
      IDX_TILE(kt, 0);
      if (kt + 1 < NTA) KI_SSTORE(kt + 1, 1, shA, sfA);
      __syncthreads();
      if (kt + 1 < NTA) {
        if (kt + 3 < NTA) KI_GLOAD(kt + 3, shA, sfA);
        IDX_TILE(kt + 1, 1);
        if (kt + 2 < NTA) KI_SSTORE(kt + 2, 0, shB, sfB);
        __syncthreads();
      }
    }
#undef IDX_TILE
#undef KI_GLOAD
#undef KI_SSTORE
  }
#pragma unroll
  for (int off = 16; off > 0; off >>= 1) {
    rmn0 = fminf(rmn0, __shfl_xor(rmn0, off)); rmx0 = fmaxf(rmx0, __shfl_xor(rmx0, off));
    rmn1 = fminf(rmn1, __shfl_xor(rmn1, off)); rmx1 = fmaxf(rmx1, __shfl_xor(rmx1, off));
  }
    constexpr int LS = 136;
    h16* sKb = (h16*)smem;
    h16* sVb = sKb + 2 * 64 * LS;
    const int kv = w >> 2, ql = 8 * (w & 3) + (r >> 2), g = r & 3, head = 4 * kv + g;
    const int i16 = lane & 15, q4 = i16 >> 2, p4 = i16 & 3, blk = (lane >> 4) & 1;
    const int tq = tok0 + ql;
    const int pq = qpos0 + ql;
    h8 qf[4];
#define DSA_QLOAD                                                                  \
    {                                                                              \
      const h16* qp = p.QB + (size_t)tq * 512 + head * 64 + 8 * hh;                \
      _Pragma("unroll") for (int t = 0; t < 4; ++t) qf[t] = *(const h8*)(qp + 16 * t); \
    }
    if (!SAMPLE) DSA_QLOAD;
    h8 sh[4];
    float4 sf[4][2];
#define KV_GLOAD(kt)                                                                                   \
  {                                                                                                    \
    _Pragma("unroll") for (int i = 0; i < 4; ++i) {                                                    \
      const int q = tid + NBLK_THREADS * i;                                                            \
      const int row = q >> 5, cc = q & 31, c16 = cc & 15;                                              \
      const int s = (kt) * 64 + row;                                                                   \
      if (!SAMPLE) {                                                                                   \
        sh[i] = *(const h8*)(((cc < 16) ? p.KB : p.VB) + (size_t)(b * 2048 + s) * 128 + c16 * 8);      \
      } else if ((kt) * 64 + 63 < PAST || s < PAST) {   \
        const float* src = ((cc < 16) ? p.c_k : p.c_v) + ((size_t)(b * PAST + s) * 128 + c16 * 8);     \
        sf[i][0] = *(const float4*)src; sf[i][1] = *(const float4*)(src + 4);                          \
      } else if (s < SKEYS) {                                                                          \
        sf[i][0] = __builtin_bit_cast(float4, *(const h8*)(((cc < 16) ? p.KB : p.VB) + (size_t)(NP + b * 32 + (s - PAST)) * 128 + c16 * 8)); \
      } else {                                                                                         \
        sf[i][0] = make_float4(0.f, 0.f, 0.f, 0.f);                                                    \
      }                                                                                                \
    }                                                                                                  \
  }
#define KV_SSTORE(kt, buf)                                                                             \
  {                                                                                                    \
    _Pragma("unroll") for (int i = 0; i < 4; ++i) {                                                    \
      const int q = tid + NBLK_THREADS * i;                                                            \
      const int row = q >> 5, cc = q & 31, c16 = cc & 15;                                              \
      const int s = (kt) * 64 + row;                                                                   \
      h8 v;                                                                                            \
      if (SAMPLE) v = ((kt) * 64 + 63 < PAST || s < PAST) ? cvt8(sf[i][0], sf[i][1]) : __builtin_bit_cast(h8, sf[i][0]); \
      else v = sh[i];                                                                                  \
      *(h8*)(((cc < 16) ? sKb : sVb) + ((buf) * 64 + row) * LS + c16 * 8) = v;                         \
    }                                                                                                  \
  }
    if (!SAMPLE) KV_GLOAD(0);
  __syncthreads();
  {
    unsigned* hist = (unsigned*)(smem + w * 8192);
    float* candv = (float*)(smem + w * 8192 + 4096);
    int* candi = (int*)(smem + w * 8192 + 4096 + 1024);
    constexpr int SNR = SAMPLE ? 33 : 32;
    float vpre[SNR];
    if (!SAMPLE && nkeys > 256) {
#pragma unroll
      for (int i = 0; i < SNR; ++i) {
        const int e = 64 * i + lane;
        vpre[i] = (e < nkeys) ? sc[(size_t)(4 * w) * scs + e] : -INFINITY;
      }
    } else {
#pragma unroll
      for (int i = 0; i < SNR; ++i) vpre[i] = 0.f;
    }
#pragma unroll 1
    for (int qw = 0; qw < 4; ++qw) {
      const int ql = 4 * w + qw;
      const float rlo = __shfl((qw & 1) ? rmn1 : rmn0, (qw >> 1) * 32), rhi = __shfl((qw & 1) ? rmx1 : rmx0, (qw >> 1) * 32);
      wave_select<SNR, SAMPLE ? 2 : 1>(sc + (size_t)ql * scs, nkeys, sMask + ql * MASK_W, hist, candv, candi, lane, vpre,
                                      (qw < 3) ? sc + (size_t)(ql + 1) * scs : (const float*)nullptr, rlo, rhi);
    }
  }
  if (SAMPLE) { DSA_QLOAD; KV_GLOAD(0); }
  __syncthreads();
  {
    const float bias_far = sBias[15 * 8 + head];
    f16v O[2];
#pragma unroll
    for (int dt = 0; dt < 2; ++dt)
#pragma unroll
      for (int i = 0; i < 16; ++i) O[dt][i] = 0.f;
    float m = -1.0e29f, l = 0.f;
#undef DSA_QLOAD
#pragma unroll
    for (int t = 0; t < 4; ++t) pin8(qf[t]);
    KV_SSTORE(0, 0);
    __syncthreads();
    int buf = 0;
    for (int kt = 0; kt < NT; ++kt) {
      if (kt + 1 < NT) KV_GLOAD(kt + 1);
      const h16* ka_ptr = sKb + buf * 64 * LS + 64 * kv + r * LS + 8 * hh;
      const h16* vb_ptr = sVb + buf * 64 * LS + 64 * kv + (4 * hh + q4) * LS + 16 * blk + 4 * p4;
      const bool nearb = (qpos0 - (kt * 64 + 63)) < 91;
      const unsigned mw0 = sMask[ql * MASK_W + kt * 2] >> (4 * hh);
      const unsigned mw1 = sMask[ql * MASK_W + kt * 2 + 1] >> (4 * hh);
      f16v S0, S1;
      const int nb = __float_as_int(NEGBIG);
      const int im0 = (int)~mw0, im1 = (int)~mw1;
      const float boff = nearb ? 0.f : bias_far;
      const float mref = (m > -1.0e28f) ? m : 0.f;
      const float cbase = boff - mref;
      MASKINITB16(S0, im0, nb, cbase);
      MASKINITB16(S1, im1, nb, cbase);
      asm volatile("s_nop 1");
      if (__builtin_expect(nearb, 0)) {
        const float* bt = sBT + (kt * 64 + 4 * hh - pq + 185) * 8 + head;
#pragma unroll
        for (int i = 0; i < 16; ++i) {
          S0[i] += bt[((i & 3) + 8 * (i >> 2)) * 8];
          S1[i] += bt[(32 + (i & 3) + 8 * (i >> 2)) * 8];
        }
      }
      {
        h8 ka0[2], ka1[2];
#pragma unroll
        for (int t = 0; t < 2; ++t) {
          ka0[t] = *(const h8*)(ka_ptr + 16 * t);
          ka1[t] = *(const h8*)(ka_ptr + 32 * LS + 16 * t);
        }
#pragma unroll
        for (int t = 0; t < 4; ++t) {
          S0 = MFMA32(ka0[t & 1], qf[t], S0);
          S1 = MFMA32(ka1[t & 1], qf[t], S1);
          if (t + 2 < 4) {
            ka0[t & 1] = *(const h8*)(ka_ptr + 16 * (t + 2));
            ka1[t & 1] = *(const h8*)(ka_ptr + 32 * LS + 16 * (t + 2));
          }
        }
      }
      h8 vf[4];
#define DSA_VLOAD(f)                                                                              \
  {                                                                                               \
    const h16* vp = vb_ptr + ((((f) >> 2) * 32) + ((((f) >> 1) & 1) * 16)) * LS + 32 * ((f) & 1); \
    vf[(f) & 3] = cat8(trread(vp), trread(vp + 8 * LS));                                          \
  }
#pragma unroll
      for (int f = 0; f < 4; ++f) DSA_VLOAD(f);
      mfma_settle();
      float mx;
      {
        float ma = max3f(S0[0], S0[1], S0[2]), mb = max3f(S0[8], S0[9], S0[10]);
        float mc = max3f(S1[0], S1[1], S1[2]), md = max3f(S1[8], S1[9], S1[10]);
        ma = max3f(ma, S0[3], S0[4]); mb = max3f(mb, S0[11], S0[12]);
        mc = max3f(mc, S1[3], S1[4]); md = max3f(md, S1[11], S1[12]);
        ma = max3f(ma, S0[5], S0[6]); mb = max3f(mb, S0[13], S0[14]);
        mc = max3f(mc, S1[5], S1[6]); md = max3f(md, S1[13], S1[14]);
        ma = max3f(ma, S0[7], S0[15]); mc = max3f(mc, S1[7], S1[15]);
        ma = max3f(ma, mb, mc);
        mx = fmaxf(ma, md);
      }
      mx = xhalf_max(mx) + mref;
      if (__builtin_expect(__any(mx > m + RESC_T), 0)) {
        const float mn = fmaxf(m, mx);
        const float alpha = fast_exp2(m - mn);
        m = mn;
        l *= alpha;
#pragma unroll
        for (int dt = 0; dt < 2; ++dt)
#pragma unroll
          for (int i = 0; i < 16; ++i) O[dt][i] *= alpha;
        const float rb = mref - mn;
#pragma unroll
        for (int i = 0; i < 16; ++i) { S0[i] += rb; S1[i] += rb; }
      }
      {
        f2v rs2 = {0.f, 0.f};
#pragma unroll
        for (int i = 0; i < 16; i += 2) {
          f2v a = {S0[i], S0[i + 1]};
          f2v c = {S1[i], S1[i + 1]};
          a[0] = fast_exp2(a[0]); a[1] = fast_exp2(a[1]);
          c[0] = fast_exp2(c[0]); c[1] = fast_exp2(c[1]);
          rs2 += a; rs2 += c;
          S0[i] = a[0]; S0[i + 1] = a[1]; S1[i] = c[0]; S1[i + 1] = c[1];
        }
        l += rs2[0] + rs2[1];
      }
      h8 pb[4];
#pragma unroll
      for (int gg = 0; gg < 4; ++gg)
#pragma unroll
        for (int jj = 0; jj < 8; ++jj) pb[gg][jj] = (h16)((gg < 2) ? S0[8 * (gg & 1) + jj] : S1[8 * (gg & 1) + jj]);
#pragma unroll
      for (int f = 0; f < 8; ++f) {
        O[f & 1] = MFMA32(vf[f & 3], pb[f >> 1], O[f & 1]);
        if (f + 4 < 8) DSA_VLOAD(f + 4);
      }
#undef DSA_VLOAD
      if (kt + 1 < NT) KV_SSTORE(kt + 1, buf ^ 1);
      __syncthreads();
      buf ^= 1;
    }
#undef KV_GLOAD
#undef KV_SSTORE
    if (threadIdx.x == 0) nxt = (int)atomicAdd(ctr, 1u);
    const float inv = 1.f / (l + __shfl_xor(l, 32));
    h16* Ot = (h16*)smem + w * (8 * 264);
    h8 gbv[4];
#pragma unroll
    for (int i = 0; i < 4; ++i) {
      const int q = lane + 64 * i;
      gbv[i] = *(const h8*)(p.GB + (size_t)(tok0 + 8 * (w & 3) + (q >> 5)) * 512 + kv * 256 + (q & 31) * 8);
    }
    {
      const int q8 = r >> 2;
#pragma unroll
      for (int dt = 0; dt < 2; ++dt) {
#pragma unroll
        for (int g4 = 0; g4 < 4; ++g4) {
          h4 o;
#pragma unroll
          for (int j = 0; j < 4; ++j) o[j] = (h16)(O[dt][4 * g4 + j] * inv);
          *(h4*)(Ot + q8 * 264 + g * 64 + 32 * dt + 8 * g4 + 4 * hh) = o;
        }
      }
    }
    wavebar();
#pragma unroll
    for (int i = 0; i < 4; ++i) {
      const int q = lane + 64 * i;
      const int row = q >> 5, ch = q & 31;
      const int tk = tok0 + 8 * (w & 3) + row;
      const h8 y = *(const h8*)(Ot + row * 264 + ch * 8);
      const h8 gb = gbv[i];
      h8 o;
#pragma unroll
      for (int j = 0; j < 8; ++j) o[j] = (h16)((float)y[j] * (float)gb[j]);
      *(h8*)(p.mix + (size_t)tk * 1024 + 512 + kv * 256 + ch * 8) = o;
    }
  }
  __syncthreads();
}

#define ITEMS_PER_Q 136
__constant__ unsigned char c_p2order[128] = {126, 127, 124, 125, 122, 123, 120, 121, 118, 119, 116, 117, 114, 115, 112, 113, 110, 111, 108, 109, 106, 107, 104, 105, 102, 103, 100, 101, 98, 99, 96, 97, 94, 95, 92, 93, 62, 63, 90, 91, 60, 61, 58, 59, 88, 89, 56, 57, 54, 55, 86, 87, 52, 53, 50, 51, 84, 85, 48, 49, 82, 83, 46, 47, 44, 45, 80, 81, 42, 43, 40, 41, 78, 79, 38, 39, 36, 37, 76, 77, 34, 35, 32, 33, 74, 75, 30, 31, 28, 29, 72, 73, 26, 27, 24, 25, 22, 23, 20, 21, 18, 19, 16, 17, 14, 15, 12, 13, 10, 11, 8, 9, 70, 71, 6, 7, 4, 5, 68, 69, 2, 3, 66, 67, 0, 1, 64, 65};
DI void phase2(const P& p, char* smem, XBar& xb, int cidx = 0) {
  volatile int& s_item = *(volatile int*)(smem + SMEM_BYTES - 16);
  const int xq = blockIdx.x & 7;
  unsigned* ctr = &p.counters[cidx * 8 + xq];
  if (threadIdx.x == 0) s_item = (int)atomicAdd(ctr, 1u);
  {
    const int tid = threadIdx.x;
    float* sBias = (float*)(smem + 73728 + 32 * MASK_W * 4);
    float* sBT = sBias + 256;
    if (tid < 256) sBias[tid] = p.rel_bias[tid] * LOG2E;
    for (int e = tid; e < 249 * 8; e += NBLK_THREADS) {
      const int rel = (e >> 3) - 185;
      const int n = rel < 0 ? -rel : rel;
      int bk = n;
      if (n >= 8) bk = 8 + (n >= 12) + (n >= 16) + (n >= 23) + (n >= 32) + (n >= 46) + (n >= 64) + (n >= 91);
      if (rel > 0) bk += 16;
      sBT[e] = p.rel_bias[bk * 8 + (e & 7)] * LOG2E;
    }
  }
  __syncthreads();
  int item = __builtin_amdgcn_readfirstlane(s_item);
  bool synced = false;
  while (item < ITEMS_PER_Q) {
    int nxt = 0;
    const int tid = opaque_tid();
    if (item < 4) {
      const int b = xq + 8 * item;
      dsa_item<true>(p, b, NP + b * 32, PAST, SKEYS, p.scS + (size_t)b * 32 * SC_STRIDE_S, SC_STRIDE_S, smem, tid, ctr, nxt);
    } else if (item < 8) {
      const int b = xq + 8 * (item - 4);
      if (!synced) { xcd_wait(xb, 3u); synced = true; }
      mla_item<true>(p, b, NP + b * 32, SKEYS, smem, tid, ctr, nxt);
    } else {
      const int k = item - 8;
      const int code = c_p2order[k];
      const int kind = code >> 6, sub = code & 1, b = xq, c = (code >> 1) & 31;
      const int tok0 = b * 2048 + c * 64 + sub * 32;
      const int nkeys = 64 * (c + 1);
      if (kind == 0) {
        if (!synced) { xcd_wait(xb, 3u); synced = true; }
        mla_item<false>(p, b, tok0, nkeys, smem, tid, ctr, nxt);
      } else {
        dsa_item<false>(p, b, tok0, c * 64 + sub * 32, nkeys, p.scP + (size_t)blockIdx.x * 32 * SC_STRIDE_P,
                        SC_STRIDE_P, smem, tid, ctr, nxt);
      }
    }
    if (threadIdx.x == 0) s_item = nxt;
    __syncthreads();
    item = __builtin_amdgcn_readfirstlane(s_item);
    __syncthreads();
  }
  if (!synced) xcd_wait(xb, 3u);
}

template <int BM>
DI void p3_epilogue(const P& p, const h16* T, int m0, int n0) {
  constexpr int TS = 136;
  const int tid = opaque_tid();
  constexpr int NIT = BM / 32;
  float4 x0[NIT], x1[NIT];
#pragma unroll
  for (int it = 0; it < NIT; ++it) {
    const int q = tid + NBLK_THREADS * it;
    const int m = m0 + (q >> 4), n = n0 + (q & 15) * 8;
    const float* xr = (m < NP ? p.x_p + (size_t)m * DM : p.x_s + (size_t)(m - NP) * DM) + n;
    x0[it] = *(const float4*)xr; x1[it] = *(const float4*)(xr + 4);
  }
#pragma unroll
  for (int it = 0; it < NIT; ++it) {
    const int q = tid + NBLK_THREADS * it;
    const int row = q >> 4, ch = q & 15;
    const int m = m0 + row, n = n0 + ch * 8;
    const h8 v = *(const h8*)(T + row * TS + ch * 8);
    h8 o;
    o[0] = (h16)(x0[it].x + (float)v[0]); o[1] = (h16)(x0[it].y + (float)v[1]);
    o[2] = (h16)(x0[it].z + (float)v[2]); o[3] = (h16)(x0[it].w + (float)v[3]);
    o[4] = (h16)(x1[it].x + (float)v[4]); o[5] = (h16)(x1[it].y + (float)v[5]);
    o[6] = (h16)(x1[it].z + (float)v[6]); o[7] = (h16)(x1[it].w + (float)v[7]);
    *(h8*)(p.XN + (size_t)m * DM + n) = o;
  }
}
DI void phase3(const P& p, char* smem) {
  constexpr int TS = 136;
  h16* T = (h16*)smem;
  for (int tile = blockIdx.x; tile < 256; tile += gridDim.x) {
    const int xcd = tile & 7, idx = tile >> 3;
    const int mt = xcd * 8 + (idx >> 2), pn = idx & 3;
    const int m0 = mt * 256;
    f32x4 acc[2][2][4][2];
    gemm8_mainloop(p.mix, p.Wt_out, DM, m0, pn * 256, smem, acc);
    __syncthreads();
    const int tid = opaque_tid();
    const int wid = tid >> 6, lane = tid & 63, wr = wid >> 2, wc = wid & 3, fr = lane & 15, fq = lane >> 4;
#pragma unroll
    for (int bj = 0; bj < 2; ++bj) {
#pragma unroll
      for (int ai = 0; ai < 2; ++ai)
#pragma unroll
        for (int m = 0; m < 4; ++m)
#pragma unroll
          for (int n = 0; n < 2; ++n)
          {
            h4 o;
#pragma unroll
            for (int jj = 0; jj < 4; ++jj) o[jj] = (h16)acc[ai][bj][m][n][jj];
            *(h4*)(T + (ai * 128 + wr * 64 + m * 16 + fr) * TS + wc * 32 + n * 16 + fq * 4) = o;
          }
      __syncthreads();
      p3_epilogue<256>(p, T, m0, pn * 256 + bj * 128);
      __syncthreads();
    }
  }
  for (int tile = blockIdx.x; tile < 128; tile += gridDim.x) {
    const int m0 = NP + (tile >> 3) * 64, n0 = (tile & 7) * 128;
    gemm_tile<64, 128, 2, 4>(p.mix, 1024, p.Wt_out, 1024, 1024, m0, n0, smem);
    p3_epilogue<64>(p, T, m0, n0);
    __syncthreads();
  }
}

DI void phase4(const P& p) {
  const int tid = opaque_tid(), lane = tid & 63, w = tid >> 6;
  const int gw = blockIdx.x * 8 + w, nw = gridDim.x * 8;
  for (int k0 = 0; gw + nw * k0 < NTOK; k0 += 5) {
    h4 v[5][4];
    float ss[5];
#pragma unroll
    for (int rr = 0; rr < 5; ++rr) {
      const int row = gw + nw * (k0 + rr);
#pragma unroll
      for (int k = 0; k < 4; ++k) {
        if (row < NTOK) v[rr][k] = *(const h4*)(p.XN + (size_t)row * DM + 4 * lane + 256 * k);
        else { v[rr][k][0] = (h16)0.f; v[rr][k][1] = (h16)0.f; v[rr][k][2] = (h16)0.f; v[rr][k][3] = (h16)0.f; }
      }
    }
#pragma unroll
    for (int rr = 0; rr < 5; ++rr) {
      float a = 0.f;
#pragma unroll
      for (int k = 0; k < 4; ++k)
#pragma unroll
        for (int e = 0; e < 4; ++e) a += (float)v[rr][k][e] * (float)v[rr][k][e];
      ss[rr] = a;
    }
#pragma unroll
    for (int off = 32; off > 0; off >>= 1) {
#pragma unroll
      for (int rr = 0; rr < 5; ++rr) ss[rr] += __shfl_xor(ss[rr], off);
    }
    float4 g[4];
#pragma unroll
    for (int k = 0; k < 4; ++k) g[k] = *(const float4*)(p.fn_g + 4 * lane + 256 * k);
#pragma unroll
    for (int rr = 0; rr < 5; ++rr) {
      const int row = gw + nw * (k0 + rr);
      if (row < NTOK) {
        const float rstd = rsqrtf(ss[rr] * (1.f / 1024.f) + 1e-6f);
        float* o = p.out + (size_t)row * DM;
#pragma unroll
        for (int k = 0; k < 4; ++k)
          *(float4*)(o + 4 * lane + 256 * k) = make_float4((float)v[rr][k][0] * rstd * g[k].x, (float)v[rr][k][1] * rstd * g[k].y,
                                                           (float)v[rr][k][2] * rstd * g[k].z, (float)v[rr][k][3] * rstd * g[k].w);
      }
    }
  }
}

__global__ void __launch_bounds__(NBLK_THREADS) mega_kernel(P p) {
  __shared__ __attribute__((aligned(16))) char smem[SMEM_BYTES];
  XBar xb;
  xb.w = p.counters;
  xb.x = (unsigned)__builtin_amdgcn_s_getreg((3 << 11) | 20) & 0xFu;
  xb.nloc = 0u; xb.nx = 0u;
  if (threadIdx.x == 0) __hip_atomic_fetch_add(&xb.w[XB_CNT(xb.x)], 1u, __ATOMIC_RELAXED, __HIP_MEMORY_SCOPE_AGENT);
  phase0(p, smem);
  xcd_barrier(xb, 1u, smem);
  phase1(p, smem);
  xcd_arrive(xb, 2u);
  h8 pf2 = zero8();
  if (gridDim.x >= 64 && blockIdx.x >= 32) {
    const int pn = (int)((blockIdx.x - 32) % 5);
    pf2 = *(const h8*)(p.Wq + (size_t)(pn * 256 + (threadIdx.x >> 1)) * 256 + (threadIdx.x & 1) * 64);
  }
  xcd_wait(xb, 2u);
  pin8(pf2);
  phase1b(p, smem);
  xcd_arrive(xb, 3u);
  phase2(p, smem, xb);
  xcd_arrive(xb, 4u);
  h8 pf4 = zero8();
  if (blockIdx.x < 256) {
    const int pn = (int)((blockIdx.x >> 3) & 3);
    pf4 = *(const h8*)(p.Wt_out + (size_t)(pn * 256 + (threadIdx.x >> 1)) * 1024 + (threadIdx.x & 1) * 64);
  }
  xcd_wait(xb, 4u);
  pin8(pf4);
  phase3(p, smem);
  xcd_barrier(xb, 5u, smem);
  phase4(p);
}

extern "C" void kernel_launch(void* const* d_in, const int* in_sizes, int n_in, void* d_out, int out_size, void* d_ws,
                              size_t ws_size, hipStream_t stream) {
  P p{};
  p.x_p = (const float*)d_in[0];
  p.x_s = (const float*)d_in[1];
  p.c_ckv = (const float*)d_in[2];
  p.c_kpe = (const float*)d_in[3];
  p.c_k = (const float*)d_in[4];
  p.c_v = (const float*)d_in[5];
  p.c_kidx = (const float*)d_in[6];
  p.norm_g = (const float*)d_in[7];
  p.w_in = (const float*)d_in[8];
  p.qn_g = (const float*)d_in[9];
  p.kvn_g = (const float*)d_in[10];
  p.w_uq = (const float*)d_in[11];
  p.w_uk = (const float*)d_in[12];
  p.w_uv = (const float*)d_in[13];
  p.rel_bias = (const float*)d_in[14];
  p.w_out = (const float*)d_in[15];
  p.fn_g = (const float*)d_in[16];
  p.out = (float*)d_out;

  char* ws = (char*)d_ws;
  size_t off = 0;
  auto carve = [&](size_t bytes) {
    char* r = ws + off;
    off += (bytes + 255) & ~(size_t)255;
    return r;
  };
  p.counters = (unsigned*)carve(XB_WORDS * 4);
  p.hX = (h16*)carve((size_t)NTOK * DM * 2);
  p.mix = p.hX;
  p.scP = (float*)carve((size_t)256 * 32 * SC_STRIDE_P * 4);
  p.CQ = (h16*)carve((size_t)NTOK * 256 * 2);
  p.Wt_in = (h16*)carve((size_t)INWP * DM * 2);
  p.Wt_out = (h16*)carve((size_t)DM * DM * 2);
  p.Wq = (h16*)carve((size_t)1280 * 256 * 2);
  p.Wuv = (h16*)carve((size_t)8 * 64 * 128 * 2);
  p.QM = (h16*)carve((size_t)NTOK * 1280 * 2);
  p.XN = (h16*)carve((size_t)NTOK * DM * 2);
  p.KM = (h16*)carve((size_t)NTOK * 160 * 2);
  p.GA = (h16*)carve((size_t)NTOK * 512 * 2);
  p.GB = (h16*)carve((size_t)NTOK * 512 * 2);
  p.QB = (h16*)carve((size_t)NTOK * 512 * 2);
  p.KB = (h16*)carve((size_t)NTOK * 128 * 2);
  p.VB = (h16*)carve((size_t)NTOK * 128 * 2);
  p.QI = (h16*)carve((size_t)NTOK * 512 * 2);
  p.KI = (h16*)carve((size_t)NTOK * 64 * 2);
  p.WI = (float*)carve((size_t)NTOK * 8 * 4);
  p.RQP = (float*)carve((size_t)NTOK * 2 * 4);
  p.ropeC = (float*)carve((size_t)2080 * 16 * 4);
  p.ropeS = (float*)carve((size_t)2080 * 16 * 4);
  p.scS = (float*)carve((size_t)32 * 32 * SC_STRIDE_S * 4);
  if (off > ws_size) {
    fprintf(stderr, "workspace too small: need %zu have %zu\n", off, ws_size);
    return;
  }
  static int grid_blocks = 0;
  if (!grid_blocks) {
    int dev = 0, cus = 0, per_cu = 0;
    hipGetDevice(&dev);
    hipDeviceGetAttribute(&cus, hipDeviceAttributeMultiprocessorCount, dev);
    hipOccupancyMaxActiveBlocksPerMultiprocessor(&per_cu, mega_kernel, NBLK_THREADS, 0);
    if (per_cu > 1) per_cu = 1;
    grid_blocks = cus * per_cu;
    if (grid_blocks > 256) grid_blocks = 256;
  }
  hipMemsetAsync(p.counters, 0, XB_WORDS * 4, stream);
  hipLaunchKernelGGL(mega_kernel, dim3(grid_blocks), dim3(NBLK_THREADS), 0, stream, p);
}
```
